# Optimizing an MI355X kernel written in HIP

```python
import math
import jax, jax.numpy as jnp
from jax import lax
import numpy as np

D_MODEL = 1024
BATCH = 32
SEQ = 256
DEPTH = 1
DEC_BATCH = 8
DEC_SEQ = 4096
PAST_LEN = 512

GRID_W = 64
N_DIR = 2
D_LRU = 1024
LRU_HEADS = 16
LRU_BLOCK = D_LRU // LRU_HEADS
CONV_W = 4
LRU_C = 8.0
D_S5 = 512
S5_GROUP = 16
S5_GROUPS = D_S5 // S5_GROUP
S5_STATE = 64
D_FF = 2816
EPS = 1e-6

kernel_name = "hybrid_rglru_s5_diffusion_step"


def _rmsnorm(x, g):
    x32 = x.astype(jnp.float32)
    y = x32 * lax.rsqrt(jnp.mean(x32 * x32, axis=-1, keepdims=True) + EPS) * g.astype(jnp.float32)
    return y.astype(x.dtype)


def _dwconv(x, w, b):
    y = lax.conv_general_dilated(x, w[:, None, :].astype(x.dtype), window_strides=(1,),
                                 padding=[(2, 1)], dimension_numbers=("NWC", "WIO", "NWC"),
                                 feature_group_count=x.shape[-1])
    return y + b.astype(x.dtype)


def _to_col_major(x):
    bsz, t, ch = x.shape
    rows = t // GRID_W
    return x.reshape(bsz, rows, GRID_W, ch).transpose(0, 2, 1, 3).reshape(bsz, t, ch)


def _from_col_major(x):
    bsz, t, ch = x.shape
    rows = t // GRID_W
    return x.reshape(bsz, GRID_W, rows, ch).transpose(0, 2, 1, 3).reshape(bsz, t, ch)


def _linear_scan(a, b, h0):
    def comb(e1, e2):
        return (e1[0] * e2[0], e2[0] * e1[1] + e2[1])
    a_cum, b_cum = lax.associative_scan(comb, (a, b), axis=1)
    return a_cum * h0[:, None] + b_cum


def _complex_linear_scan(a_re, a_im, b_re, b_im, h0_re, h0_im):
    def comb(e1, e2):
        a1r, a1i, b1r, b1i = e1
        a2r, a2i, b2r, b2i = e2
        return (a2r * a1r - a2i * a1i, a2r * a1i + a2i * a1r,
                a2r * b1r - a2i * b1i + b2r, a2r * b1i + a2i * b1r + b2i)
    ar, ai, br, bi = lax.associative_scan(comb, (a_re, a_im, b_re, b_im), axis=1)
    h0r, h0i = h0_re[:, None], h0_im[:, None]
    return ar * h0r - ai * h0i + br, ar * h0i + ai * h0r + bi


def _rglru_bidir(u, lam, w_r, b_r, w_i, b_i, h0, return_state):
    bsz, t, ch = u.shape
    out = jnp.zeros_like(u)
    finals = []
    for d in range(N_DIR):
        ud = u if d == 0 else jnp.flip(u, axis=1)
        ub = ud.reshape(bsz, t, LRU_HEADS, LRU_BLOCK)
        r = jax.nn.sigmoid(jnp.einsum("bthi,hij->bthj", ub, w_r[d].astype(jnp.float32)).reshape(bsz, t, ch)
                           + b_r[d].astype(jnp.float32))
        i = jax.nn.sigmoid(jnp.einsum("bthi,hij->bthj", ub, w_i[d].astype(jnp.float32)).reshape(bsz, t, ch)
                           + b_i[d].astype(jnp.float32))
        log_a = -LRU_C * r * jax.nn.softplus(-lam[d].astype(jnp.float32))
        a = jnp.exp(log_a)
        b = jnp.sqrt(-jnp.expm1(2.0 * log_a)) * (i * ud)
        h = _linear_scan(a, b, h0[:, d])
        if return_state:
            finals.append(h[:, -1])
        out = out + (h if d == 0 else jnp.flip(h, axis=1))
    fin = jnp.stack(finals, axis=1) if return_state else None
    return out, fin


def _s5_bidir(u, a_re, a_im, log_dt, b_re, b_im, c_re, c_im, h0_re, h0_im, return_state):
    bsz, t, ch = u.shape
    y = jnp.zeros((bsz, t, S5_GROUPS, S5_GROUP), jnp.float32)
    fin_re, fin_im = [], []
    for d in range(N_DIR):
        lr = a_re[d].astype(jnp.float32)
        li = a_im[d].astype(jnp.float32)
        dt = jnp.exp(log_dt[d].astype(jnp.float32))[:, None]
        mag = jnp.exp(lr * dt)
        abar_re, abar_im = mag * jnp.cos(li * dt), mag * jnp.sin(li * dt)
        den = lr * lr + li * li
        nr, ni = abar_re - 1.0, abar_im
        f_re = (nr * lr + ni * li) / den
        f_im = (ni * lr - nr * li) / den
        br_d, bi_d = b_re[d].astype(jnp.float32), b_im[d].astype(jnp.float32)
        bb_re = f_re[..., None] * br_d - f_im[..., None] * bi_d
        bb_im = f_re[..., None] * bi_d + f_im[..., None] * br_d
        ud = (u if d == 0 else jnp.flip(u, axis=1)).reshape(bsz, t, S5_GROUPS, S5_GROUP)
        bu_re = jnp.einsum("btgh,gph->btgp", ud, bb_re)
        bu_im = jnp.einsum("btgh,gph->btgp", ud, bb_im)
        ar = jnp.broadcast_to(abar_re, bu_re.shape)
        ai = jnp.broadcast_to(abar_im, bu_re.shape)
        h_re, h_im = _complex_linear_scan(ar, ai, bu_re, bu_im,
                                          h0_re[:, d].astype(jnp.float32), h0_im[:, d].astype(jnp.float32))
        if return_state:
            fin_re.append(h_re[:, -1])
            fin_im.append(h_im[:, -1])
        yd = (jnp.einsum("btgp,ghp->btgh", h_re, c_re[d].astype(jnp.float32))
              - jnp.einsum("btgp,ghp->btgh", h_im, c_im[d].astype(jnp.float32)))
        y = y + (yd if d == 0 else jnp.flip(yd, axis=1))
    if return_state:
        return y.reshape(bsz, t, ch), jnp.stack(fin_re, axis=1), jnp.stack(fin_im, axis=1)
    return y.reshape(bsz, t, ch), None, None


def _layer(x, cvec, p, h0_lru, h0_re, h0_im, grid_order, return_state):
    dtype = x.dtype
    mod = (jax.nn.silu(cvec) @ p["w_mod"] + p["b_mod"])[:, None, :]
    sh1, sc1, g1, sh2, sc2, g2 = jnp.split(mod, 6, axis=-1)
    hn = _rmsnorm(x, p["g_pre_mix"]) * (1.0 + sc1) + sh1
    z = hn @ p["w_in"]
    xa, ga, xs = jnp.split(z, [D_LRU, 2 * D_LRU], axis=-1)
    ua = _dwconv(xa, p["conv_w"], p["conv_b"]).astype(jnp.float32)
    ha, fin_lru = _rglru_bidir(ua, p["lru_lambda"], p["lru_w_r"], p["lru_b_r"], p["lru_w_i"], p["lru_b_i"],
                               h0_lru, return_state)
    ya = jax.nn.gelu(ga) * ha.astype(dtype)
    if grid_order:
        xs = _to_col_major(xs)
    us = xs.astype(jnp.float32)
    hs, fin_re, fin_im = _s5_bidir(us, p["s5_a_re"], p["s5_a_im"], p["s5_log_dt"], p["s5_b_re"], p["s5_b_im"],
                                   p["s5_c_re"], p["s5_c_im"], h0_re, h0_im, return_state)
    vs = jax.nn.gelu(hs + p["s5_d"].astype(jnp.float32) * us).astype(dtype)
    ys = vs * jax.nn.sigmoid(vs @ p["s5_w_glu"] + p["s5_b_glu"])
    if grid_order:
        ys = _from_col_major(ys)
    gate_a, gate_b = jnp.split(jax.nn.sigmoid(hn @ p["w_gate"] + p["b_gate"]), 2, axis=-1)
    m = (gate_a * (ya @ p["w_proj_lru"]) + gate_b * (ys @ p["w_proj_s5"])) @ p["w_out"]
    x = x + g1 * _rmsnorm(m, p["g_post_mix"])
    hn2 = _rmsnorm(x, p["g_pre_ffn"]) * (1.0 + sc2) + sh2
    u1, u3 = jnp.split(hn2 @ p["w_ff_in"], 2, axis=-1)
    f = (jax.nn.silu(u1) * u3) @ p["w_ff_out"]
    x = x + g2 * _rmsnorm(f, p["g_post_ffn"])
    return x, fin_lru, fin_re, fin_im


def setup_inputs(seed: int = 0) -> dict:
    key = jax.random.key(seed)
    ks = iter(jax.random.split(key, 48))

    def nrm(shape, scale):
        return jax.random.normal(next(ks), shape, jnp.float32) * scale

    D = D_MODEL
    a_init = jax.random.uniform(next(ks), (DEPTH, N_DIR, D_LRU), jnp.float32, 0.9, 0.999)
    n_idx = jnp.arange(S5_STATE, dtype=jnp.float32)
    return {
        "x_prompt": nrm((BATCH, SEQ, D), 1.0),
        "x_sample": nrm((DEC_BATCH, DEC_SEQ, D), 1.0),
        "c": nrm((DEC_BATCH, D), 1.0),
        "state_lru": nrm((DEC_BATCH, DEPTH, N_DIR, D_LRU), 0.5),
        "state_s5_re": nrm((DEC_BATCH, DEPTH, N_DIR, S5_GROUPS, S5_STATE), 0.5),
        "state_s5_im": nrm((DEC_BATCH, DEPTH, N_DIR, S5_GROUPS, S5_STATE), 0.5),
        "c_ctx": nrm((D,), 1.0),
        "w_mod": nrm((DEPTH, D, 6 * D), D ** -0.5),
        "b_mod": nrm((DEPTH, 6 * D), 0.02),
        "g_pre_mix": 1.0 + nrm((DEPTH, D), 0.05),
        "g_post_mix": 1.0 + nrm((DEPTH, D), 0.05),
        "g_pre_ffn": 1.0 + nrm((DEPTH, D), 0.05),
        "g_post_ffn": 1.0 + nrm((DEPTH, D), 0.05),
        "w_in": nrm((DEPTH, D, 2 * D_LRU + D_S5), D ** -0.5),
        "conv_w": nrm((DEPTH, CONV_W, D_LRU), CONV_W ** -0.5),
        "conv_b": nrm((DEPTH, D_LRU), 0.02),
        "lru_w_r": nrm((DEPTH, N_DIR, LRU_HEADS, LRU_BLOCK, LRU_BLOCK), LRU_BLOCK ** -0.5),
        "lru_b_r": nrm((DEPTH, N_DIR, D_LRU), 0.02),
        "lru_w_i": nrm((DEPTH, N_DIR, LRU_HEADS, LRU_BLOCK, LRU_BLOCK), LRU_BLOCK ** -0.5),
        "lru_b_i": nrm((DEPTH, N_DIR, D_LRU), 0.02),
        "lru_lambda": jnp.log(a_init / (1.0 - a_init)),
        "s5_a_re": -0.5 + nrm((DEPTH, N_DIR, S5_GROUPS, S5_STATE), 0.01),
        "s5_a_im": math.pi * n_idx + nrm((DEPTH, N_DIR, S5_GROUPS, S5_STATE), 0.01),
        "s5_log_dt": jax.random.uniform(next(ks), (DEPTH, N_DIR, S5_GROUPS), jnp.float32,
                                        math.log(1e-3), math.log(1e-1)),
        "s5_b_re": nrm((DEPTH, N_DIR, S5_GROUPS, S5_STATE, S5_GROUP), (2 * S5_GROUP) ** -0.5),
        "s5_b_im": nrm((DEPTH, N_DIR, S5_GROUPS, S5_STATE, S5_GROUP), (2 * S5_GROUP) ** -0.5),
        "s5_c_re": nrm((DEPTH, N_DIR, S5_GROUPS, S5_GROUP, S5_STATE), S5_STATE ** -0.5),
        "s5_c_im": nrm((DEPTH, N_DIR, S5_GROUPS, S5_GROUP, S5_STATE), S5_STATE ** -0.5),
        "s5_d": nrm((DEPTH, D_S5), 0.5),
        "s5_w_glu": nrm((DEPTH, D_S5, D_S5), D_S5 ** -0.5),
        "s5_b_glu": nrm((DEPTH, D_S5), 0.02),
        "w_proj_lru": nrm((DEPTH, D_LRU, D), D_LRU ** -0.5),
        "w_proj_s5": nrm((DEPTH, D_S5, D), D_S5 ** -0.5),
        "w_gate": nrm((DEPTH, D, 2 * D), D ** -0.5),
        "b_gate": nrm((DEPTH, 2 * D), 0.02),
        "w_out": nrm((DEPTH, D, D), D ** -0.5),
        "w_ff_in": nrm((DEPTH, D, 2 * D_FF), D ** -0.5),
        "w_ff_out": nrm((DEPTH, D_FF, D), D_FF ** -0.5),
    }


def reference(x_prompt, x_sample, c, state_lru, state_s5_re, state_s5_im, c_ctx,
              w_mod, b_mod, g_pre_mix, g_post_mix, g_pre_ffn, g_post_ffn, w_in, conv_w, conv_b,
              lru_w_r, lru_b_r, lru_w_i, lru_b_i, lru_lambda,
              s5_a_re, s5_a_im, s5_log_dt, s5_b_re, s5_b_im, s5_c_re, s5_c_im, s5_d, s5_w_glu, s5_b_glu,
              w_proj_lru, w_proj_s5, w_gate, b_gate, w_out, w_ff_in, w_ff_out):
    stacked = (("w_mod", w_mod), ("b_mod", b_mod), ("g_pre_mix", g_pre_mix), ("g_post_mix", g_post_mix),
               ("g_pre_ffn", g_pre_ffn), ("g_post_ffn", g_post_ffn), ("w_in", w_in), ("conv_w", conv_w),
               ("conv_b", conv_b), ("lru_w_r", lru_w_r), ("lru_b_r", lru_b_r), ("lru_w_i", lru_w_i),
               ("lru_b_i", lru_b_i), ("lru_lambda", lru_lambda), ("s5_a_re", s5_a_re), ("s5_a_im", s5_a_im),
               ("s5_log_dt", s5_log_dt), ("s5_b_re", s5_b_re), ("s5_b_im", s5_b_im), ("s5_c_re", s5_c_re),
               ("s5_c_im", s5_c_im), ("s5_d", s5_d), ("s5_w_glu", s5_w_glu), ("s5_b_glu", s5_b_glu),
               ("w_proj_lru", w_proj_lru), ("w_proj_s5", w_proj_s5), ("w_gate", w_gate), ("b_gate", b_gate),
               ("w_out", w_out), ("w_ff_in", w_ff_in), ("w_ff_out", w_ff_out))
    n_ctx = x_prompt.shape[0]
    ctx_c = jnp.broadcast_to(c_ctx, (n_ctx, D_MODEL))
    zero_lru = jnp.zeros((n_ctx, N_DIR, D_LRU), jnp.float32)
    zero_s5 = jnp.zeros((n_ctx, N_DIR, S5_GROUPS, S5_STATE), jnp.float32)
    y_prompt, y_sample = x_prompt, x_sample
    lru_list, re_list, im_list = [], [], []
    for l in range(DEPTH):
        p = {name: arr[l] for name, arr in stacked}
        y_prompt, f_lru, f_re, f_im = _layer(y_prompt, ctx_c, p, zero_lru, zero_s5, zero_s5,
                                             grid_order=False, return_state=True)
        lru_list.append(f_lru)
        re_list.append(f_re)
        im_list.append(f_im)
        y_sample, _, _, _ = _layer(y_sample, c, p, state_lru[:, l].astype(jnp.float32),
                                   state_s5_re[:, l], state_s5_im[:, l],
                                   grid_order=True, return_state=False)
    new_state_lru = jnp.stack(lru_list, axis=1)
    new_state_s5_re = jnp.stack(re_list, axis=1)
    new_state_s5_im = jnp.stack(im_list, axis=1)
    return (y_prompt, y_sample, new_state_lru, new_state_s5_re, new_state_s5_im)
```

```cpp
#include <hip/hip_runtime.h>
#include <hip/hip_cooperative_groups.h>
#include <cstdio>
#include <cstdint>
namespace cg = cooperative_groups;

#define LAS __attribute__((address_space(3)))
typedef unsigned short bf16_t;
typedef short bf16x8 __attribute__((ext_vector_type(8)));
typedef float f32x4 __attribute__((ext_vector_type(4)));
typedef float f32x16 __attribute__((ext_vector_type(16)));
typedef float f32x2 __attribute__((ext_vector_type(2)));
typedef unsigned u32x4 __attribute__((ext_vector_type(4)));
typedef unsigned u32x2 __attribute__((ext_vector_type(2)));

constexpr int DM = 1024, MC = 8192, MS = 32768, MT = MC + MS;
constexpr int NB_CTX = 32, T_CTX = 256, NB_S = 8, T_S = 4096;
constexpr int DFF = 2816, DS5 = 512;
constexpr float EPS = 1e-6f;
constexpr size_t OFF_LRU = (size_t)MT * DM, OFF_RE = OFF_LRU + 32 * 2 * 1024, OFF_IM = OFF_RE + 32 * 2 * 32 * 64;
constexpr size_t MiB = 1u << 20;
constexpr size_t WS_MOD = 512 * 1024;
constexpr size_t WS_W1T = 1 * MiB, WS_WPL = 10 * MiB, WS_WPS = 12 * MiB, WS_WOUT = 13 * MiB, WS_WFI = 15 * MiB, WS_WFO = 26 * MiB, WS_WGLU = 31 * MiB + 512 * 1024;
constexpr size_t WS_HN = 32 * MiB, WS_XA = 112 * MiB, WS_XS = 192 * MiB, WS_VS = 232 * MiB, WS_YA = 272 * MiB, WS_GA = 352 * MiB, WS_SSP1 = 432 * MiB, WS_SSP2 = 435 * MiB, WS_END = 438 * MiB;
constexpr size_t WS_TMP = WS_HN, WS_MPRE = WS_GA, WS_MO = WS_HN, WS_HN2 = WS_GA, WS_HID = WS_HN, WS_FO = WS_YA, WS_FOB = WS_GA, WS_YS = WS_XS;
constexpr int LDS_BYTES = 147456;

struct Params { const float* in[38]; float* out; unsigned char* ws; };
struct Ctx { const LAS unsigned long long* tbl; float* out; unsigned char* ws; };
__device__ __forceinline__ const float* inp_(const LAS unsigned long long* tbl, int i) { const unsigned long long v = tbl[i];
    const unsigned lo = __builtin_amdgcn_readfirstlane((unsigned)v), hi = __builtin_amdgcn_readfirstlane((unsigned)(v >> 32)); return (const float*)(const __attribute__((address_space(1))) float*)(((unsigned long long)hi << 32) | lo); }
#define PIN(i) inp_(p.tbl, (i))

__device__ __forceinline__ unsigned f2bf(float f) { unsigned u = __builtin_bit_cast(unsigned, f); return (u + 0x7fffu + ((u >> 16) & 1u)) >> 16; }
__device__ __forceinline__ unsigned pk2(float lo, float hi) { unsigned r; asm volatile("s_nop 1\n\tv_cvt_pk_bf16_f32 %0, %1, %2" : "=v"(r) : "v"(lo), "v"(hi)); return r; }
__device__ __forceinline__ bf16_t f2bf1(float x) { return (bf16_t)(pk2(x, 0.f) & 0xffffu); }
__device__ __forceinline__ float bf_lo(unsigned w) { return __builtin_bit_cast(float, w << 16); }
__device__ __forceinline__ float bf_hi(unsigned w) { return __builtin_bit_cast(float, w & 0xffff0000u); }
__device__ __forceinline__ float bf2f(bf16_t h) { return __builtin_bit_cast(float, ((unsigned)h) << 16); }
__device__ __forceinline__ float sigmoidf_(float x) { return __builtin_amdgcn_rcpf(1.0f + __builtin_amdgcn_exp2f(-1.44269504089f * x)); }
__device__ __forceinline__ float siluf_(float x) { return x * sigmoidf_(x); }
__device__ __forceinline__ float gelu_tanh(float x) { const float u = x + 0.044715f * x * x * x; return x * __builtin_amdgcn_rcpf(1.0f + __builtin_amdgcn_exp2f(-2.30220819f * u)); }
__device__ __forceinline__ const float* xrow(const Ctx p, int r) { return r < MC ? PIN(0) + (size_t)r * DM : PIN(1) + (size_t)(r - MC) * DM; }
__device__ __forceinline__ int mod_index(int r) { return r < MC ? 0 : 1 + ((r - MC) >> 12); }
namespace pg8 {
#define PG8_LAS __attribute__((address_space(3)))
constexpr int BM = 256, BK = 64, HALF = 128, HTB = HALF * BK * 2  , STAGE_BYTES = 8 * HTB, NXCD = 8, WGM = 8;
__host__ __device__ __forceinline__ int lds_byte(int r, int c) { const int st = (r >> 4) * 2 + (c >> 5), rr = r & 15, cc = c & 31, ob = rr * 64 + cc * 2; return st * 1024 + (ob ^ (((ob >> 9) & 1) << 5)); }
__host__ __device__ __forceinline__ void stage_rc(int b, int& R, int& C) { const int st = b / 1024, sb = b % 1024, swz = sb ^ (((sb >> 9) & 1) << 5); R = (st >> 1) * 16 + swz / 64; C = (st & 1) * 32 + (swz % 64) / 2; }
__host__ __device__ __forceinline__ int perm32(int rho) { const int n = rho >> 4, i = rho & 15; return 8 * (i >> 2) + 4 * n + (i & 3); }
struct Unit { int pm, pn; };
struct Gemm { const bf16_t* A; const bf16_t* Bt; int M, N, K; int ld = 0; };
struct StaticOrder {
    int nM, nN, nwg, G, c;
    __host__ __device__ void init(int M, int N, int G_, int c_) { nM = M / BM; nN = N / BM; nwg = nM * nN; G = G_; c = c_; }
    __host__ __device__ bool next(int i, Unit& u) const {
        const long L = (long)i * G + c; if (L >= nwg) return false;
        int wgid = (int)L; { const int q = nwg / NXCD, r = nwg % NXCD, xcd = wgid % NXCD, off = wgid / NXCD; wgid = (xcd < r ? xcd * (q + 1) : r * (q + 1) + (xcd - r) * q) + off; }
        const int nig = WGM * nN, gid = wgid / nig, fm = gid * WGM, gsz = (nM - fm) < WGM ? (nM - fm) : WGM;
        u.pm = fm + ((wgid % nig) % gsz); u.pn = (wgid % nig) / gsz; return true;
    }
    __device__ __forceinline__ void a_ready(const Unit&) const {}
    __device__ __forceinline__ void done(const Unit&) const {}
};
struct ListOrder : StaticOrder {
    int base, stride, count, extra;
    __host__ __device__ bool next(int i, Unit& u) const {
        if (i > count || (i == count && extra < 0)) return false;
        const long L = (i < count) ? (long)base + (long)i * stride : (long)extra; if (L >= nwg) return false;
        int wgid = (int)L; { const int q = nwg / NXCD, r = nwg % NXCD, xcd = wgid % NXCD, off = wgid / NXCD; wgid = (xcd < r ? xcd * (q + 1) : r * (q + 1) + (xcd - r) * q) + off; }
        const int nig = WGM * nN, gid = wgid / nig, fm = gid * WGM, gsz = (nM - fm) < WGM ? (nM - fm) : WGM;
        u.pm = fm + ((wgid % nig) % gsz); u.pn = (wgid % nig) / gsz; return true;
    }
};
__device__ __forceinline__ unsigned cvt_pk_bf16(float lo, float hi) { unsigned r; asm volatile("s_nop 1\n\tv_cvt_pk_bf16_f32 %0, %1, %2" : "=v"(r) : "v"(lo), "v"(hi)); return r; }
__device__ __forceinline__ u32x4 pack8(const f32x4 a, const f32x4 b) { u32x4 w; w.x = cvt_pk_bf16(a[0], a[1]); w.y = cvt_pk_bf16(a[2], a[3]); w.z = cvt_pk_bf16(b[0], b[1]); w.w = cvt_pk_bf16(b[2], b[3]); return w; }
__device__ __forceinline__ void unpack8(const u32x4 w, f32x4& a, f32x4& b) { a = (f32x4){bf_lo(w.x), bf_hi(w.x), bf_lo(w.y), bf_hi(w.y)}; b = (f32x4){bf_lo(w.z), bf_hi(w.z), bf_lo(w.w), bf_hi(w.w)}; }

#define EPI_LOOP_BEGIN \
    _Pragma("unroll") for (int ai = 0; ai < 2; ++ai) _Pragma("unroll") for (int m = 0; m < 4; ++m) { const int row = u.pm * BM + ai * HALF + wr * 64 + m * 16 + fr; \
    _Pragma("unroll") for (int bj = 0; bj < 2; ++bj) { const int ct = bj * HALF + wc * 32 + 8 * fq; f32x4 v0 = acc[ai][bj][m][0], v1 = acc[ai][bj][m][1];
#define EPI_LOOP_END } }

struct Epi1 {
    static constexpr bool PERM = true, AFTER_DRAIN = false;
    bf16_t* XA; bf16_t* GA; bf16_t* XS;
    __device__ __forceinline__ void operator()(const f32x4 (&acc)[2][2][4][2], const Unit& u, int wr, int wc, int fr, int fq) const {
        const int pn = u.pn;
        if (pn < 4) {
            EPI_LOOP_BEGIN *(u32x4*)(XA + (size_t)row * 1024 + pn * 256 + ct) = pack8(v0, v1); EPI_LOOP_END
        } else if (pn < 8) {
            EPI_LOOP_BEGIN
#pragma unroll
                for (int j = 0; j < 4; ++j) { v0[j] = gelu_tanh(v0[j]); v1[j] = gelu_tanh(v1[j]); }
                *(u32x4*)(GA + (size_t)row * 1024 + (pn - 4) * 256 + ct) = pack8(v0, v1); EPI_LOOP_END
        } else {
            EPI_LOOP_BEGIN *(u32x4*)(XS + (size_t)row * 512 + (pn - 8) * 256 + ct) = pack8(v0, v1); EPI_LOOP_END
        }
    }
};
struct EpiGate {
    static constexpr bool PERM = true, AFTER_DRAIN = false;
    bf16_t* GATE; const float* bgate;
    __device__ __forceinline__ void operator()(const f32x4 (&acc)[2][2][4][2], const Unit& u, int wr, int wc, int fr, int fq) const {
        const int cb = u.pn * 256;
#pragma unroll
        for (int bj = 0; bj < 2; ++bj) { const int ct = bj * HALF + wc * 32 + 8 * fq;
            const f32x4 b0 = *(const f32x4*)(bgate + cb + ct), b1 = *(const f32x4*)(bgate + cb + ct + 4);
#pragma unroll
            for (int ai = 0; ai < 2; ++ai)
#pragma unroll
                for (int m = 0; m < 4; ++m) { const int row = u.pm * BM + ai * HALF + wr * 64 + m * 16 + fr; f32x4 v0 = acc[ai][bj][m][0], v1 = acc[ai][bj][m][1];
#pragma unroll
                    for (int j = 0; j < 4; ++j) { v0[j] = 1.0f - sigmoidf_(-(v0[j] + b0[j])); v1[j] = 1.0f - sigmoidf_(-(v1[j] + b1[j])); }
                    __builtin_nontemporal_store(pack8(v0, v1), (u32x4*)(GATE + (size_t)row * 2048 + cb + ct)); } }
    }
};
struct EpiGlu {
    static constexpr bool PERM = true, AFTER_DRAIN = false;
    const bf16_t* VS; bf16_t* YS; const float* bglu;
    __device__ __forceinline__ void operator()(const f32x4 (&acc)[2][2][4][2], const Unit& u, int wr, int wc, int fr, int fq) const {
        const int cb = u.pn * 256;
        f32x4 bb[2][2];
#pragma unroll
        for (int bj = 0; bj < 2; ++bj) { const int ct = bj * HALF + wc * 32 + 8 * fq; bb[bj][0] = *(const f32x4*)(bglu + cb + ct); bb[bj][1] = *(const f32x4*)(bglu + cb + ct + 4); }
#pragma unroll
        for (int ai = 0; ai < 2; ++ai) { u32x4 sv[4][2];
#pragma unroll
            for (int m = 0; m < 4; ++m)
#pragma unroll
                for (int bj = 0; bj < 2; ++bj) sv[m][bj] = *(const u32x4*)(VS + (size_t)(u.pm * BM + ai * HALF + wr * 64 + m * 16 + fr) * 512 + cb + bj * HALF + wc * 32 + 8 * fq);
            asm volatile("s_waitcnt vmcnt(0)" ::: "memory");
#pragma unroll
            for (int m = 0; m < 4; ++m)
#pragma unroll
                for (int bj = 0; bj < 2; ++bj) { const int row = u.pm * BM + ai * HALF + wr * 64 + m * 16 + fr, ct = bj * HALF + wc * 32 + 8 * fq; f32x4 v0 = acc[ai][bj][m][0], v1 = acc[ai][bj][m][1], s0, s1; unpack8(sv[m][bj], s0, s1);
#pragma unroll
                    for (int j = 0; j < 4; ++j) { v0[j] = s0[j] * sigmoidf_(v0[j] + bb[bj][0][j]); v1[j] = s1[j] * sigmoidf_(v1[j] + bb[bj][1][j]); }
                    *(u32x4*)(YS + (size_t)row * 512 + cb + ct) = pack8(v0, v1); } }
    }
};
template <int STEP> struct EpiMerge {
    static constexpr bool PERM = true, AFTER_DRAIN = false;
    const bf16_t* GATE; bf16_t* TMP; bf16_t* MPRE;
    __device__ __forceinline__ void operator()(const f32x4 (&acc)[2][2][4][2], const Unit& u, int wr, int wc, int fr, int fq) const {
        const int cb = u.pn * 256;
#pragma unroll
        for (int ai = 0; ai < 2; ++ai) { u32x4 gv[4][2], tv[4][2];
#pragma unroll
            for (int m = 0; m < 4; ++m)
#pragma unroll
                for (int bj = 0; bj < 2; ++bj) { const size_t row = (size_t)(u.pm * BM + ai * HALF + wr * 64 + m * 16 + fr); const int ct = bj * HALF + wc * 32 + 8 * fq;
                    gv[m][bj] = __builtin_nontemporal_load((const u32x4*)(GATE + row * 2048 + STEP * 1024 + cb + ct)); if (STEP == 1) tv[m][bj] = *(const u32x4*)(TMP + row * 1024 + cb + ct); }
            asm volatile("s_waitcnt vmcnt(0)" ::: "memory");
#pragma unroll
            for (int m = 0; m < 4; ++m)
#pragma unroll
                for (int bj = 0; bj < 2; ++bj) { const size_t row = (size_t)(u.pm * BM + ai * HALF + wr * 64 + m * 16 + fr); const int ct = bj * HALF + wc * 32 + 8 * fq;
                    const f32x4 v0 = acc[ai][bj][m][0], v1 = acc[ai][bj][m][1]; f32x4 g0, g1; unpack8(gv[m][bj], g0, g1);
                    if (STEP == 0) { *(u32x4*)(TMP + row * 1024 + cb + ct) = pack8(g0 * v0, g1 * v1); }
                    else { f32x4 t0, t1; unpack8(tv[m][bj], t0, t1); *(u32x4*)(MPRE + row * 1024 + cb + ct) = pack8(t0 + g0 * v0, t1 + g1 * v1); } } }
    }
};
struct EpiOutSS {
    static constexpr bool PERM = true, AFTER_DRAIN = false;
    bf16_t* O; float* rowss;
    __device__ __forceinline__ void operator()(const f32x4 (&acc)[2][2][4][2], const Unit& u, int wr, int wc, int fr, int fq) const {
        const int cb = u.pn * 256;
#pragma unroll
        for (int ai = 0; ai < 2; ++ai)
#pragma unroll
            for (int m = 0; m < 4; ++m) { const int row = u.pm * BM + ai * HALF + wr * 64 + m * 16 + fr; float ss = 0.f;
#pragma unroll
                for (int bj = 0; bj < 2; ++bj) { const int ct = bj * HALF + wc * 32 + 8 * fq; const f32x4 v0 = acc[ai][bj][m][0], v1 = acc[ai][bj][m][1];
                    ss += (v0[0] * v0[0] + v0[1] * v0[1]) + (v0[2] * v0[2] + v0[3] * v0[3]) + (v1[0] * v1[0] + v1[1] * v1[1]) + (v1[2] * v1[2] + v1[3] * v1[3]);
                    *(u32x4*)(O + (size_t)row * 1024 + cb + ct) = pack8(v0, v1); }
                ss += __shfl_xor(ss, 16); ss += __shfl_xor(ss, 32);
                if (fq == 0) rowss[((size_t)u.pn * MT + row) * 4 + wc] = ss; }
    }
};
struct EpiPlain {
    static constexpr bool PERM = true, AFTER_DRAIN = false;
    bf16_t* O;
    __device__ __forceinline__ void operator()(const f32x4 (&acc)[2][2][4][2], const Unit& u, int wr, int wc, int fr, int fq) const {
        const int cb = u.pn * 256;
        EPI_LOOP_BEGIN *(u32x4*)(O + (size_t)row * 1024 + cb + ct) = pack8(v0, v1); EPI_LOOP_END
    }
};
struct OneUnit { int pm, pn;
    __device__ __forceinline__ bool next(int i, Unit& u) const { if (i) return false; u.pm = pm; u.pn = pn; return true; }
    __device__ __forceinline__ void a_ready(const Unit&) const {}
    __device__ __forceinline__ void done(const Unit&) const {} };
struct EpiFF {
    static constexpr bool PERM = true, AFTER_DRAIN = false;
    bf16_t* HID;
    __device__ __forceinline__ void operator()(const f32x4 (&acc)[2][2][4][2], const Unit& u, int wr, int wc, int fr, int fq) const {
#pragma unroll
        for (int ai = 0; ai < 2; ++ai)
#pragma unroll
            for (int m = 0; m < 4; ++m) { const int row = u.pm * BM + ai * HALF + wr * 64 + m * 16 + fr;
                f32x4 a0 = acc[ai][0][m][0], a1 = acc[ai][0][m][1]; const f32x4 g0 = acc[ai][1][m][0], g1 = acc[ai][1][m][1];
#pragma unroll
                for (int j = 0; j < 4; ++j) { a0[j] = siluf_(a0[j]) * g0[j]; a1[j] = siluf_(a1[j]) * g1[j]; }
                *(u32x4*)(HID + (size_t)row * DFF + u.pn * 128 + wc * 32 + 8 * fq) = pack8(a0, a1); }
    }
};
template <class Epi, class Sched>
__device__ __forceinline__ void gemm_phase(PG8_LAS unsigned char* lds, const Gemm g, const Sched& S, const Epi& E) {
    int tid_ = threadIdx.x; asm volatile("" : "+v"(tid_));
    const int tid = tid_, wid = __builtin_amdgcn_readfirstlane(tid >> 6), lane = tid & 63, wr = wid >> 2, wc = wid & 3, fr = lane & 15, fq = lane >> 4;
    const int K = g.K, nt = K / BK, LD = g.ld ? g.ld : g.K;
    unsigned voffA[2], voffB[2];
#pragma unroll
    for (int i = 0; i < 2; ++i) { int R, C; stage_rc(tid * 16 + i * 8192, R, C); const int Rb = Epi::PERM ? ((R & ~31) + perm32(R & 31)) : R;
        voffA[i] = (unsigned)(R * LD + C) * 2u; voffB[i] = (unsigned)(Rb * LD + C) * 2u; }
    const size_t kstep = (size_t)(BK * 2);
    const size_t hstep = (size_t)HALF * LD * 2;
    const size_t tstep = 2 * hstep;
    const unsigned ldsw = (unsigned)wid * 1024u;
    const int aoff = lds_byte(wr * 64 + fr, fq * 8), boff = lds_byte(wc * 32 + fr, fq * 8);
#define PG8_SA(b, h) (((b) * 2 + (h)) * HTB)
#define PG8_SB(b, h) ((4 + (b) * 2 + (h)) * HTB)
#define PG8_STAGE(bufoff, gbase, voff) do { _Pragma("unroll") for (int _i = 0; _i < 2; ++_i) \
        __builtin_amdgcn_global_load_lds((const unsigned*)((const char*)(gbase) + (voff)[_i]), (PG8_LAS unsigned*)(lds + (bufoff) + ldsw + _i * 8192), 16, 0, 0); } while (0)
#define PG8_LDA(dst, b, h) do { _Pragma("unroll") for (int m = 0; m < 4; ++m) _Pragma("unroll") for (int k = 0; k < 2; ++k) dst[m][k] = *(const PG8_LAS bf16x8*)(lds + PG8_SA(b, h) + aoff + m * 2048 + k * 1024); } while (0)
#define PG8_LDB(dst, b, h) do { _Pragma("unroll") for (int n = 0; n < 2; ++n) _Pragma("unroll") for (int k = 0; k < 2; ++k) dst[n][k] = *(const PG8_LAS bf16x8*)(lds + PG8_SB(b, h) + boff + n * 2048 + k * 1024); } while (0)
#define PG8_MMA(ai, bj, At, Bt) do { __builtin_amdgcn_s_setprio(1); _Pragma("unroll") for (int m = 0; m < 4; ++m) _Pragma("unroll") for (int n = 0; n < 2; ++n) _Pragma("unroll") for (int k = 0; k < 2; ++k) \
        acc[ai][bj][m][n] = __builtin_amdgcn_mfma_f32_16x16x32_bf16(Bt[n][k], At[m][k], acc[ai][bj][m][n], 0, 0, 0); __builtin_amdgcn_s_setprio(0); } while (0)
#define PG8_WAIT_V(n) asm volatile("s_waitcnt vmcnt(" #n ")" ::: "memory")
#define PG8_WAIT_L(n) asm volatile("s_waitcnt lgkmcnt(" #n ")" ::: "memory")
#define PG8_BAR __builtin_amdgcn_s_barrier()
#define PG8_SCHED __builtin_amdgcn_sched_barrier(0)
    Unit cur, nxt; int ui = 0;
    if (!S.next(0, cur)) return;
    f32x4 acc[2][2][4][2];
#pragma unroll
    for (int a = 0; a < 2; ++a)
#pragma unroll
        for (int b = 0; b < 2; ++b)
#pragma unroll
            for (int m = 0; m < 4; ++m)
#pragma unroll
                for (int n = 0; n < 2; ++n) acc[a][b][m][n] = (f32x4){0.f, 0.f, 0.f, 0.f};
    bf16x8 At[4][2], B0[2][2], B1[2][2];
    const char* cA = (const char*)g.A + (size_t)cur.pm * tstep; const char* cB = (const char*)g.Bt + (size_t)cur.pn * tstep;
    S.a_ready(cur);
    PG8_STAGE(PG8_SB(0, 0), cB, voffB); PG8_STAGE(PG8_SA(0, 0), cA, voffA); PG8_STAGE(PG8_SB(0, 1), cB + hstep, voffB); PG8_STAGE(PG8_SA(0, 1), cA + hstep, voffA);
    if (wr == 1) PG8_BAR;
    PG8_WAIT_V(4); PG8_BAR;
    PG8_STAGE(PG8_SB(1, 0), cB + kstep, voffB); PG8_STAGE(PG8_SA(1, 0), cA + kstep, voffA); PG8_STAGE(PG8_SB(1, 1), cB + hstep + kstep, voffB);
    PG8_WAIT_V(6); PG8_BAR;
    for (;;) {
        const bool has_next = S.next(ui + 1, nxt);
        const char* nA = has_next ? (const char*)g.A + (size_t)nxt.pm * tstep : cA; const char* nB = has_next ? (const char*)g.Bt + (size_t)nxt.pn * tstep : cB;
        for (int t = 0; t < nt; t += 2) {
            const bool last = (t == nt - 2);
            const char* a1 = cA + (size_t)(t + 1) * kstep;
            const char* a2 = last ? nA : cA + (size_t)(t + 2) * kstep; const char* b2 = last ? nB : cB + (size_t)(t + 2) * kstep;
            const char* a3 = a2 + kstep; const char* b3 = b2 + kstep;
            if (last && has_next) S.a_ready(nxt);
            PG8_LDB(B0, 0, 0); PG8_SCHED; PG8_LDA(At, 0, 0); PG8_STAGE(PG8_SA(1, 1), a1 + hstep, voffA);
            PG8_WAIT_L(8); PG8_BAR; PG8_WAIT_L(0); PG8_MMA(0, 0, At, B0); PG8_BAR; PG8_SCHED;
            PG8_LDB(B1, 0, 1); PG8_STAGE(PG8_SB(0, 0), b2, voffB);
            PG8_BAR; PG8_WAIT_L(0); PG8_MMA(0, 1, At, B1); PG8_BAR;
            PG8_LDA(At, 0, 1); PG8_STAGE(PG8_SA(0, 0), a2, voffA);
            PG8_BAR; PG8_WAIT_L(0); PG8_MMA(1, 0, At, B0); PG8_BAR; PG8_SCHED;
            PG8_STAGE(PG8_SB(0, 1), b2 + hstep, voffB);
            PG8_WAIT_V(6); PG8_BAR; PG8_MMA(1, 1, At, B1); PG8_BAR;
            PG8_LDB(B0, 1, 0); PG8_SCHED; PG8_LDA(At, 1, 0); PG8_STAGE(PG8_SA(0, 1), a2 + hstep, voffA);
            PG8_WAIT_L(8); PG8_BAR; PG8_WAIT_L(0); PG8_MMA(0, 0, At, B0); PG8_BAR; PG8_SCHED;
            PG8_LDB(B1, 1, 1); PG8_STAGE(PG8_SB(1, 0), b3, voffB);
            PG8_BAR; PG8_WAIT_L(0); PG8_MMA(0, 1, At, B1); PG8_BAR;
            PG8_LDA(At, 1, 1); PG8_STAGE(PG8_SA(1, 0), a3, voffA);
            PG8_BAR; PG8_WAIT_L(0); PG8_MMA(1, 0, At, B0); PG8_BAR; PG8_SCHED;
            PG8_STAGE(PG8_SB(1, 1), b3 + hstep, voffB);
            PG8_WAIT_V(6); PG8_BAR; PG8_MMA(1, 1, At, B1); PG8_BAR;
        }
        if constexpr (!Epi::AFTER_DRAIN) { E(acc, cur, wr, wc, fr, fq); S.done(cur); }
        if (!has_next) break;
#pragma unroll
        for (int a = 0; a < 2; ++a)
#pragma unroll
            for (int b = 0; b < 2; ++b)
#pragma unroll
                for (int m = 0; m < 4; ++m)
#pragma unroll
                    for (int n = 0; n < 2; ++n) acc[a][b][m][n] = (f32x4){0.f, 0.f, 0.f, 0.f};
        cur = nxt; cA = nA; cB = nB; ++ui;
    }
    PG8_WAIT_V(0);
    if (wr == 0) PG8_BAR;
    PG8_BAR;
    if constexpr (Epi::AFTER_DRAIN) { E.fused(acc, cur, wr, wc, fr, fq, lds, wid, lane); S.done(cur); }
#undef PG8_SA
#undef PG8_SB
#undef PG8_STAGE
#undef PG8_LDA
#undef PG8_LDB
#undef PG8_MMA
#undef PG8_WAIT_V
#undef PG8_WAIT_L
#undef PG8_BAR
#undef PG8_SCHED
}
}

__device__ __forceinline__ int ffin_row(int n) { const int half = n >= DFF, j = half ? n - DFF : n; return (j >> 7) * 256 + half * 128 + (j & 127); }
__device__ __forceinline__ void copy_tiles(const Ctx p, LAS unsigned char* lds, int tbeg, int tend, int first, int stride) {
    int tid_ = threadIdx.x; asm volatile("" : "+v"(tid_)); const int tid = tid_;
    unsigned char* ws = p.ws;
    LAS float* tile = (LAS float*)lds;
    const float* src; bf16_t* dst; int K, N, k0, n0; bool perm;
#define TILE_INFO(T) do { int t_ = (T), tk_; \
        if (t_ < 640) { src = PIN(13); K = 1024; N = 2560; dst = (bf16_t*)(ws + WS_W1T); perm = false; } \
        else if (t_ < 1152) { t_ -= 640; src = PIN(33); K = 1024; N = 2048; dst = (bf16_t*)(ws + WS_W1T) + (size_t)2560 * 1024; perm = false; } \
        else if (t_ < 1408) { t_ -= 1152; src = PIN(31); K = 1024; N = 1024; dst = (bf16_t*)(ws + WS_WPL); perm = false; } \
        else if (t_ < 1536) { t_ -= 1408; src = PIN(32); K = 512; N = 1024; dst = (bf16_t*)(ws + WS_WPS); perm = false; } \
        else if (t_ < 1792) { t_ -= 1536; src = PIN(35); K = 1024; N = 1024; dst = (bf16_t*)(ws + WS_WOUT); perm = false; } \
        else if (t_ < 3200) { t_ -= 1792; src = PIN(36); K = 1024; N = 2 * DFF; dst = (bf16_t*)(ws + WS_WFI); perm = true; } \
        else if (t_ < 3904) { t_ -= 3200; src = PIN(37); K = DFF; N = 1024; dst = (bf16_t*)(ws + WS_WFO); perm = false; } \
        else { t_ -= 3904; src = PIN(29); K = 512; N = 512; dst = (bf16_t*)(ws + WS_WGLU); perm = false; } \
        tk_ = K / 64; k0 = (t_ % tk_) * 64; n0 = (t_ / tk_) * 64; } while (0)
    {   const int r = tid >> 4, c4 = tid & 15, n = tid >> 3, kc = tid & 7;
        f32x4 v0, v1; int T = tbeg + first;
        if (T < tend) { TILE_INFO(T); v0 = *(const f32x4*)(src + (size_t)(k0 + r) * N + n0 + 4 * c4); v1 = *(const f32x4*)(src + (size_t)(k0 + r + 32) * N + n0 + 4 * c4); }
        for (; T < tend; T += stride) {
            TILE_INFO(T);
            bf16_t* const cdst = dst; const int cK = K, ck0 = k0, cdrow = perm ? ffin_row(n0 + n) : n0 + n;
            {   LAS float* t = tile + r * 65 + 4 * c4; t[0] = v0[0]; t[1] = v0[1]; t[2] = v0[2]; t[3] = v0[3]; t += 32 * 65; t[0] = v1[0]; t[1] = v1[1]; t[2] = v1[2]; t[3] = v1[3]; }
            __syncthreads();
            if (T + stride < tend) { TILE_INFO(T + stride); v0 = *(const f32x4*)(src + (size_t)(k0 + r) * N + n0 + 4 * c4); v1 = *(const f32x4*)(src + (size_t)(k0 + r + 32) * N + n0 + 4 * c4); }
            {   const LAS float* t = tile + (8 * kc) * 65 + n; u32x4 w;
                w.x = pk2(t[0], t[65]); w.y = pk2(t[130], t[195]); w.z = pk2(t[260], t[325]); w.w = pk2(t[390], t[455]);
                *(u32x4*)(cdst + (size_t)cdrow * cK + ck0 + 8 * kc) = w; }
            __syncthreads();
        }
    }
#undef TILE_INFO
}
__device__ __forceinline__ void p0_prologue(const Ctx p, LAS unsigned char* lds) {
    const int tid = threadIdx.x, G = gridDim.x, bx = blockIdx.x;
    unsigned char* ws = p.ws;
    if (bx >= G - 96) {
        const int item = bx - (G - 96), n0 = item * 64, w = tid >> 6, lane = tid & 63;
        LAS float* sc = (LAS float*)lds;
        LAS float* red = (LAS float*)(lds + 9 * 1024 * 4);
        for (int i = tid; i < 9 * 1024; i += 512) { const int j = i >> 10, k = i & 1023; const float v = j == 0 ? PIN(6)[k] : PIN(2)[(j - 1) * 1024 + k]; sc[i] = siluf_(v); }
        __syncthreads();
        float a[9];
#pragma unroll
        for (int j = 0; j < 9; ++j) a[j] = 0.f;
        const float* wm = PIN(7) + n0 + lane;
#pragma unroll 8
        for (int k = 128 * w; k < 128 * w + 128; ++k) { const float wv = wm[(size_t)k * 6144];
#pragma unroll
            for (int j = 0; j < 9; ++j) a[j] += sc[j * 1024 + k] * wv; }
#pragma unroll
        for (int j = 0; j < 9; ++j) red[(w * 9 + j) * 64 + lane] = a[j];
        __syncthreads();
        for (int i = tid; i < 9 * 64; i += 512) { const int j = i >> 6, l = i & 63; float s = PIN(8)[n0 + l];
#pragma unroll
            for (int ww = 0; ww < 8; ++ww) s += red[(ww * 9 + j) * 64 + l];
            ((float*)(ws + WS_MOD))[j * 6144 + n0 + l] = s; }
        __syncthreads();
    }
    if (bx < G - 96) { copy_tiles(p, lds, 0, 1792, bx, G - 96); copy_tiles(p, lds, 3904, 3968, bx, G - 96); }
}

#define ROW_SS(v) ((v[0][0] * v[0][0] + v[0][1] * v[0][1]) + (v[0][2] * v[0][2] + v[0][3] * v[0][3]) + (v[1][0] * v[1][0] + v[1][1] * v[1][1]) + (v[1][2] * v[1][2] + v[1][3] * v[1][3]) + \
                   (v[2][0] * v[2][0] + v[2][1] * v[2][1]) + (v[2][2] * v[2][2] + v[2][3] * v[2][3]) + (v[3][0] * v[3][0] + v[3][1] * v[3][1]) + (v[3][2] * v[3][2] + v[3][3] * v[3][3]))
__device__ __forceinline__ float wave_sum(float x) {
#pragma unroll
    for (int o = 1; o < 64; o <<= 1) x += __shfl_xor(x, o);
    return x; }
__device__ __forceinline__ f32x4 bf4(const u32x2 w) { return (f32x4){bf_lo(w.x), bf_hi(w.x), bf_lo(w.y), bf_hi(w.y)}; }
__device__ __forceinline__ void p1_hn(const Ctx p) {
    int tid_ = threadIdx.x; asm volatile("" : "+v"(tid_)); const int tid = tid_, w = tid >> 6, lane = tid & 63, r0 = blockIdx.x * 160 + w * 20;
    bf16_t* HN = (bf16_t*)(p.ws + WS_HN);
    f32x4 gs[4], sh[4]; int cur = -1;
    for (int it = 0; it < 10; ++it) { const int r = r0 + 2 * it, mi = mod_index(r);
        if (mi != cur) { cur = mi; const float* mod = (const float*)(p.ws + WS_MOD) + mi * 6144;
#pragma unroll
            for (int j = 0; j < 4; ++j) { const int c = 4 * lane + 256 * j; gs[j] = *(const f32x4*)(PIN(9) + c) * (*(const f32x4*)(mod + 1024 + c) + 1.0f); sh[j] = *(const f32x4*)(mod + c); } }
        const float* xa = xrow(p, r); const float* xb = xrow(p, r + 1); f32x4 va[4], vb[4];
#pragma unroll
        for (int j = 0; j < 4; ++j) { va[j] = __builtin_nontemporal_load((const f32x4*)(xa + 4 * lane + 256 * j)); vb[j] = __builtin_nontemporal_load((const f32x4*)(xb + 4 * lane + 256 * j)); }
        const float ra = __builtin_amdgcn_rsqf(wave_sum(ROW_SS(va)) * (1.0f / 1024.0f) + EPS), rb = __builtin_amdgcn_rsqf(wave_sum(ROW_SS(vb)) * (1.0f / 1024.0f) + EPS);
#pragma unroll
        for (int j = 0; j < 4; ++j) { const f32x4 ya = va[j] * ra * gs[j] + sh[j], yb = vb[j] * rb * gs[j] + sh[j]; u32x2 oa, ob; oa.x = pk2(ya[0], ya[1]); oa.y = pk2(ya[2], ya[3]); ob.x = pk2(yb[0], yb[1]); ob.y = pk2(yb[2], yb[3]);
            *(u32x2*)(HN + (size_t)r * 1024 + 4 * lane + 256 * j) = oa; *(u32x2*)(HN + (size_t)(r + 1) * 1024 + 4 * lane + 256 * j) = ob; }
    }
}
__device__ __forceinline__ float row_rs(const float* ssp, int r, int lane) { float q = ssp[((size_t)((lane >> 2) & 3) * MT + r) * 4 + (lane & 3)]; q += __shfl_xor(q, 1); q += __shfl_xor(q, 2); q += __shfl_xor(q, 4); q += __shfl_xor(q, 8);
    return __builtin_amdgcn_rsqf(q * (1.0f / 1024.0f) + EPS); }
__device__ __forceinline__ void p7_x1(const Ctx p) {
    int tid_ = threadIdx.x; asm volatile("" : "+v"(tid_)); const int tid = tid_, w = tid >> 6, lane = tid & 63, r0 = blockIdx.x * 160 + w * 20;
    const bf16_t* MO = (const bf16_t*)(p.ws + WS_MO); bf16_t* HN2 = (bf16_t*)(p.ws + WS_HN2); const float* ss1 = (const float*)(p.ws + WS_SSP1);
    f32x4 gg[4], gs[4], sh[4]; int cur = -1;
    for (int it = 0; it < 10; ++it) { const int r = r0 + 2 * it, mi = mod_index(r);
        if (mi != cur) { cur = mi; const float* mod = (const float*)(p.ws + WS_MOD) + mi * 6144;
#pragma unroll
            for (int j = 0; j < 4; ++j) { const int c = 4 * lane + 256 * j; gg[j] = *(const f32x4*)(mod + 2048 + c) * *(const f32x4*)(PIN(10) + c);
                gs[j] = *(const f32x4*)(PIN(11) + c) * (*(const f32x4*)(mod + 4096 + c) + 1.0f); sh[j] = *(const f32x4*)(mod + 3072 + c); } }
        const float* xa = xrow(p, r); const float* xb = xrow(p, r + 1); f32x4 va[4], vb[4]; u32x2 ma[4], mb[4];
#pragma unroll
        for (int j = 0; j < 4; ++j) { const int c = 4 * lane + 256 * j; va[j] = __builtin_nontemporal_load((const f32x4*)(xa + c)); vb[j] = __builtin_nontemporal_load((const f32x4*)(xb + c)); ma[j] = *(const u32x2*)(MO + (size_t)r * 1024 + c); mb[j] = *(const u32x2*)(MO + (size_t)(r + 1) * 1024 + c); }
        const float sa = row_rs(ss1, r, lane), sb = row_rs(ss1, r + 1, lane);
#pragma unroll
        for (int j = 0; j < 4; ++j) { const int c = 4 * lane + 256 * j; va[j] = va[j] + gg[j] * bf4(ma[j]) * sa; vb[j] = vb[j] + gg[j] * bf4(mb[j]) * sb;
            __builtin_nontemporal_store(va[j], (f32x4*)(p.out + (size_t)r * 1024 + c)); __builtin_nontemporal_store(vb[j], (f32x4*)(p.out + (size_t)(r + 1) * 1024 + c)); }
        const float ra = __builtin_amdgcn_rsqf(wave_sum(ROW_SS(va)) * (1.0f / 1024.0f) + EPS), rb = __builtin_amdgcn_rsqf(wave_sum(ROW_SS(vb)) * (1.0f / 1024.0f) + EPS);
#pragma unroll
        for (int j = 0; j < 4; ++j) { const f32x4 ya = va[j] * ra * gs[j] + sh[j], yb = vb[j] * rb * gs[j] + sh[j]; u32x2 oa, ob; oa.x = pk2(ya[0], ya[1]); oa.y = pk2(ya[2], ya[3]); ob.x = pk2(yb[0], yb[1]); ob.y = pk2(yb[2], yb[3]);
            *(u32x2*)(HN2 + (size_t)r * 1024 + 4 * lane + 256 * j) = oa; *(u32x2*)(HN2 + (size_t)(r + 1) * 1024 + 4 * lane + 256 * j) = ob; }
    }
}
__device__ __forceinline__ void p10_out(const Ctx p) {
    int tid_ = threadIdx.x; asm volatile("" : "+v"(tid_)); const int tid = tid_, w = tid >> 6, lane = tid & 63, r0 = blockIdx.x * 160 + w * 20;
    const bf16_t* FO = (const bf16_t*)(p.ws + WS_FO); const bf16_t* FOB = (const bf16_t*)(p.ws + WS_FOB);
    f32x4 gg[4]; int cur = -1;
    for (int it = 0; it < 10; ++it) { const int r = r0 + 2 * it, mi = mod_index(r); const bool split = r >= 128 * 256;
        if (mi != cur) { cur = mi; const float* mod = (const float*)(p.ws + WS_MOD) + mi * 6144;
#pragma unroll
            for (int j = 0; j < 4; ++j) { const int c = 4 * lane + 256 * j; gg[j] = *(const f32x4*)(mod + 5120 + c) * *(const f32x4*)(PIN(12) + c); } }
        f32x4 va[4], vb[4], fa[4], fb[4];
#pragma unroll
        for (int j = 0; j < 4; ++j) { const int c = 4 * lane + 256 * j; va[j] = __builtin_nontemporal_load((const f32x4*)(p.out + (size_t)r * 1024 + c)); vb[j] = __builtin_nontemporal_load((const f32x4*)(p.out + (size_t)(r + 1) * 1024 + c));
            fa[j] = bf4(*(const u32x2*)(FO + (size_t)r * 1024 + c)); fb[j] = bf4(*(const u32x2*)(FO + (size_t)(r + 1) * 1024 + c));
            if (split) { fa[j] = fa[j] + bf4(*(const u32x2*)(FOB + (size_t)r * 1024 + c)); fb[j] = fb[j] + bf4(*(const u32x2*)(FOB + (size_t)(r + 1) * 1024 + c)); } }
        const float sa = __builtin_amdgcn_rsqf(wave_sum(ROW_SS(fa)) * (1.0f / 1024.0f) + EPS), sb = __builtin_amdgcn_rsqf(wave_sum(ROW_SS(fb)) * (1.0f / 1024.0f) + EPS);
#pragma unroll
        for (int j = 0; j < 4; ++j) { const int c = 4 * lane + 256 * j; __builtin_nontemporal_store(va[j] + gg[j] * fa[j] * sa, (f32x4*)(p.out + (size_t)r * 1024 + c)); __builtin_nontemporal_store(vb[j] + gg[j] * fb[j] * sb, (f32x4*)(p.out + (size_t)(r + 1) * 1024 + c)); }
    }
}

constexpr int LRU_U16 = 0, LRU_UB = 9216, LRU_AA = LRU_UB + 17408, LRU_AGG = LRU_AA + 17408, LRU_CAR = LRU_AGG + 2048, LRU_HALF = 46592;
__device__ __forceinline__ void lru_unit(const Ctx p, LAS unsigned char* lds, int sample, int b, int hd) {
    int tid_ = threadIdx.x; asm volatile("" : "+v"(tid_)); const int tid = tid_, d = tid >> 8, ht = tid & 255, hw = ht >> 6, lane = tid & 63;
    const int T = sample ? T_S : T_CTX, row0 = sample ? MC + b * T_S : b * T_CTX, nch = T / 64;
    LAS unsigned char* L = lds + d * LRU_HALF;
    LAS bf16_t* U16 = (LAS bf16_t*)(L + LRU_U16); LAS float* UB = (LAS float*)(L + LRU_UB); LAS float* AA = (LAS float*)(L + LRU_AA);
    LAS f32x2* AGG = (LAS f32x2*)(L + LRU_AGG); LAS float* CAR = (LAS float*)(L + LRU_CAR);
    const bf16_t* XA = (const bf16_t*)(p.ws + WS_XA); const bf16_t* GA = (const bf16_t*)(p.ws + WS_GA); bf16_t* YA = (bf16_t*)(p.ws + WS_YA);
    const int fj = lane & 15, fq = lane >> 4, chg = hd * 64 + 16 * hw + fj;
    bf16x8 wrf[2], wif[2];
    {   const float* wr = PIN(16) + (size_t)(d * 16 + hd) * 4096 + 16 * hw + fj; const float* wi = PIN(18) + (size_t)(d * 16 + hd) * 4096 + 16 * hw + fj;
#pragma unroll
        for (int s = 0; s < 2; ++s)
#pragma unroll
            for (int e = 0; e < 8; ++e) { const int k = 32 * s + 8 * fq + e; wrf[s][e] = (short)f2bf(wr[k * 64]); wif[s][e] = (short)f2bf(wi[k * 64]); } }
    const float br = PIN(17)[d * 1024 + chg], bi = PIN(19)[d * 1024 + chg];
    const float sp8 = -8.0f * 1.44269504089f * log1pf(__expf(-PIN(20)[d * 1024 + chg]));
    const int cp = ht & 31, tg = ht >> 5, cc0 = hd * 64 + 2 * cp;
    float cw0[4], cw1[4];
#pragma unroll
    for (int j = 0; j < 4; ++j) { cw0[j] = PIN(14)[j * 1024 + cc0]; cw1[j] = PIN(14)[j * 1024 + cc0 + 1]; }
    const float cb0 = PIN(15)[cc0], cb1 = PIN(15)[cc0 + 1];
    const int chs = hd * 64 + lane;
    if (ht < 64) CAR[lane] = sample ? PIN(3)[(size_t)(b * 2 + d) * 1024 + chs] : 0.f;
    float hfin = 0.f;
    __syncthreads();
    unsigned xw[11];
#define LRU_LOADX(kk) do { const int c_ = d ? nch - 1 - (kk) : (kk); _Pragma("unroll") for (int i = 0; i < 11; ++i) { const int t = 64 * c_ + 8 * tg - 2 + i; unsigned w = 0u; if (t >= 0 && t < T) w = *(const unsigned*)(XA + (size_t)(row0 + t) * 1024 + cc0); xw[i] = w; } } while (0)
    LRU_LOADX(0);
    for (int k = 0; k < nch; ++k) {
        const int c = d ? nch - 1 - k : k, t0 = 64 * c; const bool second = (2 * k >= nch);
        {   float x0[11], x1[11];
#pragma unroll
            for (int i = 0; i < 11; ++i) { x0[i] = bf_lo(xw[i]); x1[i] = bf_hi(xw[i]); }
#pragma unroll
            for (int i = 0; i < 8; ++i) { const float u0 = cb0 + cw0[0] * x0[i] + cw0[1] * x0[i + 1] + cw0[2] * x0[i + 2] + cw0[3] * x0[i + 3];
                const float u1 = cb1 + cw1[0] * x1[i] + cw1[1] * x1[i + 1] + cw1[2] * x1[i + 2] + cw1[3] * x1[i + 3]; const int tl = 8 * tg + i;
                *(LAS unsigned*)(U16 + tl * 72 + 2 * cp) = pk2(u0, u1); *(LAS f32x2*)(UB + tl * 68 + 2 * cp) = (f32x2){u0, u1}; } }
        if (k + 1 < nch) LRU_LOADX(k + 1);
        unsigned short hf16[16], g16[16];
        if (second) {
#pragma unroll
            for (int i = 0; i < 16; ++i) { const int pi = 16 * hw + i, tl = d ? 63 - pi : pi; const size_t ix = (size_t)(row0 + t0 + tl) * 1024 + chs; hf16[i] = YA[ix]; g16[i] = GA[ix]; } }
        __syncthreads();
        {   f32x4 ar[4], ai[4];
#pragma unroll
            for (int m = 0; m < 4; ++m) { ar[m] = (f32x4){0.f, 0.f, 0.f, 0.f}; ai[m] = ar[m];
#pragma unroll
                for (int s = 0; s < 2; ++s) { const bf16x8 a = *(const LAS bf16x8*)(U16 + (16 * m + fj) * 72 + 32 * s + 8 * fq);
                    ar[m] = __builtin_amdgcn_mfma_f32_16x16x32_bf16(a, wrf[s], ar[m], 0, 0, 0); ai[m] = __builtin_amdgcn_mfma_f32_16x16x32_bf16(a, wif[s], ai[m], 0, 0, 0); } }
#pragma unroll
            for (int m = 0; m < 4; ++m)
#pragma unroll
                for (int r4 = 0; r4 < 4; ++r4) { const int tok = 16 * m + 4 * fq + r4, ix = tok * 68 + 16 * hw + fj;
                    const float rg = sigmoidf_(ar[m][r4] + br), a = __builtin_amdgcn_exp2f(sp8 * rg);
                    const float ei = 1.0f + __builtin_amdgcn_exp2f(-1.44269504089f * (ai[m][r4] + bi)), om = fmaxf(1.0f - a * a, 1e-30f);
                    const float bb = om * __builtin_amdgcn_rsqf(om * ei * ei) * UB[ix]; AA[ix] = a; UB[ix] = bb; } }
        __syncthreads();
        float av[16], bv[16]; float P = 1.f, h = 0.f;
#pragma unroll
        for (int i = 0; i < 16; ++i) { const int pi = 16 * hw + i, tl = d ? 63 - pi : pi; av[i] = AA[tl * 68 + lane]; bv[i] = UB[tl * 68 + lane]; h = av[i] * h + bv[i]; P *= av[i]; }
        AGG[hw * 64 + lane] = (f32x2){P, h};
        __syncthreads();
        h = CAR[(k & 1) * 64 + lane];
        for (int s2 = 0; s2 < hw; ++s2) { const f32x2 ag = AGG[s2 * 64 + lane]; h = ag.x * h + ag.y; }
#pragma unroll
        for (int i = 0; i < 16; ++i) { const int pi = 16 * hw + i, tl = d ? 63 - pi : pi; const size_t ix = (size_t)(row0 + t0 + tl) * 1024 + chs; h = av[i] * h + bv[i];
            YA[ix] = f2bf1(second ? bf2f(g16[i]) * (bf2f(hf16[i]) + h) : h); }
        if (hw == 3) { CAR[((k + 1) & 1) * 64 + lane] = h; hfin = h; }
        if (2 * k + 2 == nch) asm volatile("s_waitcnt vmcnt(0)" ::: "memory");
        __syncthreads();
    }
#undef LRU_LOADX
    if (!sample && hw == 3) p.out[OFF_LRU + (size_t)(b * 2 + d) * 1024 + chs] = hfin;
}

__device__ __forceinline__ void sincos_f(float x, float& s, float& c) {
    const float jf = rintf(x * 0.636619772f); const int j = (int)jf;
    float r = x - jf * 1.5703125f; r -= jf * 4.837512969970703125e-4f; r -= jf * 7.54978995489188216e-8f;
    const float z = r * r;
    const float sp = r + r * z * (-1.6666654611e-1f + z * (8.3321608736e-3f + z * (-1.9515295891e-4f)));
    const float cp = 1.0f - 0.5f * z + z * z * (4.166664568298827e-2f + z * (-1.388731625493765e-3f + z * 2.443315711809948e-5f));
    const int q = j & 3;
    s = (q == 0) ? sp : (q == 1) ? cp : (q == 2) ? -sp : -cp;
    c = (q == 0) ? cp : (q == 1) ? -sp : (q == 2) ? -cp : sp;
}
__device__ __forceinline__ void s5_disc(const Ctx p, int d, int g, int ps, float& abr, float& abi, float& fre, float& fim) {
    const float lr = PIN(21)[(d * 32 + g) * 64 + ps], li = PIN(22)[(d * 32 + g) * 64 + ps], dt = __expf(PIN(23)[d * 32 + g]);
    const float mag = __expf(lr * dt); float sn, cs; sincos_f(li * dt, sn, cs);
    abr = mag * cs; abi = mag * sn;
    const float den = lr * lr + li * li, nr = abr - 1.0f, ni = abi;
    fre = (nr * lr + ni * li) / den; fim = (ni * lr - nr * li) / den;
}
constexpr int S5_HS_STRIDE = 272, S5_HS_WAVE = 32 * S5_HS_STRIDE;
__device__ __forceinline__ void s5_item(const Ctx p, LAS unsigned char* lds, int sample, int b, int g0) {
    int tid_ = threadIdx.x; asm volatile("" : "+v"(tid_)); const int tid = tid_, w = tid >> 6, lane = tid & 63, d = w & 1, g = g0 + (w >> 1);
    const int T = sample ? T_S : T_CTX, row0 = sample ? MC + b * T_S : b * T_CTX, nch = T / 32;
    LAS unsigned char* Hs = lds + w * S5_HS_WAVE;
    const bf16_t* XS = (const bf16_t*)(p.ws + WS_XS); bf16_t* VS = (bf16_t*)(p.ws + WS_VS);
    const int j31 = lane & 31, hi = lane >> 5;
    float abr1, abi1, fr1, fi1, abr2, abi2, fr2, fi2;
    s5_disc(p, d, g, j31, abr1, abi1, fr1, fi1); s5_disc(p, d, g, 32 + j31, abr2, abi2, fr2, fi2);
    const float abr = hi ? abr2 : abr1, abi = hi ? abi2 : abi1;
    bf16x8 bfr[4];
#pragma unroll
    for (int st = 0; st < 2; ++st) { const int ps = 32 * st + j31; const float fr = st ? fr2 : fr1, fi = st ? fi2 : fi1;
        const float* bre = PIN(24) + ((size_t)(d * 32 + g) * 64 + ps) * 16 + 8 * hi; const float* bim = PIN(25) + ((size_t)(d * 32 + g) * 64 + ps) * 16 + 8 * hi;
#pragma unroll
        for (int e = 0; e < 8; ++e) { const float vr = bre[e], vi = bim[e]; bfr[2 * st][e] = (short)f2bf(fr * vr - fi * vi); bfr[2 * st + 1][e] = (short)f2bf(fr * vi + fi * vr); } }
    const int fh = lane & 15, kq = lane >> 4;
    bf16x8 cfr[4];
#pragma unroll
    for (int ks = 0; ks < 4; ++ks)
#pragma unroll
        for (int e = 0; e < 8; ++e) { const int pp = 16 * ks + 4 * kq + (e >> 1); const size_t ix = ((size_t)(d * 32 + g) * 16 + fh) * 64 + pp;
            cfr[ks][e] = (short)f2bf((e & 1) ? -PIN(27)[ix] : PIN(26)[ix]); }
    const float dsk = PIN(28)[g * 16 + fh];
    const float one = __builtin_fmaf(dsk, 0.f, 1.0f);
    float hr = 0.f, hi_ = 0.f;
    if (sample) { const size_t ix = ((size_t)(b * 2 + d) * 32 + g) * 64 + lane; hr = PIN(4)[ix]; hi_ = PIN(5)[ix]; }
    const int step = (d ? -1 : 1) * (sample ? 64 : 1);
    const int ua_off = step * 512 * j31 + g * 16 + 8 * hi;
    int eoff[8];
#pragma unroll
    for (int e = 0; e < 8; ++e) eoff[e] = step * 512 * (16 * (e >> 2) + 4 * kq + (e & 3)) + g * 16 + fh;
#define S5_CBASE(kk) ({ const int s0_ = d ? T - 1 - 32 * (kk) : 32 * (kk); const int t0_ = sample ? ((s0_ & 63) * 64 + (s0_ >> 6)) : s0_; (size_t)(row0 + t0_) * 512; })
    bf16x8 ua_next = *(const bf16x8*)(XS + S5_CBASE(0) + ua_off);
    for (int k = 0; k < nch; ++k) {
        const bool second = (2 * k >= nch);
        const size_t cbase = S5_CBASE(k);
        const bf16x8 ua = ua_next;
        if (k + 1 < nch) ua_next = *(const bf16x8*)(XS + S5_CBASE(k + 1) + ua_off);
        unsigned short vf16[8], xs16[8];
        if (second) {
#pragma unroll
            for (int mt = 0; mt < 2; ++mt)
#pragma unroll
                for (int r4 = 0; r4 < 4; ++r4) { const size_t ix = cbase + eoff[mt * 4 + r4]; vf16[mt * 4 + r4] = VS[ix]; xs16[mt * 4 + r4] = XS[ix]; } }
        f32x16 acc[4];
#pragma unroll
        for (int nt = 0; nt < 4; ++nt) { f32x16 z;
#pragma unroll
            for (int v = 0; v < 16; ++v) z[v] = 0.f;
            acc[nt] = __builtin_amdgcn_mfma_f32_32x32x16_bf16(ua, bfr[nt], z, 0, 0, 0); }
        float bur[32], bui[32];
#pragma unroll
        for (int v = 0; v < 16; ++v) {
            unsigned r0 = __builtin_bit_cast(unsigned, acc[0][v] * one), r1 = __builtin_bit_cast(unsigned, acc[2][v] * one);
            unsigned q0 = __builtin_bit_cast(unsigned, acc[1][v] * one), q1 = __builtin_bit_cast(unsigned, acc[3][v] * one);
            asm volatile("s_nop 1\n\tv_permlane32_swap_b32 %0, %1" : "+v"(r0), "+v"(r1));
            asm volatile("s_nop 1\n\tv_permlane32_swap_b32 %0, %1" : "+v"(q0), "+v"(q1));
            const int ta = 8 * (v >> 2) + (v & 3);
            bur[ta] = __builtin_bit_cast(float, r0); bur[ta + 4] = __builtin_bit_cast(float, r1);
            bui[ta] = __builtin_bit_cast(float, q0); bui[ta + 4] = __builtin_bit_cast(float, q1); }
#pragma unroll
        for (int tt = 0; tt < 32; ++tt) { const float nr = abr * hr - abi * hi_ + bur[tt], ni = abr * hi_ + abi * hr + bui[tt]; hr = nr; hi_ = ni;
            *(LAS unsigned*)(Hs + tt * S5_HS_STRIDE + 4 * lane) = pk2(hr, hi_); }
        f32x4 ya[2];
#pragma unroll
        for (int mt = 0; mt < 2; ++mt) { ya[mt] = (f32x4){0.f, 0.f, 0.f, 0.f};
#pragma unroll
            for (int ks = 0; ks < 4; ++ks) { const bf16x8 a = *(const LAS bf16x8*)(Hs + (16 * mt + fh) * S5_HS_STRIDE + (32 * ks + 8 * kq) * 2);
                ya[mt] = __builtin_amdgcn_mfma_f32_16x16x32_bf16(a, cfr[ks], ya[mt], 0, 0, 0); } }
#pragma unroll
        for (int mt = 0; mt < 2; ++mt)
#pragma unroll
            for (int r4 = 0; r4 < 4; ++r4) { const size_t ix = cbase + eoff[mt * 4 + r4]; float y = ya[mt][r4];
                if (second) { y = gelu_tanh(y + bf2f(vf16[mt * 4 + r4]) + dsk * bf2f(xs16[mt * 4 + r4])); }
                VS[ix] = f2bf1(y); }
        if (2 * k + 2 == nch) { asm volatile("s_waitcnt vmcnt(0)" ::: "memory"); __syncthreads(); }
    }
#undef S5_CBASE
    if (!sample) { const size_t ix = ((size_t)(b * 2 + d) * 32 + g) * 64 + lane; p.out[OFF_RE + ix] = hr; p.out[OFF_IM + ix] = hi_; }
}
__device__ __forceinline__ void p3_scans(const Ctx p, LAS unsigned char* lds) {
    const int bx = blockIdx.x;
    if (bx < 128) { lru_unit(p, lds, 1, bx >> 4, bx & 15); }
    else if (bx < 192) { const int i = bx - 128; s5_item(p, lds, 1, i >> 3, 4 * (i & 7)); }
    else { const int i = bx - 192;
        for (int e = 0; e < 8; ++e) { const int c = 8 * i + e; lru_unit(p, lds, 0, c >> 4, c & 15); __syncthreads(); }
        for (int e = 0; e < 4; ++e) { const int c = 4 * i + e; s5_item(p, lds, 0, c >> 3, 4 * (c & 7)); __syncthreads(); } }
}

#define XB_TMO      128
#define XB_XCNT(j)  (256  + 64 * (j))
#define XB_XSUB(j)  (1280 + 64 * (j))
#define XB_XGEN(j)  (2304 + 64 * (j))
#define XB_TOP      3328
#define XB_TOPGEN   3392
#define XCD_BAR_WORDS 3456
#define XB_SPIN_CAP (1u << 18)

__device__ __forceinline__ unsigned xb_ld(unsigned* p)              { return __hip_atomic_load(p, __ATOMIC_RELAXED, __HIP_MEMORY_SCOPE_AGENT); }
__device__ __forceinline__ unsigned xb_add(unsigned* p, unsigned v) { return __hip_atomic_fetch_add(p, v, __ATOMIC_RELAXED, __HIP_MEMORY_SCOPE_AGENT); }
__device__ __forceinline__ unsigned xb_xcc_id() { return (unsigned)__builtin_amdgcn_s_getreg((3 << 11) | 20) & 0xFu; }
#define XB_SPIN(cond, bar) do { unsigned _sp = 0; while (cond) { __builtin_amdgcn_s_sleep(1); \
    if ((++_sp & 255u) == 0u) { if (xb_ld(&(bar)[XB_TMO])) break; if (_sp > XB_SPIN_CAP) { atomicAdd(&(bar)[XB_TMO], 1u); break; } } } } while (0)

struct XcdBarrier {
    unsigned* bar; unsigned x;
    volatile LAS unsigned* st;
};

__device__ __forceinline__ XcdBarrier xcd_barrier_post(unsigned* bar, volatile LAS unsigned* st) {
    XcdBarrier b; b.bar = bar; b.x = xb_xcc_id(); b.st = st;
    if (threadIdx.x == 0) (void)xb_add(&bar[XB_XCNT(b.x)], 1u);
    return b;
}
__device__ __forceinline__ void xcd_barrier_complete(unsigned* bar, unsigned x, unsigned& nloc, unsigned& nx) {
    const unsigned G = gridDim.x * gridDim.y * gridDim.z;
    unsigned sum, cnt, mine, sp = 0u;
    for (;;) {
        sum = 0u; cnt = 0u; mine = 0u;
#pragma unroll
        for (unsigned j = 0; j < 16; ++j) { const unsigned c = xb_ld(&bar[XB_XCNT(j)]); sum += c; cnt += (c > 0u) ? 1u : 0u; mine = (j == x) ? c : mine; }
        if (sum == G) break;
        __builtin_amdgcn_s_sleep(1);
        if ((++sp & 255u) == 0u) { if (xb_ld(&bar[XB_TMO])) break; if (sp > XB_SPIN_CAP) { atomicAdd(&bar[XB_TMO], 1u); break; } }
    }
    nloc = mine > 0u ? mine : 1u; nx = cnt > 0u ? cnt : 1u;
}

__device__ __forceinline__ void xcd_barrier(const XcdBarrier& b) {
    asm volatile("s_waitcnt vmcnt(0)" ::: "memory");
    __syncthreads();
    if (threadIdx.x == 0) {
        unsigned* bar = b.bar;
        __builtin_amdgcn_s_waitcnt(0);
        unsigned nloc = b.st[0], nx = b.st[1];
        if (nloc == 0u) { xcd_barrier_complete(bar, b.x, nloc, nx); b.st[0] = nloc; b.st[1] = nx; }
        const unsigned old = xb_add(&bar[XB_XSUB(b.x)], 1u);
        const unsigned gen = old / nloc;
        if (old + 1u == (gen + 1u) * nloc) {
            __builtin_amdgcn_fence(__ATOMIC_RELEASE, "agent");
            asm volatile("s_waitcnt vmcnt(0)" ::: "memory");
            const unsigned og = xb_add(&bar[XB_TOP], 1u);
            const unsigned tg = og / nx;
            if (og + 1u == (tg + 1u) * nx) xb_add(&bar[XB_TOPGEN], 1u);
            else XB_SPIN(xb_ld(&bar[XB_TOPGEN]) == tg, bar);
            __builtin_amdgcn_fence(__ATOMIC_ACQUIRE, "agent");
            xb_add(&bar[XB_XGEN(b.x)], 1u);
            asm volatile("s_waitcnt vmcnt(0)" ::: "memory");
        } else {
            XB_SPIN(xb_ld(&bar[XB_XGEN(b.x)]) == gen, bar);
            __builtin_amdgcn_fence(__ATOMIC_ACQUIRE, "agent");
            asm volatile("s_waitcnt vmcnt(0)" ::: "memory");
        }
    }
    __syncthreads();
}

#define GRID_SYNC() do { asm volatile("s_waitcnt vmcnt(0)" ::: "memory"); grid.sync(); if (threadIdx.x < 64) { __builtin_amdgcn_fence(__ATOMIC_ACQUIRE, "agent"); asm volatile("s_waitcnt vmcnt(0)" ::: "memory"); } __syncthreads(); } while (0)
__global__ void __launch_bounds__(512, 2) fwd_mega(Params kp) {
    extern __shared__ __attribute__((aligned(16))) unsigned char lds_raw[];
    LAS unsigned char* lds = (LAS unsigned char*)lds_raw;
    {   LAS unsigned long long* t_ = (LAS unsigned long long*)(lds + LDS_BYTES - 512);
        if (threadIdx.x == 0) { t_[0] = (unsigned long long)kp.in[0]; t_[1] = (unsigned long long)kp.in[1]; t_[2] = (unsigned long long)kp.in[2]; t_[3] = (unsigned long long)kp.in[3]; t_[4] = (unsigned long long)kp.in[4]; t_[5] = (unsigned long long)kp.in[5]; t_[6] = (unsigned long long)kp.in[6]; t_[7] = (unsigned long long)kp.in[7]; t_[8] = (unsigned long long)kp.in[8]; t_[9] = (unsigned long long)kp.in[9]; t_[10] = (unsigned long long)kp.in[10]; t_[11] = (unsigned long long)kp.in[11]; t_[12] = (unsigned long long)kp.in[12]; t_[13] = (unsigned long long)kp.in[13]; t_[14] = (unsigned long long)kp.in[14]; t_[15] = (unsigned long long)kp.in[15]; t_[16] = (unsigned long long)kp.in[16]; t_[17] = (unsigned long long)kp.in[17]; t_[18] = (unsigned long long)kp.in[18]; t_[19] = (unsigned long long)kp.in[19]; t_[20] = (unsigned long long)kp.in[20]; t_[21] = (unsigned long long)kp.in[21]; t_[22] = (unsigned long long)kp.in[22]; t_[23] = (unsigned long long)kp.in[23]; t_[24] = (unsigned long long)kp.in[24]; t_[25] = (unsigned long long)kp.in[25]; t_[26] = (unsigned long long)kp.in[26]; t_[27] = (unsigned long long)kp.in[27]; t_[28] = (unsigned long long)kp.in[28]; t_[29] = (unsigned long long)kp.in[29]; t_[30] = (unsigned long long)kp.in[30]; t_[31] = (unsigned long long)kp.in[31]; t_[32] = (unsigned long long)kp.in[32]; t_[33] = (unsigned long long)kp.in[33]; t_[34] = (unsigned long long)kp.in[34]; t_[35] = (unsigned long long)kp.in[35]; t_[36] = (unsigned long long)kp.in[36]; t_[37] = (unsigned long long)kp.in[37]; }
        __syncthreads(); }
    Ctx p; p.tbl = (const LAS unsigned long long*)(lds + LDS_BYTES - 512); p.out = kp.out; p.ws = kp.ws;
    cg::grid_group grid = cg::this_grid();
    unsigned char* ws = p.ws; const int G = gridDim.x, bx = blockIdx.x;
    bf16_t* GATE = (bf16_t*)p.out;
    volatile LAS unsigned* xst = (volatile LAS unsigned*)(lds + LDS_BYTES - 512 - 16);
    if (threadIdx.x < 4) xst[threadIdx.x] = 0u;
    __syncthreads();
    const XcdBarrier xb = xcd_barrier_post((unsigned*)(ws + 768 * 1024), xst);
#define GRID_BAR() xcd_barrier(xb)
    p0_prologue(p, lds);
    if (G == 0x7fffffff) GRID_SYNC();
    GRID_BAR();
    p1_hn(p);
    GRID_BAR();
    {   pg8::Gemm g{(const bf16_t*)(ws + WS_HN), (const bf16_t*)(ws + WS_W1T), MT, 2560, 1024}; pg8::StaticOrder S; S.init(MT, 2560, G, bx);
        pg8::Epi1 E{(bf16_t*)(ws + WS_XA), (bf16_t*)(ws + WS_GA), (bf16_t*)(ws + WS_XS)};
        pg8::gemm_phase<pg8::Epi1, pg8::StaticOrder>(lds, g, S, E);
        pg8::Gemm g2{(const bf16_t*)(ws + WS_HN), (const bf16_t*)(ws + WS_W1T) + (size_t)2560 * 1024, MT, 2048, 1024}; pg8::ListOrder S2; S2.init(MT, 2048, G, bx); S2.base = bx; S2.stride = 256; S2.count = 3; S2.extra = bx >= 64 ? 768 + (bx - 64) : -1;
        pg8::EpiGate E2{GATE, PIN(34)};
        pg8::gemm_phase<pg8::EpiGate, pg8::ListOrder>(lds, g2, S2, E2); }
    GRID_BAR();
    p3_scans(p, lds);
    if (bx < 128 || bx >= 192) {
        __syncthreads();
        pg8::Gemm g2{(const bf16_t*)(ws + WS_HN), (const bf16_t*)(ws + WS_W1T) + (size_t)2560 * 1024, MT, 2048, 1024}; pg8::ListOrder S2; S2.init(MT, 2048, G, bx);
        S2.extra = -1; if (bx >= 192) { S2.base = 1088 + (bx - 192); S2.stride = 64; S2.count = 3; } else { S2.base = 960 + bx; S2.stride = 1; S2.count = 1; }
        pg8::EpiGate E2{GATE, PIN(34)};
        pg8::gemm_phase<pg8::EpiGate, pg8::ListOrder>(lds, g2, S2, E2);
    }
    GRID_BAR();
    {
        pg8::StaticOrder S; S.init(MT, 1024, G, bx);
        pg8::Gemm ga{(const bf16_t*)(ws + WS_YA), (const bf16_t*)(ws + WS_WPL), MT, 1024, 1024};
        pg8::EpiMerge<0> Ea{GATE, (bf16_t*)(ws + WS_TMP), (bf16_t*)(ws + WS_MPRE)};
        pg8::gemm_phase<pg8::EpiMerge<0>, pg8::StaticOrder>(lds, ga, S, Ea);
        pg8::Gemm g{(const bf16_t*)(ws + WS_VS), (const bf16_t*)(ws + WS_WGLU), MT, 512, 512}; pg8::StaticOrder S4; S4.init(MT, 512, G, (bx + 128) & 255);
        pg8::EpiGlu E{(const bf16_t*)(ws + WS_VS), (bf16_t*)(ws + WS_YS), PIN(30)};
        pg8::gemm_phase<pg8::EpiGlu, pg8::StaticOrder>(lds, g, S4, E); }
    GRID_BAR();
    {   pg8::StaticOrder S; S.init(MT, 1024, G, bx);
        pg8::Gemm gb{(const bf16_t*)(ws + WS_YS), (const bf16_t*)(ws + WS_WPS), MT, 1024, 512};
        pg8::EpiMerge<1> Eb{GATE, (bf16_t*)(ws + WS_TMP), (bf16_t*)(ws + WS_MPRE)};
        pg8::gemm_phase<pg8::EpiMerge<1>, pg8::StaticOrder>(lds, gb, S, Eb);
        if (bx >= 128) copy_tiles(p, lds, 3200, 3904, bx - 128, 128); }
    GRID_BAR();
    {   pg8::Gemm g{(const bf16_t*)(ws + WS_MPRE), (const bf16_t*)(ws + WS_WOUT), MT, 1024, 1024}; pg8::StaticOrder S; S.init(MT, 1024, G, bx);
        pg8::EpiOutSS E{(bf16_t*)(ws + WS_MO), (float*)(ws + WS_SSP1)};
        pg8::gemm_phase<pg8::EpiOutSS, pg8::StaticOrder>(lds, g, S, E);
        if (bx >= 128) copy_tiles(p, lds, 1792, 3200, bx - 128, 128); }
    GRID_BAR();
    p7_x1(p);
    GRID_BAR();
    {   pg8::Gemm g{(const bf16_t*)(ws + WS_HN2), (const bf16_t*)(ws + WS_WFI), MT, 2 * DFF, 1024}; pg8::StaticOrder S; S.init(MT, 2 * DFF, G, bx);
        pg8::EpiFF E{(bf16_t*)(ws + WS_HID)};
        pg8::gemm_phase<pg8::EpiFF, pg8::StaticOrder>(lds, g, S, E); }
    GRID_BAR();
    {
        pg8::Gemm g{(const bf16_t*)(ws + WS_HID), (const bf16_t*)(ws + WS_WFO), MT, 1024, DFF}; pg8::StaticOrder S; S.init(128 * 256, 1024, G, bx);
        pg8::EpiPlain E{(bf16_t*)(ws + WS_FO)};
        pg8::gemm_phase<pg8::EpiPlain, pg8::StaticOrder>(lds, g, S, E);
        const int tile = bx >> 1, kh = bx & 1;
        pg8::Gemm gh{(const bf16_t*)(ws + WS_HID) + kh * (DFF / 2), (const bf16_t*)(ws + WS_WFO) + kh * (DFF / 2), MT, 1024, DFF / 2, DFF};
        pg8::OneUnit S1{128 + (tile >> 2), tile & 3};
        pg8::EpiPlain Eh{(bf16_t*)(ws + (kh ? WS_FOB : WS_FO))};
        pg8::gemm_phase<pg8::EpiPlain, pg8::OneUnit>(lds, gh, S1, Eh); }
    GRID_BAR();
    p10_out(p);
}

extern "C" void kernel_launch(void* const* d_in, const int* in_sizes, int n_in, void* d_out, int out_size, void* d_ws, size_t ws_size, hipStream_t stream) {
    static int grid = 0;
    if (grid == 0) {
        if (n_in != 38 || (size_t)out_size != OFF_IM + 32 * 2 * 32 * 64 || ws_size < WS_END) { fprintf(stderr, "kernel_launch: unexpected shapes (n_in %d out %d ws %zu)\n", n_in, out_size, ws_size); grid = -1; return; }
        int dev = 0, cus = 0, per_cu = 0;
        hipGetDevice(&dev); hipDeviceGetAttribute(&cus, hipDeviceAttributeMultiprocessorCount, dev);
        if (hipFuncSetAttribute((const void*)fwd_mega, hipFuncAttributeMaxDynamicSharedMemorySize, LDS_BYTES) != hipSuccess) { fprintf(stderr, "kernel_launch: hipFuncSetAttribute failed\n"); grid = -1; return; }
        if (hipOccupancyMaxActiveBlocksPerMultiprocessor(&per_cu, (const void*)fwd_mega, 512, LDS_BYTES) != hipSuccess || per_cu < 1) { fprintf(stderr, "kernel_launch: occupancy query says %d blocks/CU\n", per_cu); grid = -1; return; }
        if (cus < 256) { fprintf(stderr, "kernel_launch: needs 256 CUs, device has %d\n", cus); grid = -1; return; }
        grid = 256;
    }
    if (grid < 0) return;
    Params p{};
    for (int i = 0; i < 38; ++i) p.in[i] = (const float*)d_in[i];
    p.out = (float*)d_out; p.ws = (unsigned char*)d_ws;
    if (hipMemsetAsync((char*)d_ws + 768 * 1024, 0, XCD_BAR_WORDS * 4, stream) != hipSuccess) { fprintf(stderr, "kernel_launch: hipMemsetAsync of the barrier word failed\n"); return; }
    void* args[] = {&p};
    hipError_t e = hipLaunchCooperativeKernel((const void*)fwd_mega, dim3(grid), dim3(512), args, LDS_BYTES, stream);
    if (e != hipSuccess) fprintf(stderr, "cooperative launch failed: %s\n", hipGetErrorString(e));
}
```

```cpp
#include <hip/hip_runtime.h>
#include <hip/hip_cooperative_groups.h>
#include <cstdio>
#include <cstdint>
namespace cg = cooperative_groups;

#define LAS __attribute__((address_space(3)))
typedef unsigned short bf16_t;
typedef short bf16x8 __attribute__((ext_vector_type(8)));
typedef float f32x4 __attribute__((ext_vector_type(4)));
typedef float f32x16 __attribute__((ext_vector_type(16)));
typedef float f32x2 __attribute__((ext_vector_type(2)));
typedef unsigned u32x4 __attribute__((ext_vector_type(4)));
typedef unsigned u32x2 __attribute__((ext_vector_type(2)));

constexpr int DM = 1024, MC = 8192, MS = 32768, MT = MC + MS;
constexpr int NB_CTX = 32, T_CTX = 256, NB_S = 8, T_S = 4096;
constexpr int DFF = 2816, DS5 = 512;
constexpr float EPS = 1e-6f;
constexpr size_t OFF_LRU = (size_t)MT * DM, OFF_RE = OFF_LRU + 32 * 2 * 1024, OFF_IM = OFF_RE + 32 * 2 * 32 * 64;
constexpr size_t MiB = 1u << 20;
constexpr size_t WS_MOD = 512 * 1024;
constexpr size_t WS_W1T = 1 * MiB, WS_WPL = 10 * MiB, WS_WPS = 12 * MiB, WS_WOUT = 13 * MiB, WS_WFI = 15 * MiB, WS_WFO = 26 * MiB, WS_WGLU = 31 * MiB + 512 * 1024;
constexpr size_t WS_HN = 32 * MiB, WS_XA = 112 * MiB, WS_XS = 192 * MiB, WS_VS = 232 * MiB, WS_YA = 272 * MiB, WS_GA = 352 * MiB, WS_SSP1 = 432 * MiB, WS_SSP2 = 435 * MiB, WS_END = 438 * MiB;
constexpr size_t WS_TMP = WS_HN, WS_MPRE = WS_GA, WS_MO = WS_HN, WS_HN2 = WS_GA, WS_HID = WS_HN, WS_FO = WS_YA, WS_FOB = WS_GA, WS_YS = WS_XS;
constexpr int LDS_BYTES = 147456;

struct Params { const float* in[38]; float* out; unsigned char* ws; };
struct Ctx { const LAS unsigned long long* tbl; float* out; unsigned char* ws; };
__device__ __forceinline__ const float* inp_(const LAS unsigned long long* tbl, int i) { const unsigned long long v = tbl[i];
    const unsigned lo = __builtin_amdgcn_readfirstlane((unsigned)v), hi = __builtin_amdgcn_readfirstlane((unsigned)(v >> 32)); return (const float*)(const __attribute__((address_space(1))) float*)(((unsigned long long)hi << 32) | lo); }
#define PIN(i) inp_(p.tbl, (i))

__device__ __forceinline__ unsigned f2bf(float f) { unsigned u = __builtin_bit_cast(unsigned, f); return (u + 0x7fffu + ((u >> 16) & 1u)) >> 16; }
__device__ __forceinline__ unsigned pk2(float lo, float hi) { unsigned r; asm volatile("s_nop 1\n\tv_cvt_pk_bf16_f32 %0, %1, %2" : "=v"(r) : "v"(lo), "v"(hi)); return r; }
__device__ __forceinline__ bf16_t f2bf1(float x) { return (bf16_t)(pk2(x, 0.f) & 0xffffu); }
__device__ __forceinline__ float bf_lo(unsigned w) { return __builtin_bit_cast(float, w << 16); }
__device__ __forceinline__ float bf_hi(unsigned w) { return __builtin_bit_cast(float, w & 0xffff0000u); }
__device__ __forceinline__ float bf2f(bf16_t h) { return __builtin_bit_cast(float, ((unsigned)h) << 16); }
__device__ __forceinline__ float sigmoidf_(float x) { return __builtin_amdgcn_rcpf(1.0f + __builtin_amdgcn_exp2f(-1.44269504089f * x)); }
__device__ __forceinline__ float siluf_(float x) { return x * sigmoidf_(x); }
__device__ __forceinline__ float gelu_tanh(float x) { const float u = x + 0.044715f * x * x * x; return x * __builtin_amdgcn_rcpf(1.0f + __builtin_amdgcn_exp2f(-2.30220819f * u)); }
__device__ __forceinline__ const float* xrow(const Ctx p, int r) { return r < MC ? PIN(0) + (size_t)r * DM : PIN(1) + (size_t)(r - MC) * DM; }
__device__ __forceinline__ int mod_index(int r) { return r < MC ? 0 : 1 + ((r - MC) >> 12); }
namespace pg8 {
#define PG8_LAS __attribute__((address_space(3)))
constexpr int BM = 256, BK = 64, HALF = 128, HTB = HALF * BK * 2  , STAGE_BYTES = 8 * HTB, NXCD = 8, WGM = 8;
__host__ __device__ __forceinline__ int lds_byte(int r, int c) { const int st = (r >> 4) * 2 + (c >> 5), rr = r & 15, cc = c & 31, ob = rr * 64 + cc * 2; return st * 1024 + (ob ^ (((ob >> 9) & 1) << 5)); }
__host__ __device__ __forceinline__ void stage_rc(int b, int& R, int& C) { const int st = b / 1024, sb = b % 1024, swz = sb ^ (((sb >> 9) & 1) << 5); R = (st >> 1) * 16 + swz / 64; C = (st & 1) * 32 + (swz % 64) / 2; }
__host__ __device__ __forceinline__ int perm32(int rho) { const int n = rho >> 4, i = rho & 15; return 8 * (i >> 2) + 4 * n + (i & 3); }
struct Unit { int pm, pn; };
struct Gemm { const bf16_t* A; const bf16_t* Bt; int M, N, K; int ld = 0; };
struct StaticOrder {
    int nM, nN, nwg, G, c;
    __host__ __device__ void init(int M, int N, int G_, int c_) { nM = M / BM; nN = N / BM; nwg = nM * nN; G = G_; c = c_; }
    __host__ __device__ bool next(int i, Unit& u) const {
        const long L = (long)i * G + c; if (L >= nwg) return false;
        int wgid = (int)L; { const int q = nwg / NXCD, r = nwg % NXCD, xcd = wgid % NXCD, off = wgid / NXCD; wgid = (xcd < r ? xcd * (q + 1) : r * (q + 1) + (xcd - r) * q) + off; }
        const int nig = WGM * nN, gid = wgid / nig, fm = gid * WGM, gsz = (nM - fm) < WGM ? (nM - fm) : WGM;
        u.pm = fm + ((wgid % nig) % gsz); u.pn = (wgid % nig) / gsz; return true;
    }
    __device__ __forceinline__ void a_ready(const Unit&) const {}
    __device__ __forceinline__ void done(const Unit&) const {}
};
struct ListOrder : StaticOrder {
    int base, stride, count, extra;
    __host__ __device__ bool next(int i, Unit& u) const {
        if (i > count || (i == count && extra < 0)) return false;
        const long L = (i < count) ? (long)base + (long)i * stride : (long)extra; if (L >= nwg) return false;
        int wgid = (int)L; { const int q = nwg / NXCD, r = nwg % NXCD, xcd = wgid % NXCD, off = wgid / NXCD; wgid = (xcd < r ? xcd * (q + 1) : r * (q + 1) + (xcd - r) * q) + off; }
        const int nig = WGM * nN, gid = wgid / nig, fm = gid * WGM, gsz = (nM - fm) < WGM ? (nM - fm) : WGM;
        u.pm = fm + ((wgid % nig) % gsz); u.pn = (wgid % nig) / gsz; return true;
    }
};
__device__ __forceinline__ unsigned cvt_pk_bf16(float lo, float hi) { unsigned r; asm volatile("s_nop 1\n\tv_cvt_pk_bf16_f32 %0, %1, %2" : "=v"(r) : "v"(lo), "v"(hi)); return r; }
__device__ __forceinline__ u32x4 pack8(const f32x4 a, const f32x4 b) { u32x4 w; w.x = cvt_pk_bf16(a[0], a[1]); w.y = cvt_pk_bf16(a[2], a[3]); w.z = cvt_pk_bf16(b[0], b[1]); w.w = cvt_pk_bf16(b[2], b[3]); return w; }
__device__ __forceinline__ void unpack8(const u32x4 w, f32x4& a, f32x4& b) { a = (f32x4){bf_lo(w.x), bf_hi(w.x), bf_lo(w.y), bf_hi(w.y)}; b = (f32x4){bf_lo(w.z), bf_hi(w.z), bf_lo(w.w), bf_hi(w.w)}; }

#define EPI_LOOP_BEGIN \
    _Pragma("unroll") for (int ai = 0; ai < 2; ++ai) _Pragma("unroll") for (int m = 0; m < 4; ++m) { const int row = u.pm * BM + ai * HALF + wr * 64 + m * 16 + fr; \
    _Pragma("unroll") for (int bj = 0; bj < 2; ++bj) { const int ct = bj * HALF + wc * 32 + 8 * fq; f32x4 v0 = acc[ai][bj][m][0], v1 = acc[ai][bj][m][1];
#define EPI_LOOP_END } }

struct Epi1 {
    static constexpr bool PERM = true, AFTER_DRAIN = false;
    bf16_t* XA; bf16_t* GA; bf16_t* XS;
    __device__ __forceinline__ void operator()(const f32x4 (&acc)[2][2][4][2], const Unit& u, int wr, int wc, int fr, int fq) const {
        const int pn = u.pn;
        if (pn < 4) {
            EPI_LOOP_BEGIN *(u32x4*)(XA + (size_t)row * 1024 + pn * 256 + ct) = pack8(v0, v1); EPI_LOOP_END
        } else if (pn < 8) {
            EPI_LOOP_BEGIN
#pragma unroll
                for (int j = 0; j < 4; ++j) { v0[j] = gelu_tanh(v0[j]); v1[j] = gelu_tanh(v1[j]); }
                *(u32x4*)(GA + (size_t)row * 1024 + (pn - 4) * 256 + ct) = pack8(v0, v1); EPI_LOOP_END
        } else {
            EPI_LOOP_BEGIN *(u32x4*)(XS + (size_t)row * 512 + (pn - 8) * 256 + ct) = pack8(v0, v1); EPI_LOOP_END
        }
    }
};
struct EpiGate {
    static constexpr bool PERM = true, AFTER_DRAIN = false;
    bf16_t* GATE; const float* bgate;
    __device__ __forceinline__ void operator()(const f32x4 (&acc)[2][2][4][2], const Unit& u, int wr, int wc, int fr, int fq) const {
        const int cb = u.pn * 256;
#pragma unroll
        for (int bj = 0; bj < 2; ++bj) { const int ct = bj * HALF + wc * 32 + 8 * fq;
            const f32x4 b0 = *(const f32x4*)(bgate + cb + ct), b1 = *(const f32x4*)(bgate + cb + ct + 4);
#pragma unroll
            for (int ai = 0; ai < 2; ++ai)
#pragma unroll
                for (int m = 0; m < 4; ++m) { const int row = u.pm * BM + ai * HALF + wr * 64 + m * 16 + fr; f32x4 v0 = acc[ai][bj][m][0], v1 = acc[ai][bj][m][1];
#pragma unroll
                    for (int j = 0; j < 4; ++j) { v0[j] = 1.0f - sigmoidf_(-(v0[j] + b0[j])); v1[j] = 1.0f - sigmoidf_(-(v1[j] + b1[j])); }
                    *(u32x4*)(GATE + (size_t)row * 2048 + cb + ct) = pack8(v0, v1); } }
    }
};
struct EpiGlu {
    static constexpr bool PERM = true, AFTER_DRAIN = false;
    const bf16_t* VS; bf16_t* YS; const float* bglu;
    __device__ __forceinline__ void operator()(const f32x4 (&acc)[2][2][4][2], const Unit& u, int wr, int wc, int fr, int fq) const {
        const int cb = u.pn * 256;
        f32x4 bb[2][2];
#pragma unroll
        for (int bj = 0; bj < 2; ++bj) { const int ct = bj * HALF + wc * 32 + 8 * fq; bb[bj][0] = *(const f32x4*)(bglu + cb + ct); bb[bj][1] = *(const f32x4*)(bglu + cb + ct + 4); }
#pragma unroll
        for (int ai = 0; ai < 2; ++ai) { u32x4 sv[4][2];
#pragma unroll
            for (int m = 0; m < 4; ++m)
#pragma unroll
                for (int bj = 0; bj < 2; ++bj) sv[m][bj] = *(const u32x4*)(VS + (size_t)(u.pm * BM + ai * HALF + wr * 64 + m * 16 + fr) * 512 + cb + bj * HALF + wc * 32 + 8 * fq);
            asm volatile("s_waitcnt vmcnt(0)" ::: "memory");
#pragma unroll
            for (int m = 0; m < 4; ++m)
#pragma unroll
                for (int bj = 0; bj < 2; ++bj) { const int row = u.pm * BM + ai * HALF + wr * 64 + m * 16 + fr, ct = bj * HALF + wc * 32 + 8 * fq; f32x4 v0 = acc[ai][bj][m][0], v1 = acc[ai][bj][m][1], s0, s1; unpack8(sv[m][bj], s0, s1);
#pragma unroll
                    for (int j = 0; j < 4; ++j) { v0[j] = s0[j] * sigmoidf_(v0[j] + bb[bj][0][j]); v1[j] = s1[j] * sigmoidf_(v1[j] + bb[bj][1][j]); }
                    *(u32x4*)(YS + (size_t)row * 512 + cb + ct) = pack8(v0, v1); } }
    }
};
template <int STEP> struct EpiMerge {
    static constexpr bool PERM = true, AFTER_DRAIN = false;
    const bf16_t* GATE; bf16_t* TMP; bf16_t* MPRE;
    __device__ __forceinline__ void operator()(const f32x4 (&acc)[2][2][4][2], const Unit& u, int wr, int wc, int fr, int fq) const {
        const int cb = u.pn * 256;
#pragma unroll
        for (int ai = 0; ai < 2; ++ai) { u32x4 gv[4][2], tv[4][2];
#pragma unroll
            for (int m = 0; m < 4; ++m)
#pragma unroll
                for (int bj = 0; bj < 2; ++bj) { const size_t row = (size_t)(u.pm * BM + ai * HALF + wr * 64 + m * 16 + fr); const int ct = bj * HALF + wc * 32 + 8 * fq;
                    gv[m][bj] = *(const u32x4*)(GATE + row * 2048 + STEP * 1024 + cb + ct); if (STEP == 1) tv[m][bj] = *(const u32x4*)(TMP + row * 1024 + cb + ct); }
            asm volatile("s_waitcnt vmcnt(0)" ::: "memory");
#pragma unroll
            for (int m = 0; m < 4; ++m)
#pragma unroll
                for (int bj = 0; bj < 2; ++bj) { const size_t row = (size_t)(u.pm * BM + ai * HALF + wr * 64 + m * 16 + fr); const int ct = bj * HALF + wc * 32 + 8 * fq;
                    const f32x4 v0 = acc[ai][bj][m][0], v1 = acc[ai][bj][m][1]; f32x4 g0, g1; unpack8(gv[m][bj], g0, g1);
                    if (STEP == 0) { *(u32x4*)(TMP + row * 1024 + cb + ct) = pack8(g0 * v0, g1 * v1); }
                    else { f32x4 t0, t1; unpack8(tv[m][bj], t0, t1); *(u32x4*)(MPRE + row * 1024 + cb + ct) = pack8(t0 + g0 * v0, t1 + g1 * v1); } } }
    }
};
struct EpiOutSS {
    static constexpr bool PERM = true, AFTER_DRAIN = false;
    bf16_t* O; float* rowss;
    __device__ __forceinline__ void operator()(const f32x4 (&acc)[2][2][4][2], const Unit& u, int wr, int wc, int fr, int fq) const {
        const int cb = u.pn * 256;
#pragma unroll
        for (int ai = 0; ai < 2; ++ai)
#pragma unroll
            for (int m = 0; m < 4; ++m) { const int row = u.pm * BM + ai * HALF + wr * 64 + m * 16 + fr; float ss = 0.f;
#pragma unroll
                for (int bj = 0; bj < 2; ++bj) { const int ct = bj * HALF + wc * 32 + 8 * fq; const f32x4 v0 = acc[ai][bj][m][0], v1 = acc[ai][bj][m][1];
                    ss += (v0[0] * v0[0] + v0[1] * v0[1]) + (v0[2] * v0[2] + v0[3] * v0[3]) + (v1[0] * v1[0] + v1[1] * v1[1]) + (v1[2] * v1[2] + v1[3] * v1[3]);
                    *(u32x4*)(O + (size_t)row * 1024 + cb + ct) = pack8(v0, v1); }
                ss += __shfl_xor(ss, 16); ss += __shfl_xor(ss, 32);
                if (fq == 0) rowss[((size_t)u.pn * MT + row) * 4 + wc] = ss; }
    }
};
struct EpiPlain {
    static constexpr bool PERM = true, AFTER_DRAIN = false;
    bf16_t* O;
    __device__ __forceinline__ void operator()(const f32x4 (&acc)[2][2][4][2], const Unit& u, int wr, int wc, int fr, int fq) const {
        const int cb = u.pn * 256;
        EPI_LOOP_BEGIN *(u32x4*)(O + (size_t)row * 1024 + cb + ct) = pack8(v0, v1); EPI_LOOP_END
    }
};
struct OneUnit { int pm, pn;
    __device__ __forceinline__ bool next(int i, Unit& u) const { if (i) return false; u.pm = pm; u.pn = pn; return true; }
    __device__ __forceinline__ void a_ready(const Unit&) const {}
    __device__ __forceinline__ void done(const Unit&) const {} };
struct EpiFF {
    static constexpr bool PERM = true, AFTER_DRAIN = false;
    bf16_t* HID;
    __device__ __forceinline__ void operator()(const f32x4 (&acc)[2][2][4][2], const Unit& u, int wr, int wc, int fr, int fq) const {
#pragma unroll
        for (int ai = 0; ai < 2; ++ai)
#pragma unroll
            for (int m = 0; m < 4; ++m) { const int row = u.pm * BM + ai * HALF + wr * 64 + m * 16 + fr;
                f32x4 a0 = acc[ai][0][m][0], a1 = acc[ai][0][m][1]; const f32x4 g0 = acc[ai][1][m][0], g1 = acc[ai][1][m][1];
#pragma unroll
                for (int j = 0; j < 4; ++j) { a0[j] = siluf_(a0[j]) * g0[j]; a1[j] = siluf_(a1[j]) * g1[j]; }
                *(u32x4*)(HID + (size_t)row * DFF + u.pn * 128 + wc * 32 + 8 * fq) = pack8(a0, a1); }
    }
};
template <class Epi, class Sched>
__device__ __forceinline__ void gemm_phase(PG8_LAS unsigned char* lds, const Gemm g, const Sched& S, const Epi& E) {
    int tid_ = threadIdx.x; asm volatile("" : "+v"(tid_));
    const int tid = tid_, wid = __builtin_amdgcn_readfirstlane(tid >> 6), lane = tid & 63, wr = wid >> 2, wc = wid & 3, fr = lane & 15, fq = lane >> 4;
    const int K = g.K, nt = K / BK, LD = g.ld ? g.ld : g.K;
    unsigned voffA[2], voffB[2];
#pragma unroll
    for (int i = 0; i < 2; ++i) { int R, C; stage_rc(tid * 16 + i * 8192, R, C); const int Rb = Epi::PERM ? ((R & ~31) + perm32(R & 31)) : R;
        voffA[i] = (unsigned)(R * LD + C) * 2u; voffB[i] = (unsigned)(Rb * LD + C) * 2u; }
    const size_t kstep = (size_t)(BK * 2);
    const size_t hstep = (size_t)HALF * LD * 2;
    const size_t tstep = 2 * hstep;
    const unsigned ldsw = (unsigned)wid * 1024u;
    const int aoff = lds_byte(wr * 64 + fr, fq * 8), boff = lds_byte(wc * 32 + fr, fq * 8);
#define PG8_SA(b, h) (((b) * 2 + (h)) * HTB)
#define PG8_SB(b, h) ((4 + (b) * 2 + (h)) * HTB)
#define PG8_STAGE(bufoff, gbase, voff) do { _Pragma("unroll") for (int _i = 0; _i < 2; ++_i) \
        __builtin_amdgcn_global_load_lds((const unsigned*)((const char*)(gbase) + (voff)[_i]), (PG8_LAS unsigned*)(lds + (bufoff) + ldsw + _i * 8192), 16, 0, 0); } while (0)
#define PG8_LDA(dst, b, h) do { _Pragma("unroll") for (int m = 0; m < 4; ++m) _Pragma("unroll") for (int k = 0; k < 2; ++k) dst[m][k] = *(const PG8_LAS bf16x8*)(lds + PG8_SA(b, h) + aoff + m * 2048 + k * 1024); } while (0)
#define PG8_LDB(dst, b, h) do { _Pragma("unroll") for (int n = 0; n < 2; ++n) _Pragma("unroll") for (int k = 0; k < 2; ++k) dst[n][k] = *(const PG8_LAS bf16x8*)(lds + PG8_SB(b, h) + boff + n * 2048 + k * 1024); } while (0)
#define PG8_MMA(ai, bj, At, Bt) do { __builtin_amdgcn_s_setprio(1); _Pragma("unroll") for (int m = 0; m < 4; ++m) _Pragma("unroll") for (int n = 0; n < 2; ++n) _Pragma("unroll") for (int k = 0; k < 2; ++k) \
        acc[ai][bj][m][n] = __builtin_amdgcn_mfma_f32_16x16x32_bf16(Bt[n][k], At[m][k], acc[ai][bj][m][n], 0, 0, 0); __builtin_amdgcn_s_setprio(0); } while (0)
#define PG8_WAIT_V(n) asm volatile("s_waitcnt vmcnt(" #n ")" ::: "memory")
#define PG8_WAIT_L(n) asm volatile("s_waitcnt lgkmcnt(" #n ")" ::: "memory")
#define PG8_BAR __builtin_amdgcn_s_barrier()
#define PG8_SCHED __builtin_amdgcn_sched_barrier(0)
    Unit cur, nxt; int ui = 0;
    if (!S.next(0, cur)) return;
    f32x4 acc[2][2][4][2];
#pragma unroll
    for (int a = 0; a < 2; ++a)
#pragma unroll
        for (int b = 0; b < 2; ++b)
#pragma unroll
            for (int m = 0; m < 4; ++m)
#pragma unroll
                for (int n = 0; n < 2; ++n) acc[a][b][m][n] = (f32x4){0.f, 0.f, 0.f, 0.f};
    bf16x8 At[4][2], B0[2][2], B1[2][2];
    const char* cA = (const char*)g.A + (size_t)cur.pm * tstep; const char* cB = (const char*)g.Bt + (size_t)cur.pn * tstep;
    S.a_ready(cur);
    PG8_STAGE(PG8_SB(0, 0), cB, voffB); PG8_STAGE(PG8_SA(0, 0), cA, voffA); PG8_STAGE(PG8_SB(0, 1), cB + hstep, voffB); PG8_STAGE(PG8_SA(0, 1), cA + hstep, voffA);
    if (wr == 1) PG8_BAR;
    PG8_WAIT_V(4); PG8_BAR;
    PG8_STAGE(PG8_SB(1, 0), cB + kstep, voffB); PG8_STAGE(PG8_SA(1, 0), cA + kstep, voffA); PG8_STAGE(PG8_SB(1, 1), cB + hstep + kstep, voffB);
    PG8_WAIT_V(6); PG8_BAR;
    for (;;) {
        const bool has_next = S.next(ui + 1, nxt);
        const char* nA = has_next ? (const char*)g.A + (size_t)nxt.pm * tstep : cA; const char* nB = has_next ? (const char*)g.Bt + (size_t)nxt.pn * tstep : cB;
        for (int t = 0; t < nt; t += 2) {
            const bool last = (t == nt - 2);
            const char* a1 = cA + (size_t)(t + 1) * kstep;
            const char* a2 = last ? nA : cA + (size_t)(t + 2) * kstep; const char* b2 = last ? nB : cB + (size_t)(t + 2) * kstep;
            const char* a3 = a2 + kstep; const char* b3 = b2 + kstep;
            if (last && has_next) S.a_ready(nxt);
            PG8_LDB(B0, 0, 0); PG8_SCHED; PG8_LDA(At, 0, 0); PG8_STAGE(PG8_SA(1, 1), a1 + hstep, voffA);
            PG8_WAIT_L(8); PG8_BAR; PG8_WAIT_L(0); PG8_MMA(0, 0, At, B0); PG8_BAR; PG8_SCHED;
            PG8_LDB(B1, 0, 1); PG8_STAGE(PG8_SB(0, 0), b2, voffB);
            PG8_BAR; PG8_WAIT_L(0); PG8_MMA(0, 1, At, B1); PG8_BAR;
            PG8_LDA(At, 0, 1); PG8_STAGE(PG8_SA(0, 0), a2, voffA);
            PG8_BAR; PG8_WAIT_L(0); PG8_MMA(1, 0, At, B0); PG8_BAR; PG8_SCHED;
            PG8_STAGE(PG8_SB(0, 1), b2 + hstep, voffB);
            PG8_WAIT_V(6); PG8_BAR; PG8_MMA(1, 1, At, B1); PG8_BAR;
            PG8_LDB(B0, 1, 0); PG8_SCHED; PG8_LDA(At, 1, 0); PG8_STAGE(PG8_SA(0, 1), a2 + hstep, voffA);
            PG8_WAIT_L(8); PG8_BAR; PG8_WAIT_L(0); PG8_MMA(0, 0, At, B0); PG8_BAR; PG8_SCHED;
            PG8_LDB(B1, 1, 1); PG8_STAGE(PG8_SB(1, 0), b3, voffB);
            PG8_BAR; PG8_WAIT_L(0); PG8_MMA(0, 1, At, B1); PG8_BAR;
            PG8_LDA(At, 1, 1); PG8_STAGE(PG8_SA(1, 0), a3, voffA);
            PG8_BAR; PG8_WAIT_L(0); PG8_MMA(1, 0, At, B0); PG8_BAR; PG8_SCHED;
            PG8_STAGE(PG8_SB(1, 1), b3 + hstep, voffB);
            PG8_WAIT_V(6); PG8_BAR; PG8_MMA(1, 1, At, B1); PG8_BAR;
        }
        if constexpr (!Epi::AFTER_DRAIN) { E(acc, cur, wr, wc, fr, fq); S.done(cur); }
        if (!has_next) break;
#pragma unroll
        for (int a = 0; a < 2; ++a)
#pragma unroll
            for (int b = 0; b < 2; ++b)
#pragma unroll
                for (int m = 0; m < 4; ++m)
#pragma unroll
                    for (int n = 0; n < 2; ++n) acc[a][b][m][n] = (f32x4){0.f, 0.f, 0.f, 0.f};
        cur = nxt; cA = nA; cB = nB; ++ui;
    }
    PG8_WAIT_V(0);
    if (wr == 0) PG8_BAR;
    PG8_BAR;
    if constexpr (Epi::AFTER_DRAIN) { E.fused(acc, cur, wr, wc, fr, fq, lds, wid, lane); S.done(cur); }
#undef PG8_SA
#undef PG8_SB
#undef PG8_STAGE
#undef PG8_LDA
#undef PG8_LDB
#undef PG8_MMA
#undef PG8_WAIT_V
#undef PG8_WAIT_L
#undef PG8_BAR
#undef PG8_SCHED
}
}

__device__ __forceinline__ int ffin_row(int n) { const int half = n >= DFF, j = half ? n - DFF : n; return (j >> 7) * 256 + half * 128 + (j & 127); }
__device__ __forceinline__ void copy_tiles(const Ctx p, LAS unsigned char* lds, int tbeg, int tend, int first, int stride) {
    int tid_ = threadIdx.x; asm volatile("" : "+v"(tid_)); const int tid = tid_;
    unsigned char* ws = p.ws;
    LAS float* tile = (LAS float*)lds;
    const float* src; bf16_t* dst; int K, N, k0, n0; bool perm;
#define TILE_INFO(T) do { int t_ = (T), tk_; \
        if (t_ < 640) { src = PIN(13); K = 1024; N = 2560; dst = (bf16_t*)(ws + WS_W1T); perm = false; } \
        else if (t_ < 1152) { t_ -= 640; src = PIN(33); K = 1024; N = 2048; dst = (bf16_t*)(ws + WS_W1T) + (size_t)2560 * 1024; perm = false; } \
        else if (t_ < 1408) { t_ -= 1152; src = PIN(31); K = 1024; N = 1024; dst = (bf16_t*)(ws + WS_WPL); perm = false; } \
        else if (t_ < 1536) { t_ -= 1408; src = PIN(32); K = 512; N = 1024; dst = (bf16_t*)(ws + WS_WPS); perm = false; } \
        else if (t_ < 1792) { t_ -= 1536; src = PIN(35); K = 1024; N = 1024; dst = (bf16_t*)(ws + WS_WOUT); perm = false; } \
        else if (t_ < 3200) { t_ -= 1792; src = PIN(36); K = 1024; N = 2 * DFF; dst = (bf16_t*)(ws + WS_WFI); perm = true; } \
        else if (t_ < 3904) { t_ -= 3200; src = PIN(37); K = DFF; N = 1024; dst = (bf16_t*)(ws + WS_WFO); perm = false; } \
        else { t_ -= 3904; src = PIN(29); K = 512; N = 512; dst = (bf16_t*)(ws + WS_WGLU); perm = false; } \
        tk_ = K / 64; k0 = (t_ % tk_) * 64; n0 = (t_ / tk_) * 64; } while (0)
    {   const int r = tid >> 4, c4 = tid & 15, n = tid >> 3, kc = tid & 7;
        f32x4 v0, v1; int T = tbeg + first;
        if (T < tend) { TILE_INFO(T); v0 = *(const f32x4*)(src + (size_t)(k0 + r) * N + n0 + 4 * c4); v1 = *(const f32x4*)(src + (size_t)(k0 + r + 32) * N + n0 + 4 * c4); }
        for (; T < tend; T += stride) {
            TILE_INFO(T);
            bf16_t* const cdst = dst; const int cK = K, ck0 = k0, cdrow = perm ? ffin_row(n0 + n) : n0 + n;
            {   LAS float* t = tile + r * 65 + 4 * c4; t[0] = v0[0]; t[1] = v0[1]; t[2] = v0[2]; t[3] = v0[3]; t += 32 * 65; t[0] = v1[0]; t[1] = v1[1]; t[2] = v1[2]; t[3] = v1[3]; }
            __syncthreads();
            if (T + stride < tend) { TILE_INFO(T + stride); v0 = *(const f32x4*)(src + (size_t)(k0 + r) * N + n0 + 4 * c4); v1 = *(const f32x4*)(src + (size_t)(k0 + r + 32) * N + n0 + 4 * c4); }
            {   const LAS float* t = tile + (8 * kc) * 65 + n; u32x4 w;
                w.x = pk2(t[0], t[65]); w.y = pk2(t[130], t[195]); w.z = pk2(t[260], t[325]); w.w = pk2(t[390], t[455]);
                *(u32x4*)(cdst + (size_t)cdrow * cK + ck0 + 8 * kc) = w; }
            __syncthreads();
        }
    }
#undef TILE_INFO
}
__device__ __forceinline__ void p0_prologue(const Ctx p, LAS unsigned char* lds) {
    const int tid = threadIdx.x, G = gridDim.x, bx = blockIdx.x;
    unsigned char* ws = p.ws;
    if (bx >= G - 96) {
        const int item = bx - (G - 96), n0 = item * 64, w = tid >> 6, lane = tid & 63;
        LAS float* sc = (LAS float*)lds;
        LAS float* red = (LAS float*)(lds + 9 * 1024 * 4);
        for (int i = tid; i < 9 * 1024; i += 512) { const int j = i >> 10, k = i & 1023; const float v = j == 0 ? PIN(6)[k] : PIN(2)[(j - 1) * 1024 + k]; sc[i] = siluf_(v); }
        __syncthreads();
        float a[9];
#pragma unroll
        for (int j = 0; j < 9; ++j) a[j] = 0.f;
        const float* wm = PIN(7) + n0 + lane;
#pragma unroll 8
        for (int k = 128 * w; k < 128 * w + 128; ++k) { const float wv = wm[(size_t)k * 6144];
#pragma unroll
            for (int j = 0; j < 9; ++j) a[j] += sc[j * 1024 + k] * wv; }
#pragma unroll
        for (int j = 0; j < 9; ++j) red[(w * 9 + j) * 64 + lane] = a[j];
        __syncthreads();
        for (int i = tid; i < 9 * 64; i += 512) { const int j = i >> 6, l = i & 63; float s = PIN(8)[n0 + l];
#pragma unroll
            for (int ww = 0; ww < 8; ++ww) s += red[(ww * 9 + j) * 64 + l];
            ((float*)(ws + WS_MOD))[j * 6144 + n0 + l] = s; }
        __syncthreads();
    }
    if (bx < G - 96) { copy_tiles(p, lds, 0, 1792, bx, G - 96); copy_tiles(p, lds, 3904, 3968, bx, G - 96); }
}

#define ROW_SS(v) ((v[0][0] * v[0][0] + v[0][1] * v[0][1]) + (v[0][2] * v[0][2] + v[0][3] * v[0][3]) + (v[1][0] * v[1][0] + v[1][1] * v[1][1]) + (v[1][2] * v[1][2] + v[1][3] * v[1][3]) + \
                   (v[2][0] * v[2][0] + v[2][1] * v[2][1]) + (v[2][2] * v[2][2] + v[2][3] * v[2][3]) + (v[3][0] * v[3][0] + v[3][1] * v[3][1]) + (v[3][2] * v[3][2] + v[3][3] * v[3][3]))
__device__ __forceinline__ float wave_sum(float x) {
#pragma unroll
    for (int o = 1; o < 64; o <<= 1) x += __shfl_xor(x, o);
    return x; }
__device__ __forceinline__ f32x4 bf4(const u32x2 w) { return (f32x4){bf_lo(w.x), bf_hi(w.x), bf_lo(w.y), bf_hi(w.y)}; }
__device__ __forceinline__ void p1_hn(const Ctx p) {
    int tid_ = threadIdx.x; asm volatile("" : "+v"(tid_)); const int tid = tid_, w = tid >> 6, lane = tid & 63, r0 = blockIdx.x * 160 + w * 20;
    bf16_t* HN = (bf16_t*)(p.ws + WS_HN);
    f32x4 gs[4], sh[4]; int cur = -1;
    for (int it = 0; it < 10; ++it) { const int r = r0 + 2 * it, mi = mod_index(r);
        if (mi != cur) { cur = mi; const float* mod = (const float*)(p.ws + WS_MOD) + mi * 6144;
#pragma unroll
            for (int j = 0; j < 4; ++j) { const int c = 4 * lane + 256 * j; gs[j] = *(const f32x4*)(PIN(9) + c) * (*(const f32x4*)(mod + 1024 + c) + 1.0f); sh[j] = *(const f32x4*)(mod + c); } }
        const float* xa = xrow(p, r); const float* xb = xrow(p, r + 1); f32x4 va[4], vb[4];
#pragma unroll
        for (int j = 0; j < 4; ++j) { va[j] = __builtin_nontemporal_load((const f32x4*)(xa + 4 * lane + 256 * j)); vb[j] = __builtin_nontemporal_load((const f32x4*)(xb + 4 * lane + 256 * j)); }
        const float ra = __builtin_amdgcn_rsqf(wave_sum(ROW_SS(va)) * (1.0f / 1024.0f) + EPS), rb = __builtin_amdgcn_rsqf(wave_sum(ROW_SS(vb)) * (1.0f / 1024.0f) + EPS);
#pragma unroll
        for (int j = 0; j < 4; ++j) { const f32x4 ya = va[j] * ra * gs[j] + sh[j], yb = vb[j] * rb * gs[j] + sh[j]; u32x2 oa, ob; oa.x = pk2(ya[0], ya[1]); oa.y = pk2(ya[2], ya[3]); ob.x = pk2(yb[0], yb[1]); ob.y = pk2(yb[2], yb[3]);
            *(u32x2*)(HN + (size_t)r * 1024 + 4 * lane + 256 * j) = oa; *(u32x2*)(HN + (size_t)(r + 1) * 1024 + 4 * lane + 256 * j) = ob; }
    }
}
__device__ __forceinline__ float row_rs(const float* ssp, int r, int lane) { float q = ssp[((size_t)((lane >> 2) & 3) * MT + r) * 4 + (lane & 3)]; q += __shfl_xor(q, 1); q += __shfl_xor(q, 2); q += __shfl_xor(q, 4); q += __shfl_xor(q, 8);
    return __builtin_amdgcn_rsqf(q * (1.0f / 1024.0f) + EPS); }
__device__ __forceinline__ void p7_x1(const Ctx p) {
    int tid_ = threadIdx.x; asm volatile("" : "+v"(tid_)); const int tid = tid_, w = tid >> 6, lane = tid & 63, r0 = blockIdx.x * 160 + w * 20;
    const bf16_t* MO = (const bf16_t*)(p.ws + WS_MO); bf16_t* HN2 = (bf16_t*)(p.ws + WS_HN2); const float* ss1 = (const float*)(p.ws + WS_SSP1);
    f32x4 gg[4], gs[4], sh[4]; int cur = -1;
    for (int it = 0; it < 10; ++it) { const int r = r0 + 2 * it, mi = mod_index(r);
        if (mi != cur) { cur = mi; const float* mod = (const float*)(p.ws + WS_MOD) + mi * 6144;
#pragma unroll
            for (int j = 0; j < 4; ++j) { const int c = 4 * lane + 256 * j; gg[j] = *(const f32x4*)(mod + 2048 + c) * *(const f32x4*)(PIN(10) + c);
                gs[j] = *(const f32x4*)(PIN(11) + c) * (*(const f32x4*)(mod + 4096 + c) + 1.0f); sh[j] = *(const f32x4*)(mod + 3072 + c); } }
        const float* xa = xrow(p, r); const float* xb = xrow(p, r + 1); f32x4 va[4], vb[4]; u32x2 ma[4], mb[4];
#pragma unroll
        for (int j = 0; j < 4; ++j) { const int c = 4 * lane + 256 * j; va[j] = __builtin_nontemporal_load((const f32x4*)(xa + c)); vb[j] = __builtin_nontemporal_load((const f32x4*)(xb + c)); ma[j] = *(const u32x2*)(MO + (size_t)r * 1024 + c); mb[j] = *(const u32x2*)(MO + (size_t)(r + 1) * 1024 + c); }
        const float sa = row_rs(ss1, r, lane), sb = row_rs(ss1, r + 1, lane);
#pragma unroll
        for (int j = 0; j < 4; ++j) { const int c = 4 * lane + 256 * j; va[j] = va[j] + gg[j] * bf4(ma[j]) * sa; vb[j] = vb[j] + gg[j] * bf4(mb[j]) * sb;
            __builtin_nontemporal_store(va[j], (f32x4*)(p.out + (size_t)r * 1024 + c)); __builtin_nontemporal_store(vb[j], (f32x4*)(p.out + (size_t)(r + 1) * 1024 + c)); }
        const float ra = __builtin_amdgcn_rsqf(wave_sum(ROW_SS(va)) * (1.0f / 1024.0f) + EPS), rb = __builtin_amdgcn_rsqf(wave_sum(ROW_SS(vb)) * (1.0f / 1024.0f) + EPS);
#pragma unroll
        for (int j = 0; j < 4; ++j) { const f32x4 ya = va[j] * ra * gs[j] + sh[j], yb = vb[j] * rb * gs[j] + sh[j]; u32x2 oa, ob; oa.x = pk2(ya[0], ya[1]); oa.y = pk2(ya[2], ya[3]); ob.x = pk2(yb[0], yb[1]); ob.y = pk2(yb[2], yb[3]);
            *(u32x2*)(HN2 + (size_t)r * 1024 + 4 * lane + 256 * j) = oa; *(u32x2*)(HN2 + (size_t)(r + 1) * 1024 + 4 * lane + 256 * j) = ob; }
    }
}
__device__ __forceinline__ void p10_out(const Ctx p) {
    int tid_ = threadIdx.x; asm volatile("" : "+v"(tid_)); const int tid = tid_, w = tid >> 6, lane = tid & 63, r0 = blockIdx.x * 160 + w * 20;
    const bf16_t* FO = (const bf16_t*)(p.ws + WS_FO); const bf16_t* FOB = (const bf16_t*)(p.ws + WS_FOB);
    f32x4 gg[4]; int cur = -1;
    for (int it = 0; it < 10; ++it) { const int r = r0 + 2 * it, mi = mod_index(r); const bool split = r >= 128 * 256;
        if (mi != cur) { cur = mi; const float* mod = (const float*)(p.ws + WS_MOD) + mi * 6144;
#pragma unroll
            for (int j = 0; j < 4; ++j) { const int c = 4 * lane + 256 * j; gg[j] = *(const f32x4*)(mod + 5120 + c) * *(const f32x4*)(PIN(12) + c); } }
        f32x4 va[4], vb[4], fa[4], fb[4];
#pragma unroll
        for (int j = 0; j < 4; ++j) { const int c = 4 * lane + 256 * j; va[j] = __builtin_nontemporal_load((const f32x4*)(p.out + (size_t)r * 1024 + c)); vb[j] = __builtin_nontemporal_load((const f32x4*)(p.out + (size_t)(r + 1) * 1024 + c));
            fa[j] = bf4(*(const u32x2*)(FO + (size_t)r * 1024 + c)); fb[j] = bf4(*(const u32x2*)(FO + (size_t)(r + 1) * 1024 + c));
            if (split) { fa[j] = fa[j] + bf4(*(const u32x2*)(FOB + (size_t)r * 1024 + c)); fb[j] = fb[j] + bf4(*(const u32x2*)(FOB + (size_t)(r + 1) * 1024 + c)); } }
        const float sa = __builtin_amdgcn_rsqf(wave_sum(ROW_SS(fa)) * (1.0f / 1024.0f) + EPS), sb = __builtin_amdgcn_rsqf(wave_sum(ROW_SS(fb)) * (1.0f / 1024.0f) + EPS);
#pragma unroll
        for (int j = 0; j < 4; ++j) { const int c = 4 * lane + 256 * j; __builtin_nontemporal_store(va[j] + gg[j] * fa[j] * sa, (f32x4*)(p.out + (size_t)r * 1024 + c)); __builtin_nontemporal_store(vb[j] + gg[j] * fb[j] * sb, (f32x4*)(p.out + (size_t)(r + 1) * 1024 + c)); }
    }
}

constexpr int LRU_U16 = 0, LRU_UB = 9216, LRU_AA = LRU_UB + 17408, LRU_AGG = LRU_AA + 17408, LRU_CAR = LRU_AGG + 2048, LRU_HALF = 46592;
__device__ __forceinline__ void lru_unit(const Ctx p, LAS unsigned char* lds, int sample, int b, int hd) {
    int tid_ = threadIdx.x; asm volatile("" : "+v"(tid_)); const int tid = tid_, d = tid >> 8, ht = tid & 255, hw = ht >> 6, lane = tid & 63;
    const int T = sample ? T_S : T_CTX, row0 = sample ? MC + b * T_S : b * T_CTX, nch = T / 64;
    LAS unsigned char* L = lds + d * LRU_HALF;
    LAS bf16_t* U16 = (LAS bf16_t*)(L + LRU_U16); LAS float* UB = (LAS float*)(L + LRU_UB); LAS float* AA = (LAS float*)(L + LRU_AA);
    LAS f32x2* AGG = (LAS f32x2*)(L + LRU_AGG); LAS float* CAR = (LAS float*)(L + LRU_CAR);
    const bf16_t* XA = (const bf16_t*)(p.ws + WS_XA); const bf16_t* GA = (const bf16_t*)(p.ws + WS_GA); bf16_t* YA = (bf16_t*)(p.ws + WS_YA);
    const int fj = lane & 15, fq = lane >> 4, chg = hd * 64 + 16 * hw + fj;
    bf16x8 wrf[2], wif[2];
    {   const float* wr = PIN(16) + (size_t)(d * 16 + hd) * 4096 + 16 * hw + fj; const float* wi = PIN(18) + (size_t)(d * 16 + hd) * 4096 + 16 * hw + fj;
#pragma unroll
        for (int s = 0; s < 2; ++s)
#pragma unroll
            for (int e = 0; e < 8; ++e) { const int k = 32 * s + 8 * fq + e; wrf[s][e] = (short)f2bf(wr[k * 64]); wif[s][e] = (short)f2bf(wi[k * 64]); } }
    const float br = PIN(17)[d * 1024 + chg], bi = PIN(19)[d * 1024 + chg];
    const float sp8 = -8.0f * 1.44269504089f * log1pf(__expf(-PIN(20)[d * 1024 + chg]));
    const int cp = ht & 31, tg = ht >> 5, cc0 = hd * 64 + 2 * cp;
    float cw0[4], cw1[4];
#pragma unroll
    for (int j = 0; j < 4; ++j) { cw0[j] = PIN(14)[j * 1024 + cc0]; cw1[j] = PIN(14)[j * 1024 + cc0 + 1]; }
    const float cb0 = PIN(15)[cc0], cb1 = PIN(15)[cc0 + 1];
    const int chs = hd * 64 + lane;
    if (ht < 64) CAR[lane] = sample ? PIN(3)[(size_t)(b * 2 + d) * 1024 + chs] : 0.f;
    float hfin = 0.f;
    __syncthreads();
    unsigned xw[11];
#define LRU_LOADX(kk) do { const int c_ = d ? nch - 1 - (kk) : (kk); _Pragma("unroll") for (int i = 0; i < 11; ++i) { const int t = 64 * c_ + 8 * tg - 2 + i; unsigned w = 0u; if (t >= 0 && t < T) w = *(const unsigned*)(XA + (size_t)(row0 + t) * 1024 + cc0); xw[i] = w; } } while (0)
    LRU_LOADX(0);
    for (int k = 0; k < nch; ++k) {
        const int c = d ? nch - 1 - k : k, t0 = 64 * c; const bool second = (2 * k >= nch);
        {   float x0[11], x1[11];
#pragma unroll
            for (int i = 0; i < 11; ++i) { x0[i] = bf_lo(xw[i]); x1[i] = bf_hi(xw[i]); }
#pragma unroll
            for (int i = 0; i < 8; ++i) { const float u0 = cb0 + cw0[0] * x0[i] + cw0[1] * x0[i + 1] + cw0[2] * x0[i + 2] + cw0[3] * x0[i + 3];
                const float u1 = cb1 + cw1[0] * x1[i] + cw1[1] * x1[i + 1] + cw1[2] * x1[i + 2] + cw1[3] * x1[i + 3]; const int tl = 8 * tg + i;
                *(LAS unsigned*)(U16 + tl * 72 + 2 * cp) = pk2(u0, u1); *(LAS f32x2*)(UB + tl * 68 + 2 * cp) = (f32x2){u0, u1}; } }
        if (k + 1 < nch) LRU_LOADX(k + 1);
        unsigned short hf16[16], g16[16];
        if (second) {
#pragma unroll
            for (int i = 0; i < 16; ++i) { const int pi = 16 * hw + i, tl = d ? 63 - pi : pi; const size_t ix = (size_t)(row0 + t0 + tl) * 1024 + chs; hf16[i] = YA[ix]; g16[i] = GA[ix]; } }
        __syncthreads();
        {   f32x4 ar[4], ai[4];
#pragma unroll
            for (int m = 0; m < 4; ++m) { ar[m] = (f32x4){0.f, 0.f, 0.f, 0.f}; ai[m] = ar[m];
#pragma unroll
                for (int s = 0; s < 2; ++s) { const bf16x8 a = *(const LAS bf16x8*)(U16 + (16 * m + fj) * 72 + 32 * s + 8 * fq);
                    ar[m] = __builtin_amdgcn_mfma_f32_16x16x32_bf16(a, wrf[s], ar[m], 0, 0, 0); ai[m] = __builtin_amdgcn_mfma_f32_16x16x32_bf16(a, wif[s], ai[m], 0, 0, 0); } }
#pragma unroll
            for (int m = 0; m < 4; ++m)
#pragma unroll
                for (int r4 = 0; r4 < 4; ++r4) { const int tok = 16 * m + 4 * fq + r4, ix = tok * 68 + 16 * hw + fj;
                    const float rg = sigmoidf_(ar[m][r4] + br), a = __builtin_amdgcn_exp2f(sp8 * rg);
                    const float ei = 1.0f + __builtin_amdgcn_exp2f(-1.44269504089f * (ai[m][r4] + bi)), om = fmaxf(1.0f - a * a, 1e-30f);
                    const float bb = om * __builtin_amdgcn_rsqf(om * ei * ei) * UB[ix]; AA[ix] = a; UB[ix] = bb; } }
        __syncthreads();
        float av[16], bv[16]; float P = 1.f, h = 0.f;
#pragma unroll
        for (int i = 0; i < 16; ++i) { const int pi = 16 * hw + i, tl = d ? 63 - pi : pi; av[i] = AA[tl * 68 + lane]; bv[i] = UB[tl * 68 + lane]; h = av[i] * h + bv[i]; P *= av[i]; }
        AGG[hw * 64 + lane] = (f32x2){P, h};
        __syncthreads();
        h = CAR[(k & 1) * 64 + lane];
        for (int s2 = 0; s2 < hw; ++s2) { const f32x2 ag = AGG[s2 * 64 + lane]; h = ag.x * h + ag.y; }
#pragma unroll
        for (int i = 0; i < 16; ++i) { const int pi = 16 * hw + i, tl = d ? 63 - pi : pi; const size_t ix = (size_t)(row0 + t0 + tl) * 1024 + chs; h = av[i] * h + bv[i];
            YA[ix] = f2bf1(second ? bf2f(g16[i]) * (bf2f(hf16[i]) + h) : h); }
        if (hw == 3) { CAR[((k + 1) & 1) * 64 + lane] = h; hfin = h; }
        if (2 * k + 2 == nch) asm volatile("s_waitcnt vmcnt(0)" ::: "memory");
        __syncthreads();
    }
#undef LRU_LOADX
    if (!sample && hw == 3) p.out[OFF_LRU + (size_t)(b * 2 + d) * 1024 + chs] = hfin;
}

__device__ __forceinline__ void sincos_f(float x, float& s, float& c) {
    const float jf = rintf(x * 0.636619772f); const int j = (int)jf;
    float r = x - jf * 1.5703125f; r -= jf * 4.837512969970703125e-4f; r -= jf * 7.54978995489188216e-8f;
    const float z = r * r;
    const float sp = r + r * z * (-1.6666654611e-1f + z * (8.3321608736e-3f + z * (-1.9515295891e-4f)));
    const float cp = 1.0f - 0.5f * z + z * z * (4.166664568298827e-2f + z * (-1.388731625493765e-3f + z * 2.443315711809948e-5f));
    const int q = j & 3;
    s = (q == 0) ? sp : (q == 1) ? cp : (q == 2) ? -sp : -cp;
    c = (q == 0) ? cp : (q == 1) ? -sp : (q == 2) ? -cp : sp;
}
__device__ __forceinline__ void s5_disc(const Ctx p, int d, int g, int ps, float& abr, float& abi, float& fre, float& fim) {
    const float lr = PIN(21)[(d * 32 + g) * 64 + ps], li = PIN(22)[(d * 32 + g) * 64 + ps], dt = __expf(PIN(23)[d * 32 + g]);
    const float mag = __expf(lr * dt); float sn, cs; sincos_f(li * dt, sn, cs);
    abr = mag * cs; abi = mag * sn;
    const float den = lr * lr + li * li, nr = abr - 1.0f, ni = abi;
    fre = (nr * lr + ni * li) / den; fim = (ni * lr - nr * li) / den;
}
constexpr int S5_HS_STRIDE = 272, S5_HS_WAVE = 32 * S5_HS_STRIDE;
__device__ __forceinline__ void s5_item(const Ctx p, LAS unsigned char* lds, int sample, int b, int g0) {
    int tid_ = threadIdx.x; asm volatile("" : "+v"(tid_)); const int tid = tid_, w = tid >> 6, lane = tid & 63, d = w & 1, g = g0 + (w >> 1);
    const int T = sample ? T_S : T_CTX, row0 = sample ? MC + b * T_S : b * T_CTX, nch = T / 32;
    LAS unsigned char* Hs = lds + w * S5_HS_WAVE;
    const bf16_t* XS = (const bf16_t*)(p.ws + WS_XS); bf16_t* VS = (bf16_t*)(p.ws + WS_VS);
    const int j31 = lane & 31, hi = lane >> 5;
    float abr1, abi1, fr1, fi1, abr2, abi2, fr2, fi2;
    s5_disc(p, d, g, j31, abr1, abi1, fr1, fi1); s5_disc(p, d, g, 32 + j31, abr2, abi2, fr2, fi2);
    const float abr = hi ? abr2 : abr1, abi = hi ? abi2 : abi1;
    bf16x8 bfr[4];
#pragma unroll
    for (int st = 0; st < 2; ++st) { const int ps = 32 * st + j31; const float fr = st ? fr2 : fr1, fi = st ? fi2 : fi1;
        const float* bre = PIN(24) + ((size_t)(d * 32 + g) * 64 + ps) * 16 + 8 * hi; const float* bim = PIN(25) + ((size_t)(d * 32 + g) * 64 + ps) * 16 + 8 * hi;
#pragma unroll
        for (int e = 0; e < 8; ++e) { const float vr = bre[e], vi = bim[e]; bfr[2 * st][e] = (short)f2bf(fr * vr - fi * vi); bfr[2 * st + 1][e] = (short)f2bf(fr * vi + fi * vr); } }
    const int fh = lane & 15, kq = lane >> 4;
    bf16x8 cfr[4];
#pragma unroll
    for (int ks = 0; ks < 4; ++ks)
#pragma unroll
        for (int e = 0; e < 8; ++e) { const int pp = 16 * ks + 4 * kq + (e >> 1); const size_t ix = ((size_t)(d * 32 + g) * 16 + fh) * 64 + pp;
            cfr[ks][e] = (short)f2bf((e & 1) ? -PIN(27)[ix] : PIN(26)[ix]); }
    const float dsk = PIN(28)[g * 16 + fh];
    const float one = __builtin_fmaf(dsk, 0.f, 1.0f);
    float hr = 0.f, hi_ = 0.f;
    if (sample) { const size_t ix = ((size_t)(b * 2 + d) * 32 + g) * 64 + lane; hr = PIN(4)[ix]; hi_ = PIN(5)[ix]; }
    const int step = (d ? -1 : 1) * (sample ? 64 : 1);
    const int ua_off = step * 512 * j31 + g * 16 + 8 * hi;
    int eoff[8];
#pragma unroll
    for (int e = 0; e < 8; ++e) eoff[e] = step * 512 * (16 * (e >> 2) + 4 * kq + (e & 3)) + g * 16 + fh;
#define S5_CBASE(kk) ({ const int s0_ = d ? T - 1 - 32 * (kk) : 32 * (kk); const int t0_ = sample ? ((s0_ & 63) * 64 + (s0_ >> 6)) : s0_; (size_t)(row0 + t0_) * 512; })
    bf16x8 ua_next = *(const bf16x8*)(XS + S5_CBASE(0) + ua_off);
    for (int k = 0; k < nch; ++k) {
        const bool second = (2 * k >= nch);
        const size_t cbase = S5_CBASE(k);
        const bf16x8 ua = ua_next;
        if (k + 1 < nch) ua_next = *(const bf16x8*)(XS + S5_CBASE(k + 1) + ua_off);
        unsigned short vf16[8], xs16[8];
        if (second) {
#pragma unroll
            for (int mt = 0; mt < 2; ++mt)
#pragma unroll
                for (int r4 = 0; r4 < 4; ++r4) { const size_t ix = cbase + eoff[mt * 4 + r4]; vf16[mt * 4 + r4] = VS[ix]; xs16[mt * 4 + r4] = XS[ix]; } }
        f32x16 acc[4];
#pragma unroll
        for (int nt = 0; nt < 4; ++nt) { f32x16 z;
#pragma unroll
            for (int v = 0; v < 16; ++v) z[v] = 0.f;
            acc[nt] = __builtin_amdgcn_mfma_f32_32x32x16_bf16(ua, bfr[nt], z, 0, 0, 0); }
        float bur[32], bui[32];
#pragma unroll
        for (int v = 0; v < 16; ++v) {
            unsigned r0 = __builtin_bit_cast(unsigned, acc[0][v] * one), r1 = __builtin_bit_cast(unsigned, acc[2][v] * one);
            unsigned q0 = __builtin_bit_cast(unsigned, acc[1][v] * one), q1 = __builtin_bit_cast(unsigned, acc[3][v] * one);
            asm volatile("s_nop 1\n\tv_permlane32_swap_b32 %0, %1" : "+v"(r0), "+v"(r1));
            asm volatile("s_nop 1\n\tv_permlane32_swap_b32 %0, %1" : "+v"(q0), "+v"(q1));
            const int ta = 8 * (v >> 2) + (v & 3);
            bur[ta] = __builtin_bit_cast(float, r0); bur[ta + 4] = __builtin_bit_cast(float, r1);
            bui[ta] = __builtin_bit_cast(float, q0); bui[ta + 4] = __builtin_bit_cast(float, q1); }
#pragma unroll
        for (int tt = 0; tt < 32; ++tt) { const float nr = abr * hr - abi * hi_ + bur[tt], ni = abr * hi_ + abi * hr + bui[tt]; hr = nr; hi_ = ni;
            *(LAS unsigned*)(Hs + tt * S5_HS_STRIDE + 4 * lane) = pk2(hr, hi_); }
        f32x4 ya[2];
#pragma unroll
        for (int mt = 0; mt < 2; ++mt) { ya[mt] = (f32x4){0.f, 0.f, 0.f, 0.f};
#pragma unroll
            for (int ks = 0; ks < 4; ++ks) { const bf16x8 a = *(const LAS bf16x8*)(Hs + (16 * mt + fh) * S5_HS_STRIDE + (32 * ks + 8 * kq) * 2);
                ya[mt] = __builtin_amdgcn_mfma_f32_16x16x32_bf16(a, cfr[ks], ya[mt], 0, 0, 0); } }
#pragma unroll
        for (int mt = 0; mt < 2; ++mt)
#pragma unroll
            for (int r4 = 0; r4 < 4; ++r4) { const size_t ix = cbase + eoff[mt * 4 + r4]; float y = ya[mt][r4];
                if (second) { y = gelu_tanh(y + bf2f(vf16[mt * 4 + r4]) + dsk * bf2f(xs16[mt * 4 + r4])); }
                VS[ix] = f2bf1(y); }
        if (2 * k + 2 == nch) { asm volatile("s_waitcnt vmcnt(0)" ::: "memory"); __syncthreads(); }
    }
#undef S5_CBASE
    if (!sample) { const size_t ix = ((size_t)(b * 2 + d) * 32 + g) * 64 + lane; p.out[OFF_RE + ix] = hr; p.out[OFF_IM + ix] = hi_; }
}
__device__ __forceinline__ void p3_scans(const Ctx p, LAS unsigned char* lds) {
    const int bx = blockIdx.x;
    if (bx < 128) { lru_unit(p, lds, 1, bx >> 4, bx & 15); }
    else if (bx < 192) { const int i = bx - 128; s5_item(p, lds, 1, i >> 3, 4 * (i & 7)); }
    else { const int i = bx - 192;
        for (int e = 0; e < 8; ++e) { const int c = 8 * i + e; lru_unit(p, lds, 0, c >> 4, c & 15); __syncthreads(); }
        for (int e = 0; e < 4; ++e) { const int c = 4 * i + e; s5_item(p, lds, 0, c >> 3, 4 * (c & 7)); __syncthreads(); } }
}

#define XB_TMO      128
#define XB_XCNT(j)  (256  + 64 * (j))
#define XB_XSUB(j)  (1280 + 64 * (j))
#define XB_XGEN(j)  (2304 + 64 * (j))
#define XB_TOP      3328
#define XB_TOPGEN   3392
#define XCD_BAR_WORDS 3456
#define XB_SPIN_CAP (1u << 18)

__device__ __forceinline__ unsigned xb_ld(unsigned* p)              { return __hip_atomic_load(p, __ATOMIC_RELAXED, __HIP_MEMORY_SCOPE_AGENT); }
__device__ __forceinline__ unsigned xb_add(unsigned* p, unsigned v) { return __hip_atomic_fetch_add(p, v, __ATOMIC_RELAXED, __HIP_MEMORY_SCOPE_AGENT); }
__device__ __forceinline__ unsigned xb_xcc_id() { return (unsigned)__builtin_amdgcn_s_getreg((3 << 11) | 20) & 0xFu; }
#define XB_SPIN(cond, bar) do { unsigned _sp = 0; while (cond) { __builtin_amdgcn_s_sleep(1); \
    if ((++_sp & 255u) == 0u) { if (xb_ld(&(bar)[XB_TMO])) break; if (_sp > XB_SPIN_CAP) { atomicAdd(&(bar)[XB_TMO], 1u); break; } } } } while (0)

struct XcdBarrier {
    unsigned* bar; unsigned x;
    volatile LAS unsigned* st;
};

__device__ __forceinline__ XcdBarrier xcd_barrier_post(unsigned* bar, volatile LAS unsigned* st) {
    XcdBarrier b; b.bar = bar; b.x = xb_xcc_id(); b.st = st;
    if (threadIdx.x == 0) (void)xb_add(&bar[XB_XCNT(b.x)], 1u);
    return b;
}
__device__ __forceinline__ void xcd_barrier_complete(unsigned* bar, unsigned x, unsigned& nloc, unsigned& nx) {
    const unsigned G = gridDim.x * gridDim.y * gridDim.z;
    unsigned sum, cnt, mine, sp = 0u;
    for (;;) {
        sum = 0u; cnt = 0u; mine = 0u;
#pragma unroll
        for (unsigned j = 0; j < 16; ++j) { const unsigned c = xb_ld(&bar[XB_XCNT(j)]); sum += c; cnt += (c > 0u) ? 1u : 0u; mine = (j == x) ? c : mine; }
        if (sum == G) break;
        __builtin_amdgcn_s_sleep(1);
        if ((++sp & 255u) == 0u) { if (xb_ld(&bar[XB_TMO])) break; if (sp > XB_SPIN_CAP) { atomicAdd(&bar[XB_TMO], 1u); break; } }
    }
    nloc = mine > 0u ? mine : 1u; nx = cnt > 0u ? cnt : 1u;
}

__device__ __forceinline__ void xcd_barrier(const XcdBarrier& b) {
    asm volatile("s_waitcnt vmcnt(0)" ::: "memory");
    __syncthreads();
    if (threadIdx.x == 0) {
        unsigned* bar = b.bar;
        __builtin_amdgcn_s_waitcnt(0);
        unsigned nloc = b.st[0], nx = b.st[1];
        if (nloc == 0u) { xcd_barrier_complete(bar, b.x, nloc, nx); b.st[0] = nloc; b.st[1] = nx; }
        const unsigned old = xb_add(&bar[XB_XSUB(b.x)], 1u);
        const unsigned gen = old / nloc;
        if (old + 1u == (gen + 1u) * nloc) {
            __builtin_amdgcn_fence(__ATOMIC_RELEASE, "agent");
            asm volatile("s_waitcnt vmcnt(0)" ::: "memory");
            const unsigned og = xb_add(&bar[XB_TOP], 1u);
            const unsigned tg = og / nx;
            if (og + 1u == (tg + 1u) * nx) xb_add(&bar[XB_TOPGEN], 1u);
            else XB_SPIN(xb_ld(&bar[XB_TOPGEN]) == tg, bar);
            __builtin_amdgcn_fence(__ATOMIC_ACQUIRE, "agent");
            xb_add(&bar[XB_XGEN(b.x)], 1u);
            asm volatile("s_waitcnt vmcnt(0)" ::: "memory");
        } else {
            XB_SPIN(xb_ld(&bar[XB_XGEN(b.x)]) == gen, bar);
            __builtin_amdgcn_fence(__ATOMIC_ACQUIRE, "agent");
            asm volatile("s_waitcnt vmcnt(0)" ::: "memory");
        }
    }
    __syncthreads();
}

#define GRID_SYNC() do { asm volatile("s_waitcnt vmcnt(0)" ::: "memory"); grid.sync(); if (threadIdx.x < 64) { __builtin_amdgcn_fence(__ATOMIC_ACQUIRE, "agent"); asm volatile("s_waitcnt vmcnt(0)" ::: "memory"); } __syncthreads(); } while (0)
__global__ void __launch_bounds__(512, 2) fwd_mega(Params kp) {
    extern __shared__ __attribute__((aligned(16))) unsigned char lds_raw[];
    LAS unsigned char* lds = (LAS unsigned char*)lds_raw;
    {   LAS unsigned long long* t_ = (LAS unsigned long long*)(lds + LDS_BYTES - 512);
        if (threadIdx.x == 0) { t_[0] = (unsigned long long)kp.in[0]; t_[1] = (unsigned long long)kp.in[1]; t_[2] = (unsigned long long)kp.in[2]; t_[3] = (unsigned long long)kp.in[3]; t_[4] = (unsigned long long)kp.in[4]; t_[5] = (unsigned long long)kp.in[5]; t_[6] = (unsigned long long)kp.in[6]; t_[7] = (unsigned long long)kp.in[7]; t_[8] = (unsigned long long)kp.in[8]; t_[9] = (unsigned long long)kp.in[9]; t_[10] = (unsigned long long)kp.in[10]; t_[11] = (unsigned long long)kp.in[11]; t_[12] = (unsigned long long)kp.in[12]; t_[13] = (unsigned long long)kp.in[13]; t_[14] = (unsigned long long)kp.in[14]; t_[15] = (unsigned long long)kp.in[15]; t_[16] = (unsigned long long)kp.in[16]; t_[17] = (unsigned long long)kp.in[17]; t_[18] = (unsigned long long)kp.in[18]; t_[19] = (unsigned long long)kp.in[19]; t_[20] = (unsigned long long)kp.in[20]; t_[21] = (unsigned long long)kp.in[21]; t_[22] = (unsigned long long)kp.in[22]; t_[23] = (unsigned long long)kp.in[23]; t_[24] = (unsigned long long)kp.in[24]; t_[25] = (unsigned long long)kp.in[25]; t_[26] = (unsigned long long)kp.in[26]; t_[27] = (unsigned long long)kp.in[27]; t_[28] = (unsigned long long)kp.in[28]; t_[29] = (unsigned long long)kp.in[29]; t_[30] = (unsigned long long)kp.in[30]; t_[31] = (unsigned long long)kp.in[31]; t_[32] = (unsigned long long)kp.in[32]; t_[33] = (unsigned long long)kp.in[33]; t_[34] = (unsigned long long)kp.in[34]; t_[35] = (unsigned long long)kp.in[35]; t_[36] = (unsigned long long)kp.in[36]; t_[37] = (unsigned long long)kp.in[37]; }
        __syncthreads(); }
    Ctx p; p.tbl = (const LAS unsigned long long*)(lds + LDS_BYTES - 512); p.out = kp.out; p.ws = kp.ws;
    cg::grid_group grid = cg::this_grid();
    unsigned char* ws = p.ws; const int G = gridDim.x, bx = blockIdx.x;
    bf16_t* GATE = (bf16_t*)p.out;
    volatile LAS unsigned* xst = (volatile LAS unsigned*)(lds + LDS_BYTES - 512 - 16);
    if (threadIdx.x < 4) xst[threadIdx.x] = 0u;
    __syncthreads();
    const XcdBarrier xb = xcd_barrier_post((unsigned*)(ws + 768 * 1024), xst);
#define GRID_BAR() xcd_barrier(xb)
    p0_prologue(p, lds);
    if (G == 0x7fffffff) GRID_SYNC();
    GRID_BAR();
    p1_hn(p);
    GRID_BAR();
    {
        pg8::Gemm g2{(const bf16_t*)(ws + WS_HN), (const bf16_t*)(ws + WS_W1T) + (size_t)2560 * 1024, MT, 2048, 1024}; pg8::ListOrder S2; S2.init(MT, 2048, G, bx); S2.base = bx; S2.stride = 256; S2.count = 3; S2.extra = bx >= 64 ? 768 + (bx - 64) : -1;
        pg8::EpiGate E2{GATE, PIN(34)};
        pg8::gemm_phase<pg8::EpiGate, pg8::ListOrder>(lds, g2, S2, E2);
        pg8::Gemm g{(const bf16_t*)(ws + WS_HN), (const bf16_t*)(ws + WS_W1T), MT, 2560, 1024}; pg8::StaticOrder S; S.init(MT, 2560, G, bx);
        pg8::Epi1 E{(bf16_t*)(ws + WS_XA), (bf16_t*)(ws + WS_GA), (bf16_t*)(ws + WS_XS)};
        pg8::gemm_phase<pg8::Epi1, pg8::StaticOrder>(lds, g, S, E); }
    GRID_BAR();
    p3_scans(p, lds);
    if (bx < 128 || bx >= 192) {
        __syncthreads();
        pg8::Gemm g2{(const bf16_t*)(ws + WS_HN), (const bf16_t*)(ws + WS_W1T) + (size_t)2560 * 1024, MT, 2048, 1024}; pg8::ListOrder S2; S2.init(MT, 2048, G, bx);
        S2.extra = -1; if (bx >= 192) { S2.base = 1088 + (bx - 192); S2.stride = 64; S2.count = 3; } else { S2.base = 960 + bx; S2.stride = 1; S2.count = 1; }
        pg8::EpiGate E2{GATE, PIN(34)};
        pg8::gemm_phase<pg8::EpiGate, pg8::ListOrder>(lds, g2, S2, E2);
    }
    GRID_BAR();
    {
        pg8::StaticOrder S; S.init(MT, 1024, G, bx);
        pg8::Gemm ga{(const bf16_t*)(ws + WS_YA), (const bf16_t*)(ws + WS_WPL), MT, 1024, 1024};
        pg8::EpiMerge<0> Ea{GATE, (bf16_t*)(ws + WS_TMP), (bf16_t*)(ws + WS_MPRE)};
        pg8::gemm_phase<pg8::EpiMerge<0>, pg8::StaticOrder>(lds, ga, S, Ea);
        pg8::Gemm g{(const bf16_t*)(ws + WS_VS), (const bf16_t*)(ws + WS_WGLU), MT, 512, 512}; pg8::StaticOrder S4; S4.init(MT, 512, G, (bx + 128) & 255);
        pg8::EpiGlu E{(const bf16_t*)(ws + WS_VS), (bf16_t*)(ws + WS_YS), PIN(30)};
        pg8::gemm_phase<pg8::EpiGlu, pg8::StaticOrder>(lds, g, S4, E); }
    GRID_BAR();
    {   pg8::StaticOrder S; S.init(MT, 1024, G, bx);
        pg8::Gemm gb{(const bf16_t*)(ws + WS_YS), (const bf16_t*)(ws + WS_WPS), MT, 1024, 512};
        pg8::EpiMerge<1> Eb{GATE, (bf16_t*)(ws + WS_TMP), (bf16_t*)(ws + WS_MPRE)};
        pg8::gemm_phase<pg8::EpiMerge<1>, pg8::StaticOrder>(lds, gb, S, Eb);
        if (bx >= 128) copy_tiles(p, lds, 3200, 3904, bx - 128, 128); }
    GRID_BAR();
    {   pg8::Gemm g{(const bf16_t*)(ws + WS_MPRE), (const bf16_t*)(ws + WS_WOUT), MT, 1024, 1024}; pg8::StaticOrder S; S.init(MT, 1024, G, bx);
        pg8::EpiOutSS E{(bf16_t*)(ws + WS_MO), (float*)(ws + WS_SSP1)};
        pg8::gemm_phase<pg8::EpiOutSS, pg8::StaticOrder>(lds, g, S, E);
        if (bx >= 128) copy_tiles(p, lds, 1792, 3200, bx - 128, 128); }
    GRID_BAR();
    p7_x1(p);
    GRID_BAR();
    {   pg8::Gemm g{(const bf16_t*)(ws + WS_HN2), (const bf16_t*)(ws + WS_WFI), MT, 2 * DFF, 1024}; pg8::StaticOrder S; S.init(MT, 2 * DFF, G, bx);
        pg8::EpiFF E{(bf16_t*)(ws + WS_HID)};
        pg8::gemm_phase<pg8::EpiFF, pg8::StaticOrder>(lds, g, S, E); }
    GRID_BAR();
    {
        pg8::Gemm g{(const bf16_t*)(ws + WS_HID), (const bf16_t*)(ws + WS_WFO), MT, 1024, DFF}; pg8::StaticOrder S; S.init(128 * 256, 1024, G, bx);
        pg8::EpiPlain E{(bf16_t*)(ws + WS_FO)};
        pg8::gemm_phase<pg8::EpiPlain, pg8::StaticOrder>(lds, g, S, E);
        const int tile = bx >> 1, kh = bx & 1;
        pg8::Gemm gh{(const bf16_t*)(ws + WS_HID) + kh * (DFF / 2), (const bf16_t*)(ws + WS_WFO) + kh * (DFF / 2), MT, 1024, DFF / 2, DFF};
        pg8::OneUnit S1{128 + (tile >> 2), tile & 3};
        pg8::EpiPlain Eh{(bf16_t*)(ws + (kh ? WS_FOB : WS_FO))};
        pg8::gemm_phase<pg8::EpiPlain, pg8::OneUnit>(lds, gh, S1, Eh); }
    GRID_BAR();
    p10_out(p);
}

extern "C" void kernel_launch(void* const* d_in, const int* in_sizes, int n_in, void* d_out, int out_size, void* d_ws, size_t ws_size, hipStream_t stream) {
    static int grid = 0;
    if (grid == 0) {
        if (n_in != 38 || (size_t)out_size != OFF_IM + 32 * 2 * 32 * 64 || ws_size < WS_END) { fprintf(stderr, "kernel_launch: unexpected shapes (n_in %d out %d ws %zu)\n", n_in, out_size, ws_size); grid = -1; return; }
        int dev = 0, cus = 0, per_cu = 0;
        hipGetDevice(&dev); hipDeviceGetAttribute(&cus, hipDeviceAttributeMultiprocessorCount, dev);
        if (hipFuncSetAttribute((const void*)fwd_mega, hipFuncAttributeMaxDynamicSharedMemorySize, LDS_BYTES) != hipSuccess) { fprintf(stderr, "kernel_launch: hipFuncSetAttribute failed\n"); grid = -1; return; }
        if (hipOccupancyMaxActiveBlocksPerMultiprocessor(&per_cu, (const void*)fwd_mega, 512, LDS_BYTES) != hipSuccess || per_cu < 1) { fprintf(stderr, "kernel_launch: occupancy query says %d blocks/CU\n", per_cu); grid = -1; return; }
        if (cus < 256) { fprintf(stderr, "kernel_launch: needs 256 CUs, device has %d\n", cus); grid = -1; return; }
        grid = 256;
    }
    if (grid < 0) return;
    Params p{};
    for (int i = 0; i < 38; ++i) p.in[i] = (const float*)d_in[i];
    p.out = (float*)d_out; p.ws = (unsigned char*)d_ws;
    if (hipMemsetAsync((char*)d_ws + 768 * 1024, 0, XCD_BAR_WORDS * 4, stream) != hipSuccess) { fprintf(stderr, "kernel_launch: hipMemsetAsync of the barrier word failed\n"); return; }
    void* args[] = {&p};
    hipError_t e = hipLaunchCooperativeKernel((const void*)fwd_mega, dim3(grid), dim3(512), args, LDS_BYTES, stream);
    if (e != hipSuccess) fprintf(stderr, "cooperative launch failed: %s\n", hipGetErrorString(e));
}
```

```cpp
#include <hip/hip_runtime.h>
#include <hip/hip_cooperative_groups.h>
#include <cstdio>
#include <cstdint>
namespace cg = cooperative_groups;

#define LAS __attribute__((address_space(3)))
typedef unsigned short bf16_t;
typedef short bf16x8 __attribute__((ext_vector_type(8)));
typedef float f32x4 __attribute__((ext_vector_type(4)));
typedef float f32x16 __attribute__((ext_vector_type(16)));
typedef float f32x2 __attribute__((ext_vector_type(2)));
typedef unsigned u32x4 __attribute__((ext_vector_type(4)));
typedef unsigned u32x2 __attribute__((ext_vector_type(2)));

constexpr int DM = 1024, MC = 8192, MS = 32768, MT = MC + MS;
constexpr int NB_CTX = 32, T_CTX = 256, NB_S = 8, T_S = 4096;
constexpr int DFF = 2816, DS5 = 512;
constexpr float EPS = 1e-6f;
constexpr size_t OFF_LRU = (size_t)MT * DM, OFF_RE = OFF_LRU + 32 * 2 * 1024, OFF_IM = OFF_RE + 32 * 2 * 32 * 64;
constexpr size_t MiB = 1u << 20;
constexpr size_t WS_MOD = 512 * 1024;
constexpr size_t WS_W1T = 1 * MiB, WS_WPL = 10 * MiB, WS_WPS = 12 * MiB, WS_WOUT = 13 * MiB, WS_WFI = 15 * MiB, WS_WFO = 26 * MiB, WS_WGLU = 31 * MiB + 512 * 1024;
constexpr size_t WS_HN = 32 * MiB, WS_XA = 112 * MiB, WS_XS = 192 * MiB, WS_VS = 232 * MiB, WS_YA = 272 * MiB, WS_GA = 352 * MiB, WS_SSP1 = 432 * MiB, WS_SSP2 = 435 * MiB, WS_END = 438 * MiB;
constexpr size_t WS_TMP = WS_HN, WS_MPRE = WS_GA, WS_MO = WS_HN, WS_HN2 = WS_GA, WS_HID = WS_HN, WS_FO = WS_YA, WS_FOB = WS_GA, WS_YS = WS_XS;
constexpr int LDS_BYTES = 147456;

struct Params { const float* in[38]; float* out; unsigned char* ws; };
struct Ctx { const LAS unsigned long long* tbl; float* out; unsigned char* ws; };
__device__ __forceinline__ const float* inp_(const LAS unsigned long long* tbl, int i) { const unsigned long long v = tbl[i];
    const unsigned lo = __builtin_amdgcn_readfirstlane((unsigned)v), hi = __builtin_amdgcn_readfirstlane((unsigned)(v >> 32)); return (const float*)(const __attribute__((address_space(1))) float*)(((unsigned long long)hi << 32) | lo); }
#define PIN(i) inp_(p.tbl, (i))

__device__ __forceinline__ unsigned f2bf(float f) { unsigned u = __builtin_bit_cast(unsigned, f); return (u + 0x7fffu + ((u >> 16) & 1u)) >> 16; }
__device__ __forceinline__ unsigned pk2(float lo, float hi) { unsigned r; asm volatile("s_nop 1\n\tv_cvt_pk_bf16_f32 %0, %1, %2" : "=v"(r) : "v"(lo), "v"(hi)); return r; }
__device__ __forceinline__ bf16_t f2bf1(float x) { return (bf16_t)(pk2(x, 0.f) & 0xffffu); }
__device__ __forceinline__ float bf_lo(unsigned w) { return __builtin_bit_cast(float, w << 16); }
__device__ __forceinline__ float bf_hi(unsigned w) { return __builtin_bit_cast(float, w & 0xffff0000u); }
__device__ __forceinline__ float bf2f(bf16_t h) { return __builtin_bit_cast(float, ((unsigned)h) << 16); }
__device__ __forceinline__ float sigmoidf_(float x) { return __builtin_amdgcn_rcpf(1.0f + __builtin_amdgcn_exp2f(-1.44269504089f * x)); }
__device__ __forceinline__ float siluf_(float x) { return x * sigmoidf_(x); }
__device__ __forceinline__ float gelu_tanh(float x) { const float u = x + 0.044715f * x * x * x; return x * __builtin_amdgcn_rcpf(1.0f + __builtin_amdgcn_exp2f(-2.30220819f * u)); }
__device__ __forceinline__ const float* xrow(const Ctx p, int r) { return r < MC ? PIN(0) + (size_t)r * DM : PIN(1) + (size_t)(r - MC) * DM; }
__device__ __forceinline__ int mod_index(int r) { return r < MC ? 0 : 1 + ((r - MC) >> 12); }
namespace pg8 {
#define PG8_LAS __attribute__((address_space(3)))
constexpr int BM = 256, BK = 64, HALF = 128, HTB = HALF * BK * 2  , STAGE_BYTES = 8 * HTB, NXCD = 8, WGM = 8;
__host__ __device__ __forceinline__ int lds_byte(int r, int c) { const int st = (r >> 4) * 2 + (c >> 5), rr = r & 15, cc = c & 31, ob = rr * 64 + cc * 2; return st * 1024 + (ob ^ (((ob >> 9) & 1) << 5)); }
__host__ __device__ __forceinline__ void stage_rc(int b, int& R, int& C) { const int st = b / 1024, sb = b % 1024, swz = sb ^ (((sb >> 9) & 1) << 5); R = (st >> 1) * 16 + swz / 64; C = (st & 1) * 32 + (swz % 64) / 2; }
__host__ __device__ __forceinline__ int perm32(int rho) { const int n = rho >> 4, i = rho & 15; return 8 * (i >> 2) + 4 * n + (i & 3); }
struct Unit { int pm, pn; };
struct Gemm { const bf16_t* A; const bf16_t* Bt; int M, N, K; int ld = 0; };
struct StaticOrder {
    int nM, nN, nwg, G, c;
    __host__ __device__ void init(int M, int N, int G_, int c_) { nM = M / BM; nN = N / BM; nwg = nM * nN; G = G_; c = c_; }
    __host__ __device__ bool next(int i, Unit& u) const {
        const long L = (long)i * G + c; if (L >= nwg) return false;
        int wgid = (int)L; { const int q = nwg / NXCD, r = nwg % NXCD, xcd = wgid % NXCD, off = wgid / NXCD; wgid = (xcd < r ? xcd * (q + 1) : r * (q + 1) + (xcd - r) * q) + off; }
        const int nig = WGM * nN, gid = wgid / nig, fm = gid * WGM, gsz = (nM - fm) < WGM ? (nM - fm) : WGM;
        u.pm = fm + ((wgid % nig) % gsz); u.pn = (wgid % nig) / gsz; return true;
    }
    __device__ __forceinline__ void a_ready(const Unit&) const {}
    __device__ __forceinline__ void done(const Unit&) const {}
};
struct ListOrder : StaticOrder {
    int base, stride, count, extra;
    __host__ __device__ bool next(int i, Unit& u) const {
        if (i > count || (i == count && extra < 0)) return false;
        const long L = (i < count) ? (long)base + (long)i * stride : (long)extra; if (L >= nwg) return false;
        int wgid = (int)L; { const int q = nwg / NXCD, r = nwg % NXCD, xcd = wgid % NXCD, off = wgid / NXCD; wgid = (xcd < r ? xcd * (q + 1) : r * (q + 1) + (xcd - r) * q) + off; }
        const int nig = WGM * nN, gid = wgid / nig, fm = gid * WGM, gsz = (nM - fm) < WGM ? (nM - fm) : WGM;
        u.pm = fm + ((wgid % nig) % gsz); u.pn = (wgid % nig) / gsz; return true;
    }
};
__device__ __forceinline__ unsigned cvt_pk_bf16(float lo, float hi) { unsigned r; asm volatile("s_nop 1\n\tv_cvt_pk_bf16_f32 %0, %1, %2" : "=v"(r) : "v"(lo), "v"(hi)); return r; }
__device__ __forceinline__ u32x4 pack8(const f32x4 a, const f32x4 b) { u32x4 w; w.x = cvt_pk_bf16(a[0], a[1]); w.y = cvt_pk_bf16(a[2], a[3]); w.z = cvt_pk_bf16(b[0], b[1]); w.w = cvt_pk_bf16(b[2], b[3]); return w; }
__device__ __forceinline__ void unpack8(const u32x4 w, f32x4& a, f32x4& b) { a = (f32x4){bf_lo(w.x), bf_hi(w.x), bf_lo(w.y), bf_hi(w.y)}; b = (f32x4){bf_lo(w.z), bf_hi(w.z), bf_lo(w.w), bf_hi(w.w)}; }

#define EPI_LOOP_BEGIN \
    _Pragma("unroll") for (int ai = 0; ai < 2; ++ai) _Pragma("unroll") for (int m = 0; m < 4; ++m) { const int row = u.pm * BM + ai * HALF + wr * 64 + m * 16 + fr; \
    _Pragma("unroll") for (int bj = 0; bj < 2; ++bj) { const int ct = bj * HALF + wc * 32 + 8 * fq; f32x4 v0 = acc[ai][bj][m][0], v1 = acc[ai][bj][m][1];
#define EPI_LOOP_END } }

struct Epi1 {
    static constexpr bool PERM = true, AFTER_DRAIN = false;
    bf16_t* XA; bf16_t* GA; bf16_t* XS;
    __device__ __forceinline__ void operator()(const f32x4 (&acc)[2][2][4][2], const Unit& u, int wr, int wc, int fr, int fq) const {
        const int pn = u.pn;
        if (pn < 4) {
            EPI_LOOP_BEGIN *(u32x4*)(XA + (size_t)row * 1024 + pn * 256 + ct) = pack8(v0, v1); EPI_LOOP_END
        } else if (pn < 8) {
            EPI_LOOP_BEGIN
#pragma unroll
                for (int j = 0; j < 4; ++j) { v0[j] = gelu_tanh(v0[j]); v1[j] = gelu_tanh(v1[j]); }
                *(u32x4*)(GA + (size_t)row * 1024 + (pn - 4) * 256 + ct) = pack8(v0, v1); EPI_LOOP_END
        } else {
            EPI_LOOP_BEGIN *(u32x4*)(XS + (size_t)row * 512 + (pn - 8) * 256 + ct) = pack8(v0, v1); EPI_LOOP_END
        }
    }
};
struct EpiGate {
    static constexpr bool PERM = true, AFTER_DRAIN = false;
    bf16_t* GATE; const float* bgate;
    __device__ __forceinline__ void operator()(const f32x4 (&acc)[2][2][4][2], const Unit& u, int wr, int wc, int fr, int fq) const {
        const int cb = u.pn * 256;
#pragma unroll
        for (int bj = 0; bj < 2; ++bj) { const int ct = bj * HALF + wc * 32 + 8 * fq;
            const f32x4 b0 = *(const f32x4*)(bgate + cb + ct), b1 = *(const f32x4*)(bgate + cb + ct + 4);
#pragma unroll
            for (int ai = 0; ai < 2; ++ai)
#pragma unroll
                for (int m = 0; m < 4; ++m) { const int row = u.pm * BM + ai * HALF + wr * 64 + m * 16 + fr; f32x4 v0 = acc[ai][bj][m][0], v1 = acc[ai][bj][m][1];
#pragma unroll
                    for (int j = 0; j < 4; ++j) { v0[j] = 1.0f - sigmoidf_(-(v0[j] + b0[j])); v1[j] = 1.0f - sigmoidf_(-(v1[j] + b1[j])); }
                    *(u32x4*)(GATE + (size_t)row * 2048 + cb + ct) = pack8(v0, v1); } }
    }
};
struct EpiGlu {
    static constexpr bool PERM = true, AFTER_DRAIN = false;
    const bf16_t* VS; bf16_t* YS; const float* bglu;
    __device__ __forceinline__ void operator()(const f32x4 (&acc)[2][2][4][2], const Unit& u, int wr, int wc, int fr, int fq) const {
        const int cb = u.pn * 256;
        f32x4 bb[2][2];
#pragma unroll
        for (int bj = 0; bj < 2; ++bj) { const int ct = bj * HALF + wc * 32 + 8 * fq; bb[bj][0] = *(const f32x4*)(bglu + cb + ct); bb[bj][1] = *(const f32x4*)(bglu + cb + ct + 4); }
#pragma unroll
        for (int ai = 0; ai < 2; ++ai) { u32x4 sv[4][2];
#pragma unroll
            for (int m = 0; m < 4; ++m)
#pragma unroll
                for (int bj = 0; bj < 2; ++bj) sv[m][bj] = *(const u32x4*)(VS + (size_t)(u.pm * BM + ai * HALF + wr * 64 + m * 16 + fr) * 512 + cb + bj * HALF + wc * 32 + 8 * fq);
            asm volatile("s_waitcnt vmcnt(0)" ::: "memory");
#pragma unroll
            for (int m = 0; m < 4; ++m)
#pragma unroll
                for (int bj = 0; bj < 2; ++bj) { const int row = u.pm * BM + ai * HALF + wr * 64 + m * 16 + fr, ct = bj * HALF + wc * 32 + 8 * fq; f32x4 v0 = acc[ai][bj][m][0], v1 = acc[ai][bj][m][1], s0, s1; unpack8(sv[m][bj], s0, s1);
#pragma unroll
                    for (int j = 0; j < 4; ++j) { v0[j] = s0[j] * sigmoidf_(v0[j] + bb[bj][0][j]); v1[j] = s1[j] * sigmoidf_(v1[j] + bb[bj][1][j]); }
                    *(u32x4*)(YS + (size_t)row * 512 + cb + ct) = pack8(v0, v1); } }
    }
};
template <int STEP> struct EpiMerge {
    static constexpr bool PERM = true, AFTER_DRAIN = false;
    const bf16_t* GATE; bf16_t* TMP; bf16_t* MPRE;
    __device__ __forceinline__ void operator()(const f32x4 (&acc)[2][2][4][2], const Unit& u, int wr, int wc, int fr, int fq) const {
        const int cb = u.pn * 256;
#pragma unroll
        for (int ai = 0; ai < 2; ++ai) { u32x4 gv[4][2], tv[4][2];
#pragma unroll
            for (int m = 0; m < 4; ++m)
#pragma unroll
                for (int bj = 0; bj < 2; ++bj) { const size_t row = (size_t)(u.pm * BM + ai * HALF + wr * 64 + m * 16 + fr); const int ct = bj * HALF + wc * 32 + 8 * fq;
                    gv[m][bj] = *(const u32x4*)(GATE + row * 2048 + STEP * 1024 + cb + ct); if (STEP == 1) tv[m][bj] = *(const u32x4*)(TMP + row * 1024 + cb + ct); }
            asm volatile("s_waitcnt vmcnt(0)" ::: "memory");
#pragma unroll
            for (int m = 0; m < 4; ++m)
#pragma unroll
                for (int bj = 0; bj < 2; ++bj) { const size_t row = (size_t)(u.pm * BM + ai * HALF + wr * 64 + m * 16 + fr); const int ct = bj * HALF + wc * 32 + 8 * fq;
                    const f32x4 v0 = acc[ai][bj][m][0], v1 = acc[ai][bj][m][1]; f32x4 g0, g1; unpack8(gv[m][bj], g0, g1);
                    if (STEP == 0) { *(u32x4*)(TMP + row * 1024 + cb + ct) = pack8(g0 * v0, g1 * v1); }
                    else { f32x4 t0, t1; unpack8(tv[m][bj], t0, t1); *(u32x4*)(MPRE + row * 1024 + cb + ct) = pack8(t0 + g0 * v0, t1 + g1 * v1); } } }
    }
};
struct EpiOutSS {
    static constexpr bool PERM = true, AFTER_DRAIN = false;
    bf16_t* O; float* rowss;
    __device__ __forceinline__ void operator()(const f32x4 (&acc)[2][2][4][2], const Unit& u, int wr, int wc, int fr, int fq) const {
        const int cb = u.pn * 256;
#pragma unroll
        for (int ai = 0; ai < 2; ++ai)
#pragma unroll
            for (int m = 0; m < 4; ++m) { const int row = u.pm * BM + ai * HALF + wr * 64 + m * 16 + fr; float ss = 0.f;
#pragma unroll
                for (int bj = 0; bj < 2; ++bj) { const int ct = bj * HALF + wc * 32 + 8 * fq; const f32x4 v0 = acc[ai][bj][m][0], v1 = acc[ai][bj][m][1];
                    ss += (v0[0] * v0[0] + v0[1] * v0[1]) + (v0[2] * v0[2] + v0[3] * v0[3]) + (v1[0] * v1[0] + v1[1] * v1[1]) + (v1[2] * v1[2] + v1[3] * v1[3]);
                    *(u32x4*)(O + (size_t)row * 1024 + cb + ct) = pack8(v0, v1); }
                ss += __shfl_xor(ss, 16); ss += __shfl_xor(ss, 32);
                if (fq == 0) rowss[((size_t)u.pn * MT + row) * 4 + wc] = ss; }
    }
};
struct EpiPlain {
    static constexpr bool PERM = true, AFTER_DRAIN = false;
    bf16_t* O;
    __device__ __forceinline__ void operator()(const f32x4 (&acc)[2][2][4][2], const Unit& u, int wr, int wc, int fr, int fq) const {
        const int cb = u.pn * 256;
        EPI_LOOP_BEGIN *(u32x4*)(O + (size_t)row * 1024 + cb + ct) = pack8(v0, v1); EPI_LOOP_END
    }
};
struct OneUnit { int pm, pn;
    __device__ __forceinline__ bool next(int i, Unit& u) const { if (i) return false; u.pm = pm; u.pn = pn; return true; }
    __device__ __forceinline__ void a_ready(const Unit&) const {}
    __device__ __forceinline__ void done(const Unit&) const {} };
struct EpiFF {
    static constexpr bool PERM = true, AFTER_DRAIN = false;
    bf16_t* HID;
    __device__ __forceinline__ void operator()(const f32x4 (&acc)[2][2][4][2], const Unit& u, int wr, int wc, int fr, int fq) const {
#pragma unroll
        for (int ai = 0; ai < 2; ++ai)
#pragma unroll
            for (int m = 0; m < 4; ++m) { const int row = u.pm * BM + ai * HALF + wr * 64 + m * 16 + fr;
                f32x4 a0 = acc[ai][0][m][0], a1 = acc[ai][0][m][1]; const f32x4 g0 = acc[ai][1][m][0], g1 = acc[ai][1][m][1];
#pragma unroll
                for (int j = 0; j < 4; ++j) { a0[j] = siluf_(a0[j]) * g0[j]; a1[j] = siluf_(a1[j]) * g1[j]; }
                *(u32x4*)(HID + (size_t)row * DFF + u.pn * 128 + wc * 32 + 8 * fq) = pack8(a0, a1); }
    }
};
template <class Epi, class Sched>
__device__ __forceinline__ void gemm_phase(PG8_LAS unsigned char* lds, const Gemm g, const Sched& S, const Epi& E) {
    int tid_ = threadIdx.x; asm volatile("" : "+v"(tid_));
    const int tid = tid_, wid = __builtin_amdgcn_readfirstlane(tid >> 6), lane = tid & 63, wr = wid >> 2, wc = wid & 3, fr = lane & 15, fq = lane >> 4;
    const int K = g.K, nt = K / BK, LD = g.ld ? g.ld : g.K;
    unsigned voffA[2], voffB[2];
#pragma unroll
    for (int i = 0; i < 2; ++i) { int R, C; stage_rc(tid * 16 + i * 8192, R, C); const int Rb = Epi::PERM ? ((R & ~31) + perm32(R & 31)) : R;
        voffA[i] = (unsigned)(R * LD + C) * 2u; voffB[i] = (unsigned)(Rb * LD + C) * 2u; }
    const size_t kstep = (size_t)(BK * 2);
    const size_t hstep = (size_t)HALF * LD * 2;
    const size_t tstep = 2 * hstep;
    const unsigned ldsw = (unsigned)wid * 1024u;
    const int aoff = lds_byte(wr * 64 + fr, fq * 8), boff = lds_byte(wc * 32 + fr, fq * 8);
#define PG8_SA(b, h) (((b) * 2 + (h)) * HTB)
#define PG8_SB(b, h) ((4 + (b) * 2 + (h)) * HTB)
#define PG8_STAGE(bufoff, gbase, voff) do { _Pragma("unroll") for (int _i = 0; _i < 2; ++_i) \
        __builtin_amdgcn_global_load_lds((const unsigned*)((const char*)(gbase) + (voff)[_i]), (PG8_LAS unsigned*)(lds + (bufoff) + ldsw + _i * 8192), 16, 0, 0); } while (0)
#define PG8_LDA(dst, b, h) do { _Pragma("unroll") for (int m = 0; m < 4; ++m) _Pragma("unroll") for (int k = 0; k < 2; ++k) dst[m][k] = *(const PG8_LAS bf16x8*)(lds + PG8_SA(b, h) + aoff + m * 2048 + k * 1024); } while (0)
#define PG8_LDB(dst, b, h) do { _Pragma("unroll") for (int n = 0; n < 2; ++n) _Pragma("unroll") for (int k = 0; k < 2; ++k) dst[n][k] = *(const PG8_LAS bf16x8*)(lds + PG8_SB(b, h) + boff + n * 2048 + k * 1024); } while (0)
#define PG8_MMA(ai, bj, At, Bt) do { __builtin_amdgcn_s_setprio(1); _Pragma("unroll") for (int m = 0; m < 4; ++m) _Pragma("unroll") for (int n = 0; n < 2; ++n) _Pragma("unroll") for (int k = 0; k < 2; ++k) \
        acc[ai][bj][m][n] = __builtin_amdgcn_mfma_f32_16x16x32_bf16(Bt[n][k], At[m][k], acc[ai][bj][m][n], 0, 0, 0); __builtin_amdgcn_s_setprio(0); } while (0)
#define PG8_WAIT_V(n) asm volatile("s_waitcnt vmcnt(" #n ")" ::: "memory")
#define PG8_WAIT_L(n) asm volatile("s_waitcnt lgkmcnt(" #n ")" ::: "memory")
#define PG8_BAR __builtin_amdgcn_s_barrier()
#define PG8_SCHED __builtin_amdgcn_sched_barrier(0)
    Unit cur, nxt; int ui = 0;
    if (!S.next(0, cur)) return;
    f32x4 acc[2][2][4][2];
#pragma unroll
    for (int a = 0; a < 2; ++a)
#pragma unroll
        for (int b = 0; b < 2; ++b)
#pragma unroll
            for (int m = 0; m < 4; ++m)
#pragma unroll
                for (int n = 0; n < 2; ++n) acc[a][b][m][n] = (f32x4){0.f, 0.f, 0.f, 0.f};
    bf16x8 At[4][2], B0[2][2], B1[2][2];
    const char* cA = (const char*)g.A + (size_t)cur.pm * tstep; const char* cB = (const char*)g.Bt + (size_t)cur.pn * tstep;
    S.a_ready(cur);
    PG8_STAGE(PG8_SB(0, 0), cB, voffB); PG8_STAGE(PG8_SA(0, 0), cA, voffA); PG8_STAGE(PG8_SB(0, 1), cB + hstep, voffB); PG8_STAGE(PG8_SA(0, 1), cA + hstep, voffA);
    if (wr == 1) PG8_BAR;
    PG8_WAIT_V(4); PG8_BAR;
    PG8_STAGE(PG8_SB(1, 0), cB + kstep, voffB); PG8_STAGE(PG8_SA(1, 0), cA + kstep, voffA); PG8_STAGE(PG8_SB(1, 1), cB + hstep + kstep, voffB);
    PG8_WAIT_V(6); PG8_BAR;
    for (;;) {
        const bool has_next = S.next(ui + 1, nxt);
        const char* nA = has_next ? (const char*)g.A + (size_t)nxt.pm * tstep : cA; const char* nB = has_next ? (const char*)g.Bt + (size_t)nxt.pn * tstep : cB;
        for (int t = 0; t < nt; t += 2) {
            const bool last = (t == nt - 2);
            const char* a1 = cA + (size_t)(t + 1) * kstep;
            const char* a2 = last ? nA : cA + (size_t)(t + 2) * kstep; const char* b2 = last ? nB : cB + (size_t)(t + 2) * kstep;
            const char* a3 = a2 + kstep; const char* b3 = b2 + kstep;
            if (last && has_next) S.a_ready(nxt);
            PG8_LDB(B0, 0, 0); PG8_SCHED; PG8_LDA(At, 0, 0); PG8_STAGE(PG8_SA(1, 1), a1 + hstep, voffA);
            PG8_WAIT_L(8); PG8_BAR; PG8_WAIT_L(0); PG8_MMA(0, 0, At, B0); PG8_BAR; PG8_SCHED;
            PG8_LDB(B1, 0, 1); PG8_STAGE(PG8_SB(0, 0), b2, voffB);
            PG8_BAR; PG8_WAIT_L(0); PG8_MMA(0, 1, At, B1); PG8_BAR;
            PG8_LDA(At, 0, 1); PG8_STAGE(PG8_SA(0, 0), a2, voffA);
            PG8_BAR; PG8_WAIT_L(0); PG8_MMA(1, 0, At, B0); PG8_BAR; PG8_SCHED;
            PG8_STAGE(PG8_SB(0, 1), b2 + hstep, voffB);
            PG8_WAIT_V(6); PG8_BAR; PG8_MMA(1, 1, At, B1); PG8_BAR;
            PG8_LDB(B0, 1, 0); PG8_SCHED; PG8_LDA(At, 1, 0); PG8_STAGE(PG8_SA(0, 1), a2 + hstep, voffA);
            PG8_WAIT_L(8); PG8_BAR; PG8_WAIT_L(0); PG8_MMA(0, 0, At, B0); PG8_BAR; PG8_SCHED;
            PG8_LDB(B1, 1, 1); PG8_STAGE(PG8_SB(1, 0), b3, voffB);
            PG8_BAR; PG8_WAIT_L(0); PG8_MMA(0, 1, At, B1); PG8_BAR;
            PG8_LDA(At, 1, 1); PG8_STAGE(PG8_SA(1, 0), a3, voffA);
            PG8_BAR; PG8_WAIT_L(0); PG8_MMA(1, 0, At, B0); PG8_BAR; PG8_SCHED;
            PG8_STAGE(PG8_SB(1, 1), b3 + hstep, voffB);
            PG8_WAIT_V(6); PG8_BAR; PG8_MMA(1, 1, At, B1); PG8_BAR;
        }
        if constexpr (!Epi::AFTER_DRAIN) { E(acc, cur, wr, wc, fr, fq); S.done(cur); }
        if (!has_next) break;
#pragma unroll
        for (int a = 0; a < 2; ++a)
#pragma unroll
            for (int b = 0; b < 2; ++b)
#pragma unroll
                for (int m = 0; m < 4; ++m)
#pragma unroll
                    for (int n = 0; n < 2; ++n) acc[a][b][m][n] = (f32x4){0.f, 0.f, 0.f, 0.f};
        cur = nxt; cA = nA; cB = nB; ++ui;
    }
    PG8_WAIT_V(0);
    if (wr == 0) PG8_BAR;
    PG8_BAR;
    if constexpr (Epi::AFTER_DRAIN) { E.fused(acc, cur, wr, wc, fr, fq, lds, wid, lane); S.done(cur); }
#undef PG8_SA
#undef PG8_SB
#undef PG8_STAGE
#undef PG8_LDA
#undef PG8_LDB
#undef PG8_MMA
#undef PG8_WAIT_V
#undef PG8_WAIT_L
#undef PG8_BAR
#undef PG8_SCHED
}
}

__device__ __forceinline__ int ffin_row(int n) { const int half = n >= DFF, j = half ? n - DFF : n; return (j >> 7) * 256 + half * 128 + (j & 127); }
__device__ __forceinline__ void copy_tiles(const Ctx p, LAS unsigned char* lds, int tbeg, int tend, int first, int stride) {
    int tid_ = threadIdx.x; asm volatile("" : "+v"(tid_)); const int tid = tid_;
    unsigned char* ws = p.ws;
    LAS float* tile = (LAS float*)lds;
    const float* src; bf16_t* dst; int K, N, k0, n0; bool perm;
#define TILE_INFO(T) do { int t_ = (T), tk_; \
        if (t_ < 640) { src = PIN(13); K = 1024; N = 2560; dst = (bf16_t*)(ws + WS_W1T); perm = false; } \
        else if (t_ < 1152) { t_ -= 640; src = PIN(33); K = 1024; N = 2048; dst = (bf16_t*)(ws + WS_W1T) + (size_t)2560 * 1024; perm = false; } \
        else if (t_ < 1408) { t_ -= 1152; src = PIN(31); K = 1024; N = 1024; dst = (bf16_t*)(ws + WS_WPL); perm = false; } \
        else if (t_ < 1536) { t_ -= 1408; src = PIN(32); K = 512; N = 1024; dst = (bf16_t*)(ws + WS_WPS); perm = false; } \
        else if (t_ < 1792) { t_ -= 1536; src = PIN(35); K = 1024; N = 1024; dst = (bf16_t*)(ws + WS_WOUT); perm = false; } \
        else if (t_ < 3200) { t_ -= 1792; src = PIN(36); K = 1024; N = 2 * DFF; dst = (bf16_t*)(ws + WS_WFI); perm = true; } \
        else if (t_ < 3904) { t_ -= 3200; src = PIN(37); K = DFF; N = 1024; dst = (bf16_t*)(ws + WS_WFO); perm = false; } \
        else { t_ -= 3904; src = PIN(29); K = 512; N = 512; dst = (bf16_t*)(ws + WS_WGLU); perm = false; } \
        tk_ = K / 64; k0 = (t_ % tk_) * 64; n0 = (t_ / tk_) * 64; } while (0)
    {   const int r = tid >> 4, c4 = tid & 15, n = tid >> 3, kc = tid & 7;
        f32x4 v0, v1; int T = tbeg + first;
        if (T < tend) { TILE_INFO(T); v0 = *(const f32x4*)(src + (size_t)(k0 + r) * N + n0 + 4 * c4); v1 = *(const f32x4*)(src + (size_t)(k0 + r + 32) * N + n0 + 4 * c4); }
        for (; T < tend; T += stride) {
            TILE_INFO(T);
            bf16_t* const cdst = dst; const int cK = K, ck0 = k0, cdrow = perm ? ffin_row(n0 + n) : n0 + n;
            {   LAS float* t = tile + r * 65 + 4 * c4; t[0] = v0[0]; t[1] = v0[1]; t[2] = v0[2]; t[3] = v0[3]; t += 32 * 65; t[0] = v1[0]; t[1] = v1[1]; t[2] = v1[2]; t[3] = v1[3]; }
            __syncthreads();
            if (T + stride < tend) { TILE_INFO(T + stride); v0 = *(const f32x4*)(src + (size_t)(k0 + r) * N + n0 + 4 * c4); v1 = *(const f32x4*)(src + (size_t)(k0 + r + 32) * N + n0 + 4 * c4); }
            {   const LAS float* t = tile + (8 * kc) * 65 + n; u32x4 w;
                w.x = pk2(t[0], t[65]); w.y = pk2(t[130], t[195]); w.z = pk2(t[260], t[325]); w.w = pk2(t[390], t[455]);
                *(u32x4*)(cdst + (size_t)cdrow * cK + ck0 + 8 * kc) = w; }
            __syncthreads();
        }
    }
#undef TILE_INFO
}
__device__ __forceinline__ void p0_prologue(const Ctx p, LAS unsigned char* lds) {
    const int tid = threadIdx.x, G = gridDim.x, bx = blockIdx.x;
    unsigned char* ws = p.ws;
    if (bx >= G - 96) {
        const int item = bx - (G - 96), n0 = item * 64, w = tid >> 6, lane = tid & 63;
        LAS float* sc = (LAS float*)lds;
        LAS float* red = (LAS float*)(lds + 9 * 1024 * 4);
        for (int i = tid; i < 9 * 1024; i += 512) { const int j = i >> 10, k = i & 1023; const float v = j == 0 ? PIN(6)[k] : PIN(2)[(j - 1) * 1024 + k]; sc[i] = siluf_(v); }
        __syncthreads();
        float a[9];
#pragma unroll
        for (int j = 0; j < 9; ++j) a[j] = 0.f;
        const float* wm = PIN(7) + n0 + lane;
#pragma unroll 8
        for (int k = 128 * w; k < 128 * w + 128; ++k) { const float wv = wm[(size_t)k * 6144];
#pragma unroll
            for (int j = 0; j < 9; ++j) a[j] += sc[j * 1024 + k] * wv; }
#pragma unroll
        for (int j = 0; j < 9; ++j) red[(w * 9 + j) * 64 + lane] = a[j];
        __syncthreads();
        for (int i = tid; i < 9 * 64; i += 512) { const int j = i >> 6, l = i & 63; float s = PIN(8)[n0 + l];
#pragma unroll
            for (int ww = 0; ww < 8; ++ww) s += red[(ww * 9 + j) * 64 + l];
            ((float*)(ws + WS_MOD))[j * 6144 + n0 + l] = s; }
        __syncthreads();
    }
    if (bx < G - 96) { copy_tiles(p, lds, 0, 1792, bx, G - 96); copy_tiles(p, lds, 3904, 3968, bx, G - 96); }
}

#define ROW_SS(v) ((v[0][0] * v[0][0] + v[0][1] * v[0][1]) + (v[0][2] * v[0][2] + v[0][3] * v[0][3]) + (v[1][0] * v[1][0] + v[1][1] * v[1][1]) + (v[1][2] * v[1][2] + v[1][3] * v[1][3]) + \
                   (v[2][0] * v[2][0] + v[2][1] * v[2][1]) + (v[2][2] * v[2][2] + v[2][3] * v[2][3]) + (v[3][0] * v[3][0] + v[3][1] * v[3][1]) + (v[3][2] * v[3][2] + v[3][3] * v[3][3]))
__device__ __forceinline__ float wave_sum(float x) {
#pragma unroll
    for (int o = 1; o < 64; o <<= 1) x += __shfl_xor(x, o);
    return x; }
__device__ __forceinline__ f32x4 bf4(const u32x2 w) { return (f32x4){bf_lo(w.x), bf_hi(w.x), bf_lo(w.y), bf_hi(w.y)}; }
__device__ __forceinline__ void p1_hn(const Ctx p) {
    int tid_ = threadIdx.x; asm volatile("" : "+v"(tid_)); const int tid = tid_, w = tid >> 6, lane = tid & 63, r0 = blockIdx.x * 160 + w * 20;
    bf16_t* HN = (bf16_t*)(p.ws + WS_HN);
    f32x4 gs[4], sh[4]; int cur = -1;
    for (int it = 0; it < 10; ++it) { const int r = r0 + 2 * it, mi = mod_index(r);
        if (mi != cur) { cur = mi; const float* mod = (const float*)(p.ws + WS_MOD) + mi * 6144;
#pragma unroll
            for (int j = 0; j < 4; ++j) { const int c = 4 * lane + 256 * j; gs[j] = *(const f32x4*)(PIN(9) + c) * (*(const f32x4*)(mod + 1024 + c) + 1.0f); sh[j] = *(const f32x4*)(mod + c); } }
        const float* xa = xrow(p, r); const float* xb = xrow(p, r + 1); f32x4 va[4], vb[4];
#pragma unroll
        for (int j = 0; j < 4; ++j) { va[j] = __builtin_nontemporal_load((const f32x4*)(xa + 4 * lane + 256 * j)); vb[j] = __builtin_nontemporal_load((const f32x4*)(xb + 4 * lane + 256 * j)); }
        const float ra = __builtin_amdgcn_rsqf(wave_sum(ROW_SS(va)) * (1.0f / 1024.0f) + EPS), rb = __builtin_amdgcn_rsqf(wave_sum(ROW_SS(vb)) * (1.0f / 1024.0f) + EPS);
#pragma unroll
        for (int j = 0; j < 4; ++j) { const f32x4 ya = va[j] * ra * gs[j] + sh[j], yb = vb[j] * rb * gs[j] + sh[j]; u32x2 oa, ob; oa.x = pk2(ya[0], ya[1]); oa.y = pk2(ya[2], ya[3]); ob.x = pk2(yb[0], yb[1]); ob.y = pk2(yb[2], yb[3]);
            *(u32x2*)(HN + (size_t)r * 1024 + 4 * lane + 256 * j) = oa; *(u32x2*)(HN + (size_t)(r + 1) * 1024 + 4 * lane + 256 * j) = ob; }
    }
}
__device__ __forceinline__ float row_rs(const float* ssp, int r, int lane) { float q = ssp[((size_t)((lane >> 2) & 3) * MT + r) * 4 + (lane & 3)]; q += __shfl_xor(q, 1); q += __shfl_xor(q, 2); q += __shfl_xor(q, 4); q += __shfl_xor(q, 8);
    return __builtin_amdgcn_rsqf(q * (1.0f / 1024.0f) + EPS); }
__device__ __forceinline__ void p7_x1(const Ctx p) {
    int tid_ = threadIdx.x; asm volatile("" : "+v"(tid_)); const int tid = tid_, w = tid >> 6, lane = tid & 63, r0 = blockIdx.x * 160 + w * 20;
    const bf16_t* MO = (const bf16_t*)(p.ws + WS_MO); bf16_t* HN2 = (bf16_t*)(p.ws + WS_HN2); const float* ss1 = (const float*)(p.ws + WS_SSP1);
    f32x4 gg[4], gs[4], sh[4]; int cur = -1;
    for (int it = 0; it < 10; ++it) { const int r = r0 + 2 * it, mi = mod_index(r);
        if (mi != cur) { cur = mi; const float* mod = (const float*)(p.ws + WS_MOD) + mi * 6144;
#pragma unroll
            for (int j = 0; j < 4; ++j) { const int c = 4 * lane + 256 * j; gg[j] = *(const f32x4*)(mod + 2048 + c) * *(const f32x4*)(PIN(10) + c);
                gs[j] = *(const f32x4*)(PIN(11) + c) * (*(const f32x4*)(mod + 4096 + c) + 1.0f); sh[j] = *(const f32x4*)(mod + 3072 + c); } }
        const float* xa = xrow(p, r); const float* xb = xrow(p, r + 1); f32x4 va[4], vb[4]; u32x2 ma[4], mb[4];
#pragma unroll
        for (int j = 0; j < 4; ++j) { const int c = 4 * lane + 256 * j; va[j] = __builtin_nontemporal_load((const f32x4*)(xa + c)); vb[j] = __builtin_nontemporal_load((const f32x4*)(xb + c)); ma[j] = *(const u32x2*)(MO + (size_t)r * 1024 + c); mb[j] = *(const u32x2*)(MO + (size_t)(r + 1) * 1024 + c); }
        const float sa = row_rs(ss1, r, lane), sb = row_rs(ss1, r + 1, lane);
#pragma unroll
        for (int j = 0; j < 4; ++j) { const int c = 4 * lane + 256 * j; va[j] = va[j] + gg[j] * bf4(ma[j]) * sa; vb[j] = vb[j] + gg[j] * bf4(mb[j]) * sb;
            __builtin_nontemporal_store(va[j], (f32x4*)(p.out + (size_t)r * 1024 + c)); __builtin_nontemporal_store(vb[j], (f32x4*)(p.out + (size_t)(r + 1) * 1024 + c)); }
        const float ra = __builtin_amdgcn_rsqf(wave_sum(ROW_SS(va)) * (1.0f / 1024.0f) + EPS), rb = __builtin_amdgcn_rsqf(wave_sum(ROW_SS(vb)) * (1.0f / 1024.0f) + EPS);
#pragma unroll
        for (int j = 0; j < 4; ++j) { const f32x4 ya = va[j] * ra * gs[j] + sh[j], yb = vb[j] * rb * gs[j] + sh[j]; u32x2 oa, ob; oa.x = pk2(ya[0], ya[1]); oa.y = pk2(ya[2], ya[3]); ob.x = pk2(yb[0], yb[1]); ob.y = pk2(yb[2], yb[3]);
            *(u32x2*)(HN2 + (size_t)r * 1024 + 4 * lane + 256 * j) = oa; *(u32x2*)(HN2 + (size_t)(r + 1) * 1024 + 4 * lane + 256 * j) = ob; }
    }
}
__device__ __forceinline__ void p10_out(const Ctx p) {
    int tid_ = threadIdx.x; asm volatile("" : "+v"(tid_)); const int tid = tid_, w = tid >> 6, lane = tid & 63, r0 = blockIdx.x * 160 + w * 20;
    const bf16_t* FO = (const bf16_t*)(p.ws + WS_FO); const bf16_t* FOB = (const bf16_t*)(p.ws + WS_FOB);
    f32x4 gg[4]; int cur = -1;
    for (int it = 0; it < 10; ++it) { const int r = r0 + 2 * it, mi = mod_index(r); const bool split = r >= 128 * 256;
        if (mi != cur) { cur = mi; const float* mod = (const float*)(p.ws + WS_MOD) + mi * 6144;
#pragma unroll
            for (int j = 0; j < 4; ++j) { const int c = 4 * lane + 256 * j; gg[j] = *(const f32x4*)(mod + 5120 + c) * *(const f32x4*)(PIN(12) + c); } }
        f32x4 va[4], vb[4], fa[4], fb[4];
#pragma unroll
        for (int j = 0; j < 4; ++j) { const int c = 4 * lane + 256 * j; va[j] = __builtin_nontemporal_load((const f32x4*)(p.out + (size_t)r * 1024 + c)); vb[j] = __builtin_nontemporal_load((const f32x4*)(p.out + (size_t)(r + 1) * 1024 + c));
            fa[j] = bf4(*(const u32x2*)(FO + (size_t)r * 1024 + c)); fb[j] = bf4(*(const u32x2*)(FO + (size_t)(r + 1) * 1024 + c));
            if (split) { fa[j] = fa[j] + bf4(*(const u32x2*)(FOB + (size_t)r * 1024 + c)); fb[j] = fb[j] + bf4(*(const u32x2*)(FOB + (size_t)(r + 1) * 1024 + c)); } }
        const float sa = __builtin_amdgcn_rsqf(wave_sum(ROW_SS(fa)) * (1.0f / 1024.0f) + EPS), sb = __builtin_amdgcn_rsqf(wave_sum(ROW_SS(fb)) * (1.0f / 1024.0f) + EPS);
#pragma unroll
        for (int j = 0; j < 4; ++j) { const int c = 4 * lane + 256 * j; __builtin_nontemporal_store(va[j] + gg[j] * fa[j] * sa, (f32x4*)(p.out + (size_t)r * 1024 + c)); __builtin_nontemporal_store(vb[j] + gg[j] * fb[j] * sb, (f32x4*)(p.out + (size_t)(r + 1) * 1024 + c)); }
    }
}

constexpr int LRU_U16 = 0, LRU_UB = 9216, LRU_AA = LRU_UB + 17408, LRU_AGG = LRU_AA + 17408, LRU_CAR = LRU_AGG + 2048, LRU_HALF = 46592;
__device__ __forceinline__ void lru_unit(const Ctx p, LAS unsigned char* lds, int sample, int b, int hd) {
    int tid_ = threadIdx.x; asm volatile("" : "+v"(tid_)); const int tid = tid_, d = tid >> 8, ht = tid & 255, hw = ht >> 6, lane = tid & 63;
    const int T = sample ? T_S : T_CTX, row0 = sample ? MC + b * T_S : b * T_CTX, nch = T / 64;
    LAS unsigned char* L = lds + d * LRU_HALF;
    LAS bf16_t* U16 = (LAS bf16_t*)(L + LRU_U16); LAS float* UB = (LAS float*)(L + LRU_UB); LAS float* AA = (LAS float*)(L + LRU_AA);
    LAS f32x2* AGG = (LAS f32x2*)(L + LRU_AGG); LAS float* CAR = (LAS float*)(L + LRU_CAR);
    const bf16_t* XA = (const bf16_t*)(p.ws + WS_XA); const bf16_t* GA = (const bf16_t*)(p.ws + WS_GA); bf16_t* YA = (bf16_t*)(p.ws + WS_YA);
    const int fj = lane & 15, fq = lane >> 4, chg = hd * 64 + 16 * hw + fj;
    bf16x8 wrf[2], wif[2];
    {   const float* wr = PIN(16) + (size_t)(d * 16 + hd) * 4096 + 16 * hw + fj; const float* wi = PIN(18) + (size_t)(d * 16 + hd) * 4096 + 16 * hw + fj;
#pragma unroll
        for (int s = 0; s < 2; ++s)
#pragma unroll
            for (int e = 0; e < 8; ++e) { const int k = 32 * s + 8 * fq + e; wrf[s][e] = (short)f2bf(wr[k * 64]); wif[s][e] = (short)f2bf(wi[k * 64]); } }
    const float br = PIN(17)[d * 1024 + chg], bi = PIN(19)[d * 1024 + chg];
    const float sp8 = -8.0f * 1.44269504089f * log1pf(__expf(-PIN(20)[d * 1024 + chg]));
    const int cp = ht & 31, tg = ht >> 5, cc0 = hd * 64 + 2 * cp;
    float cw0[4], cw1[4];
#pragma unroll
    for (int j = 0; j < 4; ++j) { cw0[j] = PIN(14)[j * 1024 + cc0]; cw1[j] = PIN(14)[j * 1024 + cc0 + 1]; }
    const float cb0 = PIN(15)[cc0], cb1 = PIN(15)[cc0 + 1];
    const int chs = hd * 64 + lane;
    if (ht < 64) CAR[lane] = sample ? PIN(3)[(size_t)(b * 2 + d) * 1024 + chs] : 0.f;
    float hfin = 0.f;
    __syncthreads();
    unsigned xw[11];
#define LRU_LOADX(kk) do { const int c_ = d ? nch - 1 - (kk) : (kk); _Pragma("unroll") for (int i = 0; i < 11; ++i) { const int t = 64 * c_ + 8 * tg - 2 + i; unsigned w = 0u; if (t >= 0 && t < T) w = *(const unsigned*)(XA + (size_t)(row0 + t) * 1024 + cc0); xw[i] = w; } } while (0)
    LRU_LOADX(0);
    for (int k = 0; k < nch; ++k) {
        const int c = d ? nch - 1 - k : k, t0 = 64 * c; const bool second = (2 * k >= nch);
        {   float x0[11], x1[11];
#pragma unroll
            for (int i = 0; i < 11; ++i) { x0[i] = bf_lo(xw[i]); x1[i] = bf_hi(xw[i]); }
#pragma unroll
            for (int i = 0; i < 8; ++i) { const float u0 = cb0 + cw0[0] * x0[i] + cw0[1] * x0[i + 1] + cw0[2] * x0[i + 2] + cw0[3] * x0[i + 3];
                const float u1 = cb1 + cw1[0] * x1[i] + cw1[1] * x1[i + 1] + cw1[2] * x1[i + 2] + cw1[3] * x1[i + 3]; const int tl = 8 * tg + i;
                *(LAS unsigned*)(U16 + tl * 72 + 2 * cp) = pk2(u0, u1); *(LAS f32x2*)(UB + tl * 68 + 2 * cp) = (f32x2){u0, u1}; } }
        if (k + 1 < nch) LRU_LOADX(k + 1);
        unsigned short hf16[16], g16[16];
        if (second) {
#pragma unroll
            for (int i = 0; i < 16; ++i) { const int pi = 16 * hw + i, tl = d ? 63 - pi : pi; const size_t ix = (size_t)(row0 + t0 + tl) * 1024 + chs; hf16[i] = YA[ix]; g16[i] = GA[ix]; } }
        __syncthreads();
        {   f32x4 ar[4], ai[4];
#pragma unroll
            for (int m = 0; m < 4; ++m) { ar[m] = (f32x4){0.f, 0.f, 0.f, 0.f}; ai[m] = ar[m];
#pragma unroll
                for (int s = 0; s < 2; ++s) { const bf16x8 a = *(const LAS bf16x8*)(U16 + (16 * m + fj) * 72 + 32 * s + 8 * fq);
                    ar[m] = __builtin_amdgcn_mfma_f32_16x16x32_bf16(a, wrf[s], ar[m], 0, 0, 0); ai[m] = __builtin_amdgcn_mfma_f32_16x16x32_bf16(a, wif[s], ai[m], 0, 0, 0); } }
#pragma unroll
            for (int m = 0; m < 4; ++m)
#pragma unroll
                for (int r4 = 0; r4 < 4; ++r4) { const int tok = 16 * m + 4 * fq + r4, ix = tok * 68 + 16 * hw + fj;
                    const float rg = sigmoidf_(ar[m][r4] + br), a = __builtin_amdgcn_exp2f(sp8 * rg);
                    const float ei = 1.0f + __builtin_amdgcn_exp2f(-1.44269504089f * (ai[m][r4] + bi)), om = fmaxf(1.0f - a * a, 1e-30f);
                    const float bb = om * __builtin_amdgcn_rsqf(om * ei * ei) * UB[ix]; AA[ix] = a; UB[ix] = bb; } }
        __syncthreads();
        float av[16], bv[16]; float P = 1.f, h = 0.f;
#pragma unroll
        for (int i = 0; i < 16; ++i) { const int pi = 16 * hw + i, tl = d ? 63 - pi : pi; av[i] = AA[tl * 68 + lane]; bv[i] = UB[tl * 68 + lane]; h = av[i] * h + bv[i]; P *= av[i]; }
        AGG[hw * 64 + lane] = (f32x2){P, h};
        __syncthreads();
        h = CAR[(k & 1) * 64 + lane];
        for (int s2 = 0; s2 < hw; ++s2) { const f32x2 ag = AGG[s2 * 64 + lane]; h = ag.x * h + ag.y; }
#pragma unroll
        for (int i = 0; i < 16; ++i) { const int pi = 16 * hw + i, tl = d ? 63 - pi : pi; const size_t ix = (size_t)(row0 + t0 + tl) * 1024 + chs; h = av[i] * h + bv[i];
            YA[ix] = f2bf1(second ? bf2f(g16[i]) * (bf2f(hf16[i]) + h) : h); }
        if (hw == 3) { CAR[((k + 1) & 1) * 64 + lane] = h; hfin = h; }
        if (2 * k + 2 == nch) asm volatile("s_waitcnt vmcnt(0)" ::: "memory");
        __syncthreads();
    }
#undef LRU_LOADX
    if (!sample && hw == 3) p.out[OFF_LRU + (size_t)(b * 2 + d) * 1024 + chs] = hfin;
}

__device__ __forceinline__ void sincos_f(float x, float& s, float& c) {
    const float jf = rintf(x * 0.636619772f); const int j = (int)jf;
    float r = x - jf * 1.5703125f; r -= jf * 4.837512969970703125e-4f; r -= jf * 7.54978995489188216e-8f;
    const float z = r * r;
    const float sp = r + r * z * (-1.6666654611e-1f + z * (8.3321608736e-3f + z * (-1.9515295891e-4f)));
    const float cp = 1.0f - 0.5f * z + z * z * (4.166664568298827e-2f + z * (-1.388731625493765e-3f + z * 2.443315711809948e-5f));
    const int q = j & 3;
    s = (q == 0) ? sp : (q == 1) ? cp : (q == 2) ? -sp : -cp;
    c = (q == 0) ? cp : (q == 1) ? -sp : (q == 2) ? -cp : sp;
}
__device__ __forceinline__ void s5_disc(const Ctx p, int d, int g, int ps, float& abr, float& abi, float& fre, float& fim) {
    const float lr = PIN(21)[(d * 32 + g) * 64 + ps], li = PIN(22)[(d * 32 + g) * 64 + ps], dt = __expf(PIN(23)[d * 32 + g]);
    const float mag = __expf(lr * dt); float sn, cs; sincos_f(li * dt, sn, cs);
    abr = mag * cs; abi = mag * sn;
    const float den = lr * lr + li * li, nr = abr - 1.0f, ni = abi;
    fre = (nr * lr + ni * li) / den; fim = (ni * lr - nr * li) / den;
}
constexpr int S5_HS_STRIDE = 272, S5_HS_WAVE = 32 * S5_HS_STRIDE;
__device__ __forceinline__ void s5_item(const Ctx p, LAS unsigned char* lds, int sample, int b, int g0) {
    int tid_ = threadIdx.x; asm volatile("" : "+v"(tid_)); const int tid = tid_, w = tid >> 6, lane = tid & 63, d = w & 1, g = g0 + (w >> 1);
    const int T = sample ? T_S : T_CTX, row0 = sample ? MC + b * T_S : b * T_CTX, nch = T / 32;
    LAS unsigned char* Hs = lds + w * S5_HS_WAVE;
    const bf16_t* XS = (const bf16_t*)(p.ws + WS_XS); bf16_t* VS = (bf16_t*)(p.ws + WS_VS);
    const int j31 = lane & 31, hi = lane >> 5;
    float abr1, abi1, fr1, fi1, abr2, abi2, fr2, fi2;
    s5_disc(p, d, g, j31, abr1, abi1, fr1, fi1); s5_disc(p, d, g, 32 + j31, abr2, abi2, fr2, fi2);
    const float abr = hi ? abr2 : abr1, abi = hi ? abi2 : abi1;
    bf16x8 bfr[4];
#pragma unroll
    for (int st = 0; st < 2; ++st) { const int ps = 32 * st + j31; const float fr = st ? fr2 : fr1, fi = st ? fi2 : fi1;
        const float* bre = PIN(24) + ((size_t)(d * 32 + g) * 64 + ps) * 16 + 8 * hi; const float* bim = PIN(25) + ((size_t)(d * 32 + g) * 64 + ps) * 16 + 8 * hi;
#pragma unroll
        for (int e = 0; e < 8; ++e) { const float vr = bre[e], vi = bim[e]; bfr[2 * st][e] = (short)f2bf(fr * vr - fi * vi); bfr[2 * st + 1][e] = (short)f2bf(fr * vi + fi * vr); } }
    const int fh = lane & 15, kq = lane >> 4;
    bf16x8 cfr[4];
#pragma unroll
    for (int ks = 0; ks < 4; ++ks)
#pragma unroll
        for (int e = 0; e < 8; ++e) { const int pp = 16 * ks + 4 * kq + (e >> 1); const size_t ix = ((size_t)(d * 32 + g) * 16 + fh) * 64 + pp;
            cfr[ks][e] = (short)f2bf((e & 1) ? -PIN(27)[ix] : PIN(26)[ix]); }
    const float dsk = PIN(28)[g * 16 + fh];
    const float one = __builtin_fmaf(dsk, 0.f, 1.0f);
    float hr = 0.f, hi_ = 0.f;
    if (sample) { const size_t ix = ((size_t)(b * 2 + d) * 32 + g) * 64 + lane; hr = PIN(4)[ix]; hi_ = PIN(5)[ix]; }
    const int step = (d ? -1 : 1) * (sample ? 64 : 1);
    const int ua_off = step * 512 * j31 + g * 16 + 8 * hi;
    int eoff[8];
#pragma unroll
    for (int e = 0; e < 8; ++e) eoff[e] = step * 512 * (16 * (e >> 2) + 4 * kq + (e & 3)) + g * 16 + fh;
#define S5_CBASE(kk) ({ const int s0_ = d ? T - 1 - 32 * (kk) : 32 * (kk); const int t0_ = sample ? ((s0_ & 63) * 64 + (s0_ >> 6)) : s0_; (size_t)(row0 + t0_) * 512; })
    bf16x8 ua_next = *(const bf16x8*)(XS + S5_CBASE(0) + ua_off);
    for (int k = 0; k < nch; ++k) {
        const bool second = (2 * k >= nch);
        const size_t cbase = S5_CBASE(k);
        const bf16x8 ua = ua_next;
        if (k + 1 < nch) ua_next = *(const bf16x8*)(XS + S5_CBASE(k + 1) + ua_off);
        unsigned short vf16[8], xs16[8];
        if (second) {
#pragma unroll
            for (int mt = 0; mt < 2; ++mt)
#pragma unroll
                for (int r4 = 0; r4 < 4; ++r4) { const size_t ix = cbase + eoff[mt * 4 + r4]; vf16[mt * 4 + r4] = VS[ix]; xs16[mt * 4 + r4] = XS[ix]; } }
        f32x16 acc[4];
#pragma unroll
        for (int nt = 0; nt < 4; ++nt) { f32x16 z;
#pragma unroll
            for (int v = 0; v < 16; ++v) z[v] = 0.f;
            acc[nt] = __builtin_amdgcn_mfma_f32_32x32x16_bf16(ua, bfr[nt], z, 0, 0, 0); }
        float bur[32], bui[32];
#pragma unroll
        for (int v = 0; v < 16; ++v) {
            unsigned r0 = __builtin_bit_cast(unsigned, acc[0][v] * one), r1 = __builtin_bit_cast(unsigned, acc[2][v] * one);
            unsigned q0 = __builtin_bit_cast(unsigned, acc[1][v] * one), q1 = __builtin_bit_cast(unsigned, acc[3][v] * one);
            asm volatile("s_nop 1\n\tv_permlane32_swap_b32 %0, %1" : "+v"(r0), "+v"(r1));
            asm volatile("s_nop 1\n\tv_permlane32_swap_b32 %0, %1" : "+v"(q0), "+v"(q1));
            const int ta = 8 * (v >> 2) + (v & 3);
            bur[ta] = __builtin_bit_cast(float, r0); bur[ta + 4] = __builtin_bit_cast(float, r1);
            bui[ta] = __builtin_bit_cast(float, q0); bui[ta + 4] = __builtin_bit_cast(float, q1); }
#pragma unroll
        for (int tt = 0; tt < 32; ++tt) { const float nr = abr * hr - abi * hi_ + bur[tt], ni = abr * hi_ + abi * hr + bui[tt]; hr = nr; hi_ = ni;
            *(LAS unsigned*)(Hs + tt * S5_HS_STRIDE + 4 * lane) = pk2(hr, hi_); }
        f32x4 ya[2];
#pragma unroll
        for (int mt = 0; mt < 2; ++mt) { ya[mt] = (f32x4){0.f, 0.f, 0.f, 0.f};
#pragma unroll
            for (int ks = 0; ks < 4; ++ks) { const bf16x8 a = *(const LAS bf16x8*)(Hs + (16 * mt + fh) * S5_HS_STRIDE + (32 * ks + 8 * kq) * 2);
                ya[mt] = __builtin_amdgcn_mfma_f32_16x16x32_bf16(a, cfr[ks], ya[mt], 0, 0, 0); } }
#pragma unroll
        for (int mt = 0; mt < 2; ++mt)
#pragma unroll
            for (int r4 = 0; r4 < 4; ++r4) { const size_t ix = cbase + eoff[mt * 4 + r4]; float y = ya[mt][r4];
                if (second) { y = gelu_tanh(y + bf2f(vf16[mt * 4 + r4]) + dsk * bf2f(xs16[mt * 4 + r4])); }
                VS[ix] = f2bf1(y); }
        if (2 * k + 2 == nch) { asm volatile("s_waitcnt vmcnt(0)" ::: "memory"); __syncthreads(); }
    }
#undef S5_CBASE
    if (!sample) { const size_t ix = ((size_t)(b * 2 + d) * 32 + g) * 64 + lane; p.out[OFF_RE + ix] = hr; p.out[OFF_IM + ix] = hi_; }
}
__device__ __forceinline__ void p3_scans(const Ctx p, LAS unsigned char* lds) {
    const int bx = blockIdx.x;
    if (bx < 128) { lru_unit(p, lds, 1, bx >> 4, bx & 15); }
    else if (bx < 192) { const int i = bx - 128; s5_item(p, lds, 1, i >> 3, 4 * (i & 7)); }
    else { const int i = bx - 192;
        for (int e = 0; e < 8; ++e) { const int c = 8 * i + e; lru_unit(p, lds, 0, c >> 4, c & 15); __syncthreads(); }
        for (int e = 0; e < 4; ++e) { const int c = 4 * i + e; s5_item(p, lds, 0, c >> 3, 4 * (c & 7)); __syncthreads(); } }
}

#define XB_TMO      128
#define XB_XCNT(j)  (256  + 64 * (j))
#define XB_XSUB(j)  (1280 + 64 * (j))
#define XB_XGEN(j)  (2304 + 64 * (j))
#define XB_TOP      3328
#define XB_TOPGEN   3392
#define XCD_BAR_WORDS 3456
#define XB_SPIN_CAP (1u << 18)

__device__ __forceinline__ unsigned xb_ld(unsigned* p)              { return __hip_atomic_load(p, __ATOMIC_RELAXED, __HIP_MEMORY_SCOPE_AGENT); }
__device__ __forceinline__ unsigned xb_add(unsigned* p, unsigned v) { return __hip_atomic_fetch_add(p, v, __ATOMIC_RELAXED, __HIP_MEMORY_SCOPE_AGENT); }
__device__ __forceinline__ unsigned xb_xcc_id() { return (unsigned)__builtin_amdgcn_s_getreg((3 << 11) | 20) & 0xFu; }
#define XB_SPIN(cond, bar) do { unsigned _sp = 0; while (cond) { __builtin_amdgcn_s_sleep(1); \
    if ((++_sp & 255u) == 0u) { if (xb_ld(&(bar)[XB_TMO])) break; if (_sp > XB_SPIN_CAP) { atomicAdd(&(bar)[XB_TMO], 1u); break; } } } } while (0)

struct XcdBarrier {
    unsigned* bar; unsigned x;
    volatile LAS unsigned* st;
};

__device__ __forceinline__ XcdBarrier xcd_barrier_post(unsigned* bar, volatile LAS unsigned* st) {
    XcdBarrier b; b.bar = bar; b.x = xb_xcc_id(); b.st = st;
    if (threadIdx.x == 0) (void)xb_add(&bar[XB_XCNT(b.x)], 1u);
    return b;
}
__device__ __forceinline__ void xcd_barrier_complete(unsigned* bar, unsigned x, unsigned& nloc, unsigned& nx) {
    const unsigned G = gridDim.x * gridDim.y * gridDim.z;
    unsigned sum, cnt, mine, sp = 0u;
    for (;;) {
        sum = 0u; cnt = 0u; mine = 0u;
#pragma unroll
        for (unsigned j = 0; j < 16; ++j) { const unsigned c = xb_ld(&bar[XB_XCNT(j)]); sum += c; cnt += (c > 0u) ? 1u : 0u; mine = (j == x) ? c : mine; }
        if (sum == G) break;
        __builtin_amdgcn_s_sleep(1);
        if ((++sp & 255u) == 0u) { if (xb_ld(&bar[XB_TMO])) break; if (sp > XB_SPIN_CAP) { atomicAdd(&bar[XB_TMO], 1u); break; } }
    }
    nloc = mine > 0u ? mine : 1u; nx = cnt > 0u ? cnt : 1u;
}

__device__ __forceinline__ void xcd_barrier(const XcdBarrier& b) {
    asm volatile("s_waitcnt vmcnt(0)" ::: "memory");
    __syncthreads();
    if (threadIdx.x == 0) {
        unsigned* bar = b.bar;
        __builtin_amdgcn_s_waitcnt(0);
        unsigned nloc = b.st[0], nx = b.st[1];
        if (nloc == 0u) { xcd_barrier_complete(bar, b.x, nloc, nx); b.st[0] = nloc; b.st[1] = nx; }
        const unsigned old = xb_add(&bar[XB_XSUB(b.x)], 1u);
        const unsigned gen = old / nloc;
        if (old + 1u == (gen + 1u) * nloc) {
            __builtin_amdgcn_fence(__ATOMIC_RELEASE, "agent");
            asm volatile("s_waitcnt vmcnt(0)" ::: "memory");
            const unsigned og = xb_add(&bar[XB_TOP], 1u);
            const unsigned tg = og / nx;
            if (og + 1u == (tg + 1u) * nx) xb_add(&bar[XB_TOPGEN], 1u);
            else XB_SPIN(xb_ld(&bar[XB_TOPGEN]) == tg, bar);
            __builtin_amdgcn_fence(__ATOMIC_ACQUIRE, "agent");
            xb_add(&bar[XB_XGEN(b.x)], 1u);
            asm volatile("s_waitcnt vmcnt(0)" ::: "memory");
        } else {
            XB_SPIN(xb_ld(&bar[XB_XGEN(b.x)]) == gen, bar);
            __builtin_amdgcn_fence(__ATOMIC_ACQUIRE, "agent");
            asm volatile("s_waitcnt vmcnt(0)" ::: "memory");
        }
    }
    __syncthreads();
}

#define GRID_SYNC() do { asm volatile("s_waitcnt vmcnt(0)" ::: "memory"); grid.sync(); if (threadIdx.x < 64) { __builtin_amdgcn_fence(__ATOMIC_ACQUIRE, "agent"); asm volatile("s_waitcnt vmcnt(0)" ::: "memory"); } __syncthreads(); } while (0)
__global__ void __launch_bounds__(512, 2) fwd_mega(Params kp) {
    extern __shared__ __attribute__((aligned(16))) unsigned char lds_raw[];
    LAS unsigned char* lds = (LAS unsigned char*)lds_raw;
    {   LAS unsigned long long* t_ = (LAS unsigned long long*)(lds + LDS_BYTES - 512);
        if (threadIdx.x == 0) { t_[0] = (unsigned long long)kp.in[0]; t_[1] = (unsigned long long)kp.in[1]; t_[2] = (unsigned long long)kp.in[2]; t_[3] = (unsigned long long)kp.in[3]; t_[4] = (unsigned long long)kp.in[4]; t_[5] = (unsigned long long)kp.in[5]; t_[6] = (unsigned long long)kp.in[6]; t_[7] = (unsigned long long)kp.in[7]; t_[8] = (unsigned long long)kp.in[8]; t_[9] = (unsigned long long)kp.in[9]; t_[10] = (unsigned long long)kp.in[10]; t_[11] = (unsigned long long)kp.in[11]; t_[12] = (unsigned long long)kp.in[12]; t_[13] = (unsigned long long)kp.in[13]; t_[14] = (unsigned long long)kp.in[14]; t_[15] = (unsigned long long)kp.in[15]; t_[16] = (unsigned long long)kp.in[16]; t_[17] = (unsigned long long)kp.in[17]; t_[18] = (unsigned long long)kp.in[18]; t_[19] = (unsigned long long)kp.in[19]; t_[20] = (unsigned long long)kp.in[20]; t_[21] = (unsigned long long)kp.in[21]; t_[22] = (unsigned long long)kp.in[22]; t_[23] = (unsigned long long)kp.in[23]; t_[24] = (unsigned long long)kp.in[24]; t_[25] = (unsigned long long)kp.in[25]; t_[26] = (unsigned long long)kp.in[26]; t_[27] = (unsigned long long)kp.in[27]; t_[28] = (unsigned long long)kp.in[28]; t_[29] = (unsigned long long)kp.in[29]; t_[30] = (unsigned long long)kp.in[30]; t_[31] = (unsigned long long)kp.in[31]; t_[32] = (unsigned long long)kp.in[32]; t_[33] = (unsigned long long)kp.in[33]; t_[34] = (unsigned long long)kp.in[34]; t_[35] = (unsigned long long)kp.in[35]; t_[36] = (unsigned long long)kp.in[36]; t_[37] = (unsigned long long)kp.in[37]; }
        __syncthreads(); }
    Ctx p; p.tbl = (const LAS unsigned long long*)(lds + LDS_BYTES - 512); p.out = kp.out; p.ws = kp.ws;
    cg::grid_group grid = cg::this_grid();
    unsigned char* ws = p.ws; const int G = gridDim.x, bx = blockIdx.x;
    bf16_t* GATE = (bf16_t*)p.out;
    volatile LAS unsigned* xst = (volatile LAS unsigned*)(lds + LDS_BYTES - 512 - 16);
    if (threadIdx.x < 4) xst[threadIdx.x] = 0u;
    __syncthreads();
    const XcdBarrier xb = xcd_barrier_post((unsigned*)(ws + 768 * 1024), xst);
#define GRID_BAR() xcd_barrier(xb)
    p0_prologue(p, lds);
    if (G == 0x7fffffff) GRID_SYNC();
    GRID_BAR();
    p1_hn(p);
    GRID_BAR();
    {   pg8::Gemm g{(const bf16_t*)(ws + WS_HN), (const bf16_t*)(ws + WS_W1T), MT, 2560, 1024}; pg8::StaticOrder S; S.init(MT, 2560, G, bx);
        pg8::Epi1 E{(bf16_t*)(ws + WS_XA), (bf16_t*)(ws + WS_GA), (bf16_t*)(ws + WS_XS)};
        pg8::gemm_phase<pg8::Epi1, pg8::StaticOrder>(lds, g, S, E);
        pg8::Gemm g2{(const bf16_t*)(ws + WS_HN), (const bf16_t*)(ws + WS_W1T) + (size_t)2560 * 1024, MT, 2048, 1024}; pg8::ListOrder S2; S2.init(MT, 2048, G, bx); S2.base = bx; S2.stride = 256; S2.count = 3; S2.extra = bx >= 64 ? 768 + (bx - 64) : -1;
        pg8::EpiGate E2{GATE, PIN(34)};
        pg8::gemm_phase<pg8::EpiGate, pg8::ListOrder>(lds, g2, S2, E2); }
    GRID_BAR();
    p3_scans(p, lds);
    if (bx < 128 || bx >= 192) {
        __syncthreads();
        pg8::Gemm g2{(const bf16_t*)(ws + WS_HN), (const bf16_t*)(ws + WS_W1T) + (size_t)2560 * 1024, MT, 2048, 1024}; pg8::ListOrder S2; S2.init(MT, 2048, G, bx);
        S2.extra = -1; if (bx >= 192) { S2.base = 1088 + (bx - 192); S2.stride = 64; S2.count = 3; } else { S2.base = 960 + bx; S2.stride = 1; S2.count = 1; }
        pg8::EpiGate E2{GATE, PIN(34)};
        pg8::gemm_phase<pg8::EpiGate, pg8::ListOrder>(lds, g2, S2, E2);
    }
    GRID_BAR();
    {
        pg8::StaticOrder S; S.init(MT, 1024, G, bx);
        pg8::Gemm ga{(const bf16_t*)(ws + WS_YA), (const bf16_t*)(ws + WS_WPL), MT, 1024, 1024};
        pg8::EpiMerge<0> Ea{GATE, (bf16_t*)(ws + WS_TMP), (bf16_t*)(ws + WS_MPRE)};
        pg8::Gemm g{(const bf16_t*)(ws + WS_VS), (const bf16_t*)(ws + WS_WGLU), MT, 512, 512}; pg8::StaticOrder S4; S4.init(MT, 512, G, (bx + 128) & 255);
        pg8::EpiGlu E{(const bf16_t*)(ws + WS_VS), (bf16_t*)(ws + WS_YS), PIN(30)};
        pg8::gemm_phase<pg8::EpiGlu, pg8::StaticOrder>(lds, g, S4, E);
        pg8::gemm_phase<pg8::EpiMerge<0>, pg8::StaticOrder>(lds, ga, S, Ea); }
    GRID_BAR();
    {   pg8::StaticOrder S; S.init(MT, 1024, G, bx);
        pg8::Gemm gb{(const bf16_t*)(ws + WS_YS), (const bf16_t*)(ws + WS_WPS), MT, 1024, 512};
        pg8::EpiMerge<1> Eb{GATE, (bf16_t*)(ws + WS_TMP), (bf16_t*)(ws + WS_MPRE)};
        pg8::gemm_phase<pg8::EpiMerge<1>, pg8::StaticOrder>(lds, gb, S, Eb);
        if (bx >= 128) copy_tiles(p, lds, 3200, 3904, bx - 128, 128); }
    GRID_BAR();
    {   pg8::Gemm g{(const bf16_t*)(ws + WS_MPRE), (const bf16_t*)(ws + WS_WOUT), MT, 1024, 1024}; pg8::StaticOrder S; S.init(MT, 1024, G, bx);
        pg8::EpiOutSS E{(bf16_t*)(ws + WS_MO), (float*)(ws + WS_SSP1)};
        pg8::gemm_phase<pg8::EpiOutSS, pg8::StaticOrder>(lds, g, S, E);
        if (bx >= 128) copy_tiles(p, lds, 1792, 3200, bx - 128, 128); }
    GRID_BAR();
    p7_x1(p);
    GRID_BAR();
    {   pg8::Gemm g{(const bf16_t*)(ws + WS_HN2), (const bf16_t*)(ws + WS_WFI), MT, 2 * DFF, 1024}; pg8::StaticOrder S; S.init(MT, 2 * DFF, G, bx);
        pg8::EpiFF E{(bf16_t*)(ws + WS_HID)};
        pg8::gemm_phase<pg8::EpiFF, pg8::StaticOrder>(lds, g, S, E); }
    GRID_BAR();
    {
        pg8::Gemm g{(const bf16_t*)(ws + WS_HID), (const bf16_t*)(ws + WS_WFO), MT, 1024, DFF}; pg8::StaticOrder S; S.init(128 * 256, 1024, G, bx);
        pg8::EpiPlain E{(bf16_t*)(ws + WS_FO)};
        pg8::gemm_phase<pg8::EpiPlain, pg8::StaticOrder>(lds, g, S, E);
        const int tile = bx >> 1, kh = bx & 1;
        pg8::Gemm gh{(const bf16_t*)(ws + WS_HID) + kh * (DFF / 2), (const bf16_t*)(ws + WS_WFO) + kh * (DFF / 2), MT, 1024, DFF / 2, DFF};
        pg8::OneUnit S1{128 + (tile >> 2), tile & 3};
        pg8::EpiPlain Eh{(bf16_t*)(ws + (kh ? WS_FOB : WS_FO))};
        pg8::gemm_phase<pg8::EpiPlain, pg8::OneUnit>(lds, gh, S1, Eh); }
    GRID_BAR();
    p10_out(p);
}

extern "C" void kernel_launch(void* const* d_in, const int* in_sizes, int n_in, void* d_out, int out_size, void* d_ws, size_t ws_size, hipStream_t stream) {
    static int grid = 0;
    if (grid == 0) {
        if (n_in != 38 || (size_t)out_size != OFF_IM + 32 * 2 * 32 * 64 || ws_size < WS_END) { fprintf(stderr, "kernel_launch: unexpected shapes (n_in %d out %d ws %zu)\n", n_in, out_size, ws_size); grid = -1; return; }
        int dev = 0, cus = 0, per_cu = 0;
        hipGetDevice(&dev); hipDeviceGetAttribute(&cus, hipDeviceAttributeMultiprocessorCount, dev);
        if (hipFuncSetAttribute((const void*)fwd_mega, hipFuncAttributeMaxDynamicSharedMemorySize, LDS_BYTES) != hipSuccess) { fprintf(stderr, "kernel_launch: hipFuncSetAttribute failed\n"); grid = -1; return; }
        if (hipOccupancyMaxActiveBlocksPerMultiprocessor(&per_cu, (const void*)fwd_mega, 512, LDS_BYTES) != hipSuccess || per_cu < 1) { fprintf(stderr, "kernel_launch: occupancy query says %d blocks/CU\n", per_cu); grid = -1; return; }
        if (cus < 256) { fprintf(stderr, "kernel_launch: needs 256 CUs, device has %d\n", cus); grid = -1; return; }
        grid = 256;
    }
    if (grid < 0) return;
    Params p{};
    for (int i = 0; i < 38; ++i) p.in[i] = (const float*)d_in[i];
    p.out = (float*)d_out; p.ws = (unsigned char*)d_ws;
    if (hipMemsetAsync((char*)d_ws + 768 * 1024, 0, XCD_BAR_WORDS * 4, stream) != hipSuccess) { fprintf(stderr, "kernel_launch: hipMemsetAsync of the barrier word failed\n"); return; }
    void* args[] = {&p};
    hipError_t e = hipLaunchCooperativeKernel((const void*)fwd_mega, dim3(grid), dim3(512), args, LDS_BYTES, stream);
    if (e != hipSuccess) fprintf(stderr, "cooperative launch failed: %s\n", hipGetErrorString(e));
}
```

```cpp
#include <hip/hip_runtime.h>
#include <hip/hip_cooperative_groups.h>
#include <cstdio>
#include <cstdint>
namespace cg = cooperative_groups;

#define LAS __attribute__((address_space(3)))
typedef unsigned short bf16_t;
typedef short bf16x8 __attribute__((ext_vector_type(8)));
typedef float f32x4 __attribute__((ext_vector_type(4)));
typedef float f32x16 __attribute__((ext_vector_type(16)));
typedef float f32x2 __attribute__((ext_vector_type(2)));
typedef unsigned u32x4 __attribute__((ext_vector_type(4)));
typedef unsigned u32x2 __attribute__((ext_vector_type(2)));

constexpr int DM = 1024, MC = 8192, MS = 32768, MT = MC + MS;
constexpr int NB_CTX = 32, T_CTX = 256, NB_S = 8, T_S = 4096;
constexpr int DFF = 2816, DS5 = 512;
constexpr float EPS = 1e-6f;
constexpr size_t OFF_LRU = (size_t)MT * DM, OFF_RE = OFF_LRU + 32 * 2 * 1024, OFF_IM = OFF_RE + 32 * 2 * 32 * 64;
constexpr size_t MiB = 1u << 20;
constexpr size_t WS_MOD = 512 * 1024;
constexpr size_t WS_W1T = 1 * MiB, WS_WPL = 10 * MiB, WS_WPS = 12 * MiB, WS_WOUT = 13 * MiB, WS_WFI = 15 * MiB, WS_WFO = 26 * MiB, WS_WGLU = 31 * MiB + 512 * 1024;
constexpr size_t WS_HN = 32 * MiB, WS_XA = 112 * MiB, WS_XS = 192 * MiB, WS_VS = 232 * MiB, WS_YA = 272 * MiB, WS_GA = 352 * MiB, WS_SSP1 = 432 * MiB, WS_SSP2 = 435 * MiB, WS_X1A = 252 * MiB  , WS_X1B = 438 * MiB  , WS_END = 498 * MiB;
constexpr size_t WS_TMP = WS_HN, WS_MPRE = WS_GA, WS_MO = WS_HN, WS_HN2 = WS_GA, WS_HID = WS_HN, WS_FO = WS_YA, WS_FOB = WS_GA, WS_YS = WS_XS;
constexpr int LDS_BYTES = 147456;

struct Params { const float* in[38]; float* out; unsigned char* ws; };
struct Ctx { const LAS unsigned long long* tbl; float* out; unsigned char* ws; };
__device__ __forceinline__ const float* inp_(const LAS unsigned long long* tbl, int i) { const unsigned long long v = tbl[i];
    const unsigned lo = __builtin_amdgcn_readfirstlane((unsigned)v), hi = __builtin_amdgcn_readfirstlane((unsigned)(v >> 32)); return (const float*)(const __attribute__((address_space(1))) float*)(((unsigned long long)hi << 32) | lo); }
#define PIN(i) inp_(p.tbl, (i))

__device__ __forceinline__ unsigned f2bf(float f) { unsigned u = __builtin_bit_cast(unsigned, f); return (u + 0x7fffu + ((u >> 16) & 1u)) >> 16; }
__device__ __forceinline__ unsigned pk2(float lo, float hi) { unsigned r; asm volatile("s_nop 1\n\tv_cvt_pk_bf16_f32 %0, %1, %2" : "=v"(r) : "v"(lo), "v"(hi)); return r; }
__device__ __forceinline__ bf16_t f2bf1(float x) { return (bf16_t)(pk2(x, 0.f) & 0xffffu); }
__device__ __forceinline__ float bf_lo(unsigned w) { return __builtin_bit_cast(float, w << 16); }
__device__ __forceinline__ float bf_hi(unsigned w) { return __builtin_bit_cast(float, w & 0xffff0000u); }
__device__ __forceinline__ float bf2f(bf16_t h) { return __builtin_bit_cast(float, ((unsigned)h) << 16); }
__device__ __forceinline__ float sigmoidf_(float x) { return __builtin_amdgcn_rcpf(1.0f + __builtin_amdgcn_exp2f(-1.44269504089f * x)); }
__device__ __forceinline__ float siluf_(float x) { return x * sigmoidf_(x); }
__device__ __forceinline__ float gelu_tanh(float x) { const float u = x + 0.044715f * x * x * x; return x * __builtin_amdgcn_rcpf(1.0f + __builtin_amdgcn_exp2f(-2.30220819f * u)); }
__device__ __forceinline__ const float* xrow(const Ctx p, int r) { return r < MC ? PIN(0) + (size_t)r * DM : PIN(1) + (size_t)(r - MC) * DM; }
__device__ __forceinline__ int mod_index(int r) { return r < MC ? 0 : 1 + ((r - MC) >> 12); }
namespace pg8 {
#define PG8_LAS __attribute__((address_space(3)))
constexpr int BM = 256, BK = 64, HALF = 128, HTB = HALF * BK * 2  , STAGE_BYTES = 8 * HTB, NXCD = 8, WGM = 8;
__host__ __device__ __forceinline__ int lds_byte(int r, int c) { const int st = (r >> 4) * 2 + (c >> 5), rr = r & 15, cc = c & 31, ob = rr * 64 + cc * 2; return st * 1024 + (ob ^ (((ob >> 9) & 1) << 5)); }
__host__ __device__ __forceinline__ void stage_rc(int b, int& R, int& C) { const int st = b / 1024, sb = b % 1024, swz = sb ^ (((sb >> 9) & 1) << 5); R = (st >> 1) * 16 + swz / 64; C = (st & 1) * 32 + (swz % 64) / 2; }
__host__ __device__ __forceinline__ int perm32(int rho) { const int n = rho >> 4, i = rho & 15; return 8 * (i >> 2) + 4 * n + (i & 3); }
struct Unit { int pm, pn; };
struct Gemm { const bf16_t* A; const bf16_t* Bt; int M, N, K; int ld = 0; };
struct StaticOrder {
    int nM, nN, nwg, G, c;
    __host__ __device__ void init(int M, int N, int G_, int c_) { nM = M / BM; nN = N / BM; nwg = nM * nN; G = G_; c = c_; }
    __host__ __device__ bool next(int i, Unit& u) const {
        const long L = (long)i * G + c; if (L >= nwg) return false;
        int wgid = (int)L; { const int q = nwg / NXCD, r = nwg % NXCD, xcd = wgid % NXCD, off = wgid / NXCD; wgid = (xcd < r ? xcd * (q + 1) : r * (q + 1) + (xcd - r) * q) + off; }
        const int nig = WGM * nN, gid = wgid / nig, fm = gid * WGM, gsz = (nM - fm) < WGM ? (nM - fm) : WGM;
        u.pm = fm + ((wgid % nig) % gsz); u.pn = (wgid % nig) / gsz; return true;
    }
    __device__ __forceinline__ void a_ready(const Unit&) const {}
    __device__ __forceinline__ void done(const Unit&) const {}
};
struct ListOrder : StaticOrder {
    int base, stride, count, extra;
    __host__ __device__ bool next(int i, Unit& u) const {
        if (i > count || (i == count && extra < 0)) return false;
        const long L = (i < count) ? (long)base + (long)i * stride : (long)extra; if (L >= nwg) return false;
        int wgid = (int)L; { const int q = nwg / NXCD, r = nwg % NXCD, xcd = wgid % NXCD, off = wgid / NXCD; wgid = (xcd < r ? xcd * (q + 1) : r * (q + 1) + (xcd - r) * q) + off; }
        const int nig = WGM * nN, gid = wgid / nig, fm = gid * WGM, gsz = (nM - fm) < WGM ? (nM - fm) : WGM;
        u.pm = fm + ((wgid % nig) % gsz); u.pn = (wgid % nig) / gsz; return true;
    }
};
__device__ __forceinline__ unsigned cvt_pk_bf16(float lo, float hi) { unsigned r; asm volatile("s_nop 1\n\tv_cvt_pk_bf16_f32 %0, %1, %2" : "=v"(r) : "v"(lo), "v"(hi)); return r; }
__device__ __forceinline__ u32x4 pack8(const f32x4 a, const f32x4 b) { u32x4 w; w.x = cvt_pk_bf16(a[0], a[1]); w.y = cvt_pk_bf16(a[2], a[3]); w.z = cvt_pk_bf16(b[0], b[1]); w.w = cvt_pk_bf16(b[2], b[3]); return w; }
__device__ __forceinline__ void unpack8(const u32x4 w, f32x4& a, f32x4& b) { a = (f32x4){bf_lo(w.x), bf_hi(w.x), bf_lo(w.y), bf_hi(w.y)}; b = (f32x4){bf_lo(w.z), bf_hi(w.z), bf_lo(w.w), bf_hi(w.w)}; }

#define EPI_LOOP_BEGIN \
    _Pragma("unroll") for (int ai = 0; ai < 2; ++ai) _Pragma("unroll") for (int m = 0; m < 4; ++m) { const int row = u.pm * BM + ai * HALF + wr * 64 + m * 16 + fr; \
    _Pragma("unroll") for (int bj = 0; bj < 2; ++bj) { const int ct = bj * HALF + wc * 32 + 8 * fq; f32x4 v0 = acc[ai][bj][m][0], v1 = acc[ai][bj][m][1];
#define EPI_LOOP_END } }

struct Epi1 {
    static constexpr bool PERM = true, AFTER_DRAIN = false;
    bf16_t* XA; bf16_t* GA; bf16_t* XS;
    __device__ __forceinline__ void operator()(const f32x4 (&acc)[2][2][4][2], const Unit& u, int wr, int wc, int fr, int fq) const {
        const int pn = u.pn;
        if (pn < 4) {
            EPI_LOOP_BEGIN *(u32x4*)(XA + (size_t)row * 1024 + pn * 256 + ct) = pack8(v0, v1); EPI_LOOP_END
        } else if (pn < 8) {
            EPI_LOOP_BEGIN
#pragma unroll
                for (int j = 0; j < 4; ++j) { v0[j] = gelu_tanh(v0[j]); v1[j] = gelu_tanh(v1[j]); }
                *(u32x4*)(GA + (size_t)row * 1024 + (pn - 4) * 256 + ct) = pack8(v0, v1); EPI_LOOP_END
        } else {
            EPI_LOOP_BEGIN *(u32x4*)(XS + (size_t)row * 512 + (pn - 8) * 256 + ct) = pack8(v0, v1); EPI_LOOP_END
        }
    }
};
struct EpiGate {
    static constexpr bool PERM = true, AFTER_DRAIN = false;
    bf16_t* GATE; const float* bgate;
    __device__ __forceinline__ void operator()(const f32x4 (&acc)[2][2][4][2], const Unit& u, int wr, int wc, int fr, int fq) const {
        const int cb = u.pn * 256;
#pragma unroll
        for (int bj = 0; bj < 2; ++bj) { const int ct = bj * HALF + wc * 32 + 8 * fq;
            const f32x4 b0 = *(const f32x4*)(bgate + cb + ct), b1 = *(const f32x4*)(bgate + cb + ct + 4);
#pragma unroll
            for (int ai = 0; ai < 2; ++ai)
#pragma unroll
                for (int m = 0; m < 4; ++m) { const int row = u.pm * BM + ai * HALF + wr * 64 + m * 16 + fr; f32x4 v0 = acc[ai][bj][m][0], v1 = acc[ai][bj][m][1];
#pragma unroll
                    for (int j = 0; j < 4; ++j) { v0[j] = 1.0f - sigmoidf_(-(v0[j] + b0[j])); v1[j] = 1.0f - sigmoidf_(-(v1[j] + b1[j])); }
                    *(u32x4*)(GATE + (size_t)row * 2048 + cb + ct) = pack8(v0, v1); } }
    }
};
struct EpiGlu {
    static constexpr bool PERM = true, AFTER_DRAIN = false;
    const bf16_t* VS; bf16_t* YS; const float* bglu;
    __device__ __forceinline__ void operator()(const f32x4 (&acc)[2][2][4][2], const Unit& u, int wr, int wc, int fr, int fq) const {
        const int cb = u.pn * 256;
        f32x4 bb[2][2];
#pragma unroll
        for (int bj = 0; bj < 2; ++bj) { const int ct = bj * HALF + wc * 32 + 8 * fq; bb[bj][0] = *(const f32x4*)(bglu + cb + ct); bb[bj][1] = *(const f32x4*)(bglu + cb + ct + 4); }
#pragma unroll
        for (int ai = 0; ai < 2; ++ai) { u32x4 sv[4][2];
#pragma unroll
            for (int m = 0; m < 4; ++m)
#pragma unroll
                for (int bj = 0; bj < 2; ++bj) sv[m][bj] = *(const u32x4*)(VS + (size_t)(u.pm * BM + ai * HALF + wr * 64 + m * 16 + fr) * 512 + cb + bj * HALF + wc * 32 + 8 * fq);
            asm volatile("s_waitcnt vmcnt(0)" ::: "memory");
#pragma unroll
            for (int m = 0; m < 4; ++m)
#pragma unroll
                for (int bj = 0; bj < 2; ++bj) { const int row = u.pm * BM + ai * HALF + wr * 64 + m * 16 + fr, ct = bj * HALF + wc * 32 + 8 * fq; f32x4 v0 = acc[ai][bj][m][0], v1 = acc[ai][bj][m][1], s0, s1; unpack8(sv[m][bj], s0, s1);
#pragma unroll
                    for (int j = 0; j < 4; ++j) { v0[j] = s0[j] * sigmoidf_(v0[j] + bb[bj][0][j]); v1[j] = s1[j] * sigmoidf_(v1[j] + bb[bj][1][j]); }
                    *(u32x4*)(YS + (size_t)row * 512 + cb + ct) = pack8(v0, v1); } }
    }
};
template <int STEP> struct EpiMerge {
    static constexpr bool PERM = true, AFTER_DRAIN = false;
    const bf16_t* GATE; bf16_t* TMP; bf16_t* MPRE;
    __device__ __forceinline__ void operator()(const f32x4 (&acc)[2][2][4][2], const Unit& u, int wr, int wc, int fr, int fq) const {
        const int cb = u.pn * 256;
#pragma unroll
        for (int ai = 0; ai < 2; ++ai) { u32x4 gv[4][2], tv[4][2];
#pragma unroll
            for (int m = 0; m < 4; ++m)
#pragma unroll
                for (int bj = 0; bj < 2; ++bj) { const size_t row = (size_t)(u.pm * BM + ai * HALF + wr * 64 + m * 16 + fr); const int ct = bj * HALF + wc * 32 + 8 * fq;
                    gv[m][bj] = *(const u32x4*)(GATE + row * 2048 + STEP * 1024 + cb + ct); if (STEP == 1) tv[m][bj] = *(const u32x4*)(TMP + row * 1024 + cb + ct); }
            asm volatile("s_waitcnt vmcnt(0)" ::: "memory");
#pragma unroll
            for (int m = 0; m < 4; ++m)
#pragma unroll
                for (int bj = 0; bj < 2; ++bj) { const size_t row = (size_t)(u.pm * BM + ai * HALF + wr * 64 + m * 16 + fr); const int ct = bj * HALF + wc * 32 + 8 * fq;
                    const f32x4 v0 = acc[ai][bj][m][0], v1 = acc[ai][bj][m][1]; f32x4 g0, g1; unpack8(gv[m][bj], g0, g1);
                    if (STEP == 0) { *(u32x4*)(TMP + row * 1024 + cb + ct) = pack8(g0 * v0, g1 * v1); }
                    else { f32x4 t0, t1; unpack8(tv[m][bj], t0, t1); *(u32x4*)(MPRE + row * 1024 + cb + ct) = pack8(t0 + g0 * v0, t1 + g1 * v1); } } }
    }
};
struct EpiOutSS {
    static constexpr bool PERM = true, AFTER_DRAIN = false;
    bf16_t* O; float* rowss;
    __device__ __forceinline__ void operator()(const f32x4 (&acc)[2][2][4][2], const Unit& u, int wr, int wc, int fr, int fq) const {
        const int cb = u.pn * 256;
#pragma unroll
        for (int ai = 0; ai < 2; ++ai)
#pragma unroll
            for (int m = 0; m < 4; ++m) { const int row = u.pm * BM + ai * HALF + wr * 64 + m * 16 + fr; float ss = 0.f;
#pragma unroll
                for (int bj = 0; bj < 2; ++bj) { const int ct = bj * HALF + wc * 32 + 8 * fq; const f32x4 v0 = acc[ai][bj][m][0], v1 = acc[ai][bj][m][1];
                    ss += (v0[0] * v0[0] + v0[1] * v0[1]) + (v0[2] * v0[2] + v0[3] * v0[3]) + (v1[0] * v1[0] + v1[1] * v1[1]) + (v1[2] * v1[2] + v1[3] * v1[3]);
                    *(u32x4*)(O + (size_t)row * 1024 + cb + ct) = pack8(v0, v1); }
                ss += __shfl_xor(ss, 16); ss += __shfl_xor(ss, 32);
                if (fq == 0) rowss[((size_t)u.pn * MT + row) * 4 + wc] = ss; }
    }
};
struct EpiPlain {
    static constexpr bool PERM = true, AFTER_DRAIN = false;
    bf16_t* O;
    __device__ __forceinline__ void operator()(const f32x4 (&acc)[2][2][4][2], const Unit& u, int wr, int wc, int fr, int fq) const {
        const int cb = u.pn * 256;
        EPI_LOOP_BEGIN *(u32x4*)(O + (size_t)row * 1024 + cb + ct) = pack8(v0, v1); EPI_LOOP_END
    }
};
struct OneUnit { int pm, pn;
    __device__ __forceinline__ bool next(int i, Unit& u) const { if (i) return false; u.pm = pm; u.pn = pn; return true; }
    __device__ __forceinline__ void a_ready(const Unit&) const {}
    __device__ __forceinline__ void done(const Unit&) const {} };
struct EpiFF {
    static constexpr bool PERM = true, AFTER_DRAIN = false;
    bf16_t* HID;
    __device__ __forceinline__ void operator()(const f32x4 (&acc)[2][2][4][2], const Unit& u, int wr, int wc, int fr, int fq) const {
#pragma unroll
        for (int ai = 0; ai < 2; ++ai)
#pragma unroll
            for (int m = 0; m < 4; ++m) { const int row = u.pm * BM + ai * HALF + wr * 64 + m * 16 + fr;
                f32x4 a0 = acc[ai][0][m][0], a1 = acc[ai][0][m][1]; const f32x4 g0 = acc[ai][1][m][0], g1 = acc[ai][1][m][1];
#pragma unroll
                for (int j = 0; j < 4; ++j) { a0[j] = siluf_(a0[j]) * g0[j]; a1[j] = siluf_(a1[j]) * g1[j]; }
                *(u32x4*)(HID + (size_t)row * DFF + u.pn * 128 + wc * 32 + 8 * fq) = pack8(a0, a1); }
    }
};
template <class Epi, class Sched>
__device__ __forceinline__ void gemm_phase(PG8_LAS unsigned char* lds, const Gemm g, const Sched& S, const Epi& E) {
    int tid_ = threadIdx.x; asm volatile("" : "+v"(tid_));
    const int tid = tid_, wid = __builtin_amdgcn_readfirstlane(tid >> 6), lane = tid & 63, wr = wid >> 2, wc = wid & 3, fr = lane & 15, fq = lane >> 4;
    const int K = g.K, nt = K / BK, LD = g.ld ? g.ld : g.K;
    unsigned voffA[2], voffB[2];
#pragma unroll
    for (int i = 0; i < 2; ++i) { int R, C; stage_rc(tid * 16 + i * 8192, R, C); const int Rb = Epi::PERM ? ((R & ~31) + perm32(R & 31)) : R;
        voffA[i] = (unsigned)(R * LD + C) * 2u; voffB[i] = (unsigned)(Rb * LD + C) * 2u; }
    const size_t kstep = (size_t)(BK * 2);
    const size_t hstep = (size_t)HALF * LD * 2;
    const size_t tstep = 2 * hstep;
    const unsigned ldsw = (unsigned)wid * 1024u;
    const int aoff = lds_byte(wr * 64 + fr, fq * 8), boff = lds_byte(wc * 32 + fr, fq * 8);
#define PG8_SA(b, h) (((b) * 2 + (h)) * HTB)
#define PG8_SB(b, h) ((4 + (b) * 2 + (h)) * HTB)
#define PG8_STAGE(bufoff, gbase, voff) do { _Pragma("unroll") for (int _i = 0; _i < 2; ++_i) \
        __builtin_amdgcn_global_load_lds((const unsigned*)((const char*)(gbase) + (voff)[_i]), (PG8_LAS unsigned*)(lds + (bufoff) + ldsw + _i * 8192), 16, 0, 0); } while (0)
#define PG8_LDA(dst, b, h) do { _Pragma("unroll") for (int m = 0; m < 4; ++m) _Pragma("unroll") for (int k = 0; k < 2; ++k) dst[m][k] = *(const PG8_LAS bf16x8*)(lds + PG8_SA(b, h) + aoff + m * 2048 + k * 1024); } while (0)
#define PG8_LDB(dst, b, h) do { _Pragma("unroll") for (int n = 0; n < 2; ++n) _Pragma("unroll") for (int k = 0; k < 2; ++k) dst[n][k] = *(const PG8_LAS bf16x8*)(lds + PG8_SB(b, h) + boff + n * 2048 + k * 1024); } while (0)
#define PG8_MMA(ai, bj, At, Bt) do { __builtin_amdgcn_s_setprio(1); _Pragma("unroll") for (int m = 0; m < 4; ++m) _Pragma("unroll") for (int n = 0; n < 2; ++n) _Pragma("unroll") for (int k = 0; k < 2; ++k) \
        acc[ai][bj][m][n] = __builtin_amdgcn_mfma_f32_16x16x32_bf16(Bt[n][k], At[m][k], acc[ai][bj][m][n], 0, 0, 0); __builtin_amdgcn_s_setprio(0); } while (0)
#define PG8_WAIT_V(n) asm volatile("s_waitcnt vmcnt(" #n ")" ::: "memory")
#define PG8_WAIT_L(n) asm volatile("s_waitcnt lgkmcnt(" #n ")" ::: "memory")
#define PG8_BAR __builtin_amdgcn_s_barrier()
#define PG8_SCHED __builtin_amdgcn_sched_barrier(0)
    Unit cur, nxt; int ui = 0;
    if (!S.next(0, cur)) return;
    f32x4 acc[2][2][4][2];
#pragma unroll
    for (int a = 0; a < 2; ++a)
#pragma unroll
        for (int b = 0; b < 2; ++b)
#pragma unroll
            for (int m = 0; m < 4; ++m)
#pragma unroll
                for (int n = 0; n < 2; ++n) acc[a][b][m][n] = (f32x4){0.f, 0.f, 0.f, 0.f};
    bf16x8 At[4][2], B0[2][2], B1[2][2];
    const char* cA = (const char*)g.A + (size_t)cur.pm * tstep; const char* cB = (const char*)g.Bt + (size_t)cur.pn * tstep;
    S.a_ready(cur);
    PG8_STAGE(PG8_SB(0, 0), cB, voffB); PG8_STAGE(PG8_SA(0, 0), cA, voffA); PG8_STAGE(PG8_SB(0, 1), cB + hstep, voffB); PG8_STAGE(PG8_SA(0, 1), cA + hstep, voffA);
    if (wr == 1) PG8_BAR;
    PG8_WAIT_V(4); PG8_BAR;
    PG8_STAGE(PG8_SB(1, 0), cB + kstep, voffB); PG8_STAGE(PG8_SA(1, 0), cA + kstep, voffA); PG8_STAGE(PG8_SB(1, 1), cB + hstep + kstep, voffB);
    PG8_WAIT_V(6); PG8_BAR;
    for (;;) {
        const bool has_next = S.next(ui + 1, nxt);
        const char* nA = has_next ? (const char*)g.A + (size_t)nxt.pm * tstep : cA; const char* nB = has_next ? (const char*)g.Bt + (size_t)nxt.pn * tstep : cB;
        for (int t = 0; t < nt; t += 2) {
            const bool last = (t == nt - 2);
            const char* a1 = cA + (size_t)(t + 1) * kstep;
            const char* a2 = last ? nA : cA + (size_t)(t + 2) * kstep; const char* b2 = last ? nB : cB + (size_t)(t + 2) * kstep;
            const char* a3 = a2 + kstep; const char* b3 = b2 + kstep;
            if (last && has_next) S.a_ready(nxt);
            PG8_LDB(B0, 0, 0); PG8_SCHED; PG8_LDA(At, 0, 0); PG8_STAGE(PG8_SA(1, 1), a1 + hstep, voffA);
            PG8_WAIT_L(8); PG8_BAR; PG8_WAIT_L(0); PG8_MMA(0, 0, At, B0); PG8_BAR; PG8_SCHED;
            PG8_LDB(B1, 0, 1); PG8_STAGE(PG8_SB(0, 0), b2, voffB);
            PG8_BAR; PG8_WAIT_L(0); PG8_MMA(0, 1, At, B1); PG8_BAR;
            PG8_LDA(At, 0, 1); PG8_STAGE(PG8_SA(0, 0), a2, voffA);
            PG8_BAR; PG8_WAIT_L(0); PG8_MMA(1, 0, At, B0); PG8_BAR; PG8_SCHED;
            PG8_STAGE(PG8_SB(0, 1), b2 + hstep, voffB);
            PG8_WAIT_V(6); PG8_BAR; PG8_MMA(1, 1, At, B1); PG8_BAR;
            PG8_LDB(B0, 1, 0); PG8_SCHED; PG8_LDA(At, 1, 0); PG8_STAGE(PG8_SA(0, 1), a2 + hstep, voffA);
            PG8_WAIT_L(8); PG8_BAR; PG8_WAIT_L(0); PG8_MMA(0, 0, At, B0); PG8_BAR; PG8_SCHED;
            PG8_LDB(B1, 1, 1); PG8_STAGE(PG8_SB(1, 0), b3, voffB);
            PG8_BAR; PG8_WAIT_L(0); PG8_MMA(0, 1, At, B1); PG8_BAR;
            PG8_LDA(At, 1, 1); PG8_STAGE(PG8_SA(1, 0), a3, voffA);
            PG8_BAR; PG8_WAIT_L(0); PG8_MMA(1, 0, At, B0); PG8_BAR; PG8_SCHED;
            PG8_STAGE(PG8_SB(1, 1), b3 + hstep, voffB);
            PG8_WAIT_V(6); PG8_BAR; PG8_MMA(1, 1, At, B1); PG8_BAR;
        }
        if constexpr (!Epi::AFTER_DRAIN) { E(acc, cur, wr, wc, fr, fq); S.done(cur); }
        if (!has_next) break;
#pragma unroll
        for (int a = 0; a < 2; ++a)
#pragma unroll
            for (int b = 0; b < 2; ++b)
#pragma unroll
                for (int m = 0; m < 4; ++m)
#pragma unroll
                    for (int n = 0; n < 2; ++n) acc[a][b][m][n] = (f32x4){0.f, 0.f, 0.f, 0.f};
        cur = nxt; cA = nA; cB = nB; ++ui;
    }
    PG8_WAIT_V(0);
    if (wr == 0) PG8_BAR;
    PG8_BAR;
    if constexpr (Epi::AFTER_DRAIN) { E.fused(acc, cur, wr, wc, fr, fq, lds, wid, lane); S.done(cur); }
#undef PG8_SA
#undef PG8_SB
#undef PG8_STAGE
#undef PG8_LDA
#undef PG8_LDB
#undef PG8_MMA
#undef PG8_WAIT_V
#undef PG8_WAIT_L
#undef PG8_BAR
#undef PG8_SCHED
}
}

__device__ __forceinline__ int ffin_row(int n) { const int half = n >= DFF, j = half ? n - DFF : n; return (j >> 7) * 256 + half * 128 + (j & 127); }
__device__ __forceinline__ void copy_tiles(const Ctx p, LAS unsigned char* lds, int tbeg, int tend, int first, int stride) {
    int tid_ = threadIdx.x; asm volatile("" : "+v"(tid_)); const int tid = tid_;
    unsigned char* ws = p.ws;
    LAS float* tile = (LAS float*)lds;
    const float* src; bf16_t* dst; int K, N, k0, n0; bool perm;
#define TILE_INFO(T) do { int t_ = (T), tk_; \
        if (t_ < 640) { src = PIN(13); K = 1024; N = 2560; dst = (bf16_t*)(ws + WS_W1T); perm = false; } \
        else if (t_ < 1152) { t_ -= 640; src = PIN(33); K = 1024; N = 2048; dst = (bf16_t*)(ws + WS_W1T) + (size_t)2560 * 1024; perm = false; } \
        else if (t_ < 1408) { t_ -= 1152; src = PIN(31); K = 1024; N = 1024; dst = (bf16_t*)(ws + WS_WPL); perm = false; } \
        else if (t_ < 1536) { t_ -= 1408; src = PIN(32); K = 512; N = 1024; dst = (bf16_t*)(ws + WS_WPS); perm = false; } \
        else if (t_ < 1792) { t_ -= 1536; src = PIN(35); K = 1024; N = 1024; dst = (bf16_t*)(ws + WS_WOUT); perm = false; } \
        else if (t_ < 3200) { t_ -= 1792; src = PIN(36); K = 1024; N = 2 * DFF; dst = (bf16_t*)(ws + WS_WFI); perm = true; } \
        else if (t_ < 3904) { t_ -= 3200; src = PIN(37); K = DFF; N = 1024; dst = (bf16_t*)(ws + WS_WFO); perm = false; } \
        else { t_ -= 3904; src = PIN(29); K = 512; N = 512; dst = (bf16_t*)(ws + WS_WGLU); perm = false; } \
        tk_ = K / 64; k0 = (t_ % tk_) * 64; n0 = (t_ / tk_) * 64; } while (0)
    {   const int r = tid >> 4, c4 = tid & 15, n = tid >> 3, kc = tid & 7;
        f32x4 v0, v1; int T = tbeg + first;
        if (T < tend) { TILE_INFO(T); v0 = *(const f32x4*)(src + (size_t)(k0 + r) * N + n0 + 4 * c4); v1 = *(const f32x4*)(src + (size_t)(k0 + r + 32) * N + n0 + 4 * c4); }
        for (; T < tend; T += stride) {
            TILE_INFO(T);
            bf16_t* const cdst = dst; const int cK = K, ck0 = k0, cdrow = perm ? ffin_row(n0 + n) : n0 + n;
            {   LAS float* t = tile + r * 65 + 4 * c4; t[0] = v0[0]; t[1] = v0[1]; t[2] = v0[2]; t[3] = v0[3]; t += 32 * 65; t[0] = v1[0]; t[1] = v1[1]; t[2] = v1[2]; t[3] = v1[3]; }
            __syncthreads();
            if (T + stride < tend) { TILE_INFO(T + stride); v0 = *(const f32x4*)(src + (size_t)(k0 + r) * N + n0 + 4 * c4); v1 = *(const f32x4*)(src + (size_t)(k0 + r + 32) * N + n0 + 4 * c4); }
            {   const LAS float* t = tile + (8 * kc) * 65 + n; u32x4 w;
                w.x = pk2(t[0], t[65]); w.y = pk2(t[130], t[195]); w.z = pk2(t[260], t[325]); w.w = pk2(t[390], t[455]);
                *(u32x4*)(cdst + (size_t)cdrow * cK + ck0 + 8 * kc) = w; }
            __syncthreads();
        }
    }
#undef TILE_INFO
}
__device__ __forceinline__ void p0_prologue(const Ctx p, LAS unsigned char* lds) {
    const int tid = threadIdx.x, G = gridDim.x, bx = blockIdx.x;
    unsigned char* ws = p.ws;
    if (bx >= G - 96) {
        const int item = bx - (G - 96), n0 = item * 64, w = tid >> 6, lane = tid & 63;
        LAS float* sc = (LAS float*)lds;
        LAS float* red = (LAS float*)(lds + 9 * 1024 * 4);
        for (int i = tid; i < 9 * 1024; i += 512) { const int j = i >> 10, k = i & 1023; const float v = j == 0 ? PIN(6)[k] : PIN(2)[(j - 1) * 1024 + k]; sc[i] = siluf_(v); }
        __syncthreads();
        float a[9];
#pragma unroll
        for (int j = 0; j < 9; ++j) a[j] = 0.f;
        const float* wm = PIN(7) + n0 + lane;
#pragma unroll 8
        for (int k = 128 * w; k < 128 * w + 128; ++k) { const float wv = wm[(size_t)k * 6144];
#pragma unroll
            for (int j = 0; j < 9; ++j) a[j] += sc[j * 1024 + k] * wv; }
#pragma unroll
        for (int j = 0; j < 9; ++j) red[(w * 9 + j) * 64 + lane] = a[j];
        __syncthreads();
        for (int i = tid; i < 9 * 64; i += 512) { const int j = i >> 6, l = i & 63; float s = PIN(8)[n0 + l];
#pragma unroll
            for (int ww = 0; ww < 8; ++ww) s += red[(ww * 9 + j) * 64 + l];
            ((float*)(ws + WS_MOD))[j * 6144 + n0 + l] = s; }
        __syncthreads();
    }
    if (bx < G - 96) { copy_tiles(p, lds, 0, 1792, bx, G - 96); copy_tiles(p, lds, 3904, 3968, bx, G - 96); }
}

#define ROW_SS(v) ((v[0][0] * v[0][0] + v[0][1] * v[0][1]) + (v[0][2] * v[0][2] + v[0][3] * v[0][3]) + (v[1][0] * v[1][0] + v[1][1] * v[1][1]) + (v[1][2] * v[1][2] + v[1][3] * v[1][3]) + \
                   (v[2][0] * v[2][0] + v[2][1] * v[2][1]) + (v[2][2] * v[2][2] + v[2][3] * v[2][3]) + (v[3][0] * v[3][0] + v[3][1] * v[3][1]) + (v[3][2] * v[3][2] + v[3][3] * v[3][3]))
__device__ __forceinline__ float wave_sum(float x) {
#pragma unroll
    for (int o = 1; o < 64; o <<= 1) x += __shfl_xor(x, o);
    return x; }
__device__ __forceinline__ f32x4 bf4(const u32x2 w) { return (f32x4){bf_lo(w.x), bf_hi(w.x), bf_lo(w.y), bf_hi(w.y)}; }
__device__ __forceinline__ bf16_t* x1_row(const Ctx p, int r) { return r < 10240 ? (bf16_t*)(p.ws + WS_X1A) + (size_t)r * 1024 : (bf16_t*)(p.ws + WS_X1B) + (size_t)(r - 10240) * 1024; }
__device__ __forceinline__ void p1_hn(const Ctx p) {
    int tid_ = threadIdx.x; asm volatile("" : "+v"(tid_)); const int tid = tid_, w = tid >> 6, lane = tid & 63, r0 = blockIdx.x * 160 + w * 20;
    bf16_t* HN = (bf16_t*)(p.ws + WS_HN);
    f32x4 gs[4], sh[4]; int cur = -1;
    for (int it = 0; it < 10; ++it) { const int r = r0 + 2 * it, mi = mod_index(r);
        if (mi != cur) { cur = mi; const float* mod = (const float*)(p.ws + WS_MOD) + mi * 6144;
#pragma unroll
            for (int j = 0; j < 4; ++j) { const int c = 4 * lane + 256 * j; gs[j] = *(const f32x4*)(PIN(9) + c) * (*(const f32x4*)(mod + 1024 + c) + 1.0f); sh[j] = *(const f32x4*)(mod + c); } }
        const float* xa = xrow(p, r); const float* xb = xrow(p, r + 1); f32x4 va[4], vb[4];
#pragma unroll
        for (int j = 0; j < 4; ++j) { va[j] = __builtin_nontemporal_load((const f32x4*)(xa + 4 * lane + 256 * j)); vb[j] = __builtin_nontemporal_load((const f32x4*)(xb + 4 * lane + 256 * j)); }
        const float ra = __builtin_amdgcn_rsqf(wave_sum(ROW_SS(va)) * (1.0f / 1024.0f) + EPS), rb = __builtin_amdgcn_rsqf(wave_sum(ROW_SS(vb)) * (1.0f / 1024.0f) + EPS);
#pragma unroll
        for (int j = 0; j < 4; ++j) { const f32x4 ya = va[j] * ra * gs[j] + sh[j], yb = vb[j] * rb * gs[j] + sh[j]; u32x2 oa, ob; oa.x = pk2(ya[0], ya[1]); oa.y = pk2(ya[2], ya[3]); ob.x = pk2(yb[0], yb[1]); ob.y = pk2(yb[2], yb[3]);
            *(u32x2*)(HN + (size_t)r * 1024 + 4 * lane + 256 * j) = oa; *(u32x2*)(HN + (size_t)(r + 1) * 1024 + 4 * lane + 256 * j) = ob; }
    }
}
__device__ __forceinline__ float row_rs(const float* ssp, int r, int lane) { float q = ssp[((size_t)((lane >> 2) & 3) * MT + r) * 4 + (lane & 3)]; q += __shfl_xor(q, 1); q += __shfl_xor(q, 2); q += __shfl_xor(q, 4); q += __shfl_xor(q, 8);
    return __builtin_amdgcn_rsqf(q * (1.0f / 1024.0f) + EPS); }
__device__ __forceinline__ void p7_x1(const Ctx p) {
    int tid_ = threadIdx.x; asm volatile("" : "+v"(tid_)); const int tid = tid_, w = tid >> 6, lane = tid & 63, r0 = blockIdx.x * 160 + w * 20;
    const bf16_t* MO = (const bf16_t*)(p.ws + WS_MO); bf16_t* HN2 = (bf16_t*)(p.ws + WS_HN2); const float* ss1 = (const float*)(p.ws + WS_SSP1);
    f32x4 gg[4], gs[4], sh[4]; int cur = -1;
    for (int it = 0; it < 10; ++it) { const int r = r0 + 2 * it, mi = mod_index(r);
        if (mi != cur) { cur = mi; const float* mod = (const float*)(p.ws + WS_MOD) + mi * 6144;
#pragma unroll
            for (int j = 0; j < 4; ++j) { const int c = 4 * lane + 256 * j; gg[j] = *(const f32x4*)(mod + 2048 + c) * *(const f32x4*)(PIN(10) + c);
                gs[j] = *(const f32x4*)(PIN(11) + c) * (*(const f32x4*)(mod + 4096 + c) + 1.0f); sh[j] = *(const f32x4*)(mod + 3072 + c); } }
        const float* xa = xrow(p, r); const float* xb = xrow(p, r + 1); f32x4 va[4], vb[4]; u32x2 ma[4], mb[4];
#pragma unroll
        for (int j = 0; j < 4; ++j) { const int c = 4 * lane + 256 * j; va[j] = __builtin_nontemporal_load((const f32x4*)(xa + c)); vb[j] = __builtin_nontemporal_load((const f32x4*)(xb + c)); ma[j] = *(const u32x2*)(MO + (size_t)r * 1024 + c); mb[j] = *(const u32x2*)(MO + (size_t)(r + 1) * 1024 + c); }
        const float sa = row_rs(ss1, r, lane), sb = row_rs(ss1, r + 1, lane);
#pragma unroll
        for (int j = 0; j < 4; ++j) { const int c = 4 * lane + 256 * j; va[j] = va[j] + gg[j] * bf4(ma[j]) * sa; vb[j] = vb[j] + gg[j] * bf4(mb[j]) * sb;
            { u32x2 oa, ob; oa.x = pk2(va[j][0], va[j][1]); oa.y = pk2(va[j][2], va[j][3]); ob.x = pk2(vb[j][0], vb[j][1]); ob.y = pk2(vb[j][2], vb[j][3]); __builtin_nontemporal_store(oa, (u32x2*)(x1_row(p, r) + c)); __builtin_nontemporal_store(ob, (u32x2*)(x1_row(p, r + 1) + c)); } }
        const float ra = __builtin_amdgcn_rsqf(wave_sum(ROW_SS(va)) * (1.0f / 1024.0f) + EPS), rb = __builtin_amdgcn_rsqf(wave_sum(ROW_SS(vb)) * (1.0f / 1024.0f) + EPS);
#pragma unroll
        for (int j = 0; j < 4; ++j) { const f32x4 ya = va[j] * ra * gs[j] + sh[j], yb = vb[j] * rb * gs[j] + sh[j]; u32x2 oa, ob; oa.x = pk2(ya[0], ya[1]); oa.y = pk2(ya[2], ya[3]); ob.x = pk2(yb[0], yb[1]); ob.y = pk2(yb[2], yb[3]);
            *(u32x2*)(HN2 + (size_t)r * 1024 + 4 * lane + 256 * j) = oa; *(u32x2*)(HN2 + (size_t)(r + 1) * 1024 + 4 * lane + 256 * j) = ob; }
    }
}
__device__ __forceinline__ void p10_out(const Ctx p) {
    int tid_ = threadIdx.x; asm volatile("" : "+v"(tid_)); const int tid = tid_, w = tid >> 6, lane = tid & 63, r0 = blockIdx.x * 160 + w * 20;
    const bf16_t* FO = (const bf16_t*)(p.ws + WS_FO); const bf16_t* FOB = (const bf16_t*)(p.ws + WS_FOB);
    f32x4 gg[4]; int cur = -1;
    for (int it = 0; it < 10; ++it) { const int r = r0 + 2 * it, mi = mod_index(r); const bool split = r >= 128 * 256;
        if (mi != cur) { cur = mi; const float* mod = (const float*)(p.ws + WS_MOD) + mi * 6144;
#pragma unroll
            for (int j = 0; j < 4; ++j) { const int c = 4 * lane + 256 * j; gg[j] = *(const f32x4*)(mod + 5120 + c) * *(const f32x4*)(PIN(12) + c); } }
        f32x4 va[4], vb[4], fa[4], fb[4];
#pragma unroll
        for (int j = 0; j < 4; ++j) { const int c = 4 * lane + 256 * j; va[j] = bf4(__builtin_nontemporal_load((const u32x2*)(x1_row(p, r) + c))); vb[j] = bf4(__builtin_nontemporal_load((const u32x2*)(x1_row(p, r + 1) + c)));
            fa[j] = bf4(*(const u32x2*)(FO + (size_t)r * 1024 + c)); fb[j] = bf4(*(const u32x2*)(FO + (size_t)(r + 1) * 1024 + c));
            if (split) { fa[j] = fa[j] + bf4(*(const u32x2*)(FOB + (size_t)r * 1024 + c)); fb[j] = fb[j] + bf4(*(const u32x2*)(FOB + (size_t)(r + 1) * 1024 + c)); } }
        const float sa = __builtin_amdgcn_rsqf(wave_sum(ROW_SS(fa)) * (1.0f / 1024.0f) + EPS), sb = __builtin_amdgcn_rsqf(wave_sum(ROW_SS(fb)) * (1.0f / 1024.0f) + EPS);
#pragma unroll
        for (int j = 0; j < 4; ++j) { const int c = 4 * lane + 256 * j; __builtin_nontemporal_store(va[j] + gg[j] * fa[j] * sa, (f32x4*)(p.out + (size_t)r * 1024 + c)); __builtin_nontemporal_store(vb[j] + gg[j] * fb[j] * sb, (f32x4*)(p.out + (size_t)(r + 1) * 1024 + c)); }
    }
}

constexpr int LRU_U16 = 0, LRU_UB = 9216, LRU_AA = LRU_UB + 17408, LRU_AGG = LRU_AA + 17408, LRU_CAR = LRU_AGG + 2048, LRU_HALF = 46592;
__device__ __forceinline__ void lru_unit(const Ctx p, LAS unsigned char* lds, int sample, int b, int hd) {
    int tid_ = threadIdx.x; asm volatile("" : "+v"(tid_)); const int tid = tid_, d = tid >> 8, ht = tid & 255, hw = ht >> 6, lane = tid & 63;
    const int T = sample ? T_S : T_CTX, row0 = sample ? MC + b * T_S : b * T_CTX, nch = T / 64;
    LAS unsigned char* L = lds + d * LRU_HALF;
    LAS bf16_t* U16 = (LAS bf16_t*)(L + LRU_U16); LAS float* UB = (LAS float*)(L + LRU_UB); LAS float* AA = (LAS float*)(L + LRU_AA);
    LAS f32x2* AGG = (LAS f32x2*)(L + LRU_AGG); LAS float* CAR = (LAS float*)(L + LRU_CAR);
    const bf16_t* XA = (const bf16_t*)(p.ws + WS_XA); const bf16_t* GA = (const bf16_t*)(p.ws + WS_GA); bf16_t* YA = (bf16_t*)(p.ws + WS_YA);
    const int fj = lane & 15, fq = lane >> 4, chg = hd * 64 + 16 * hw + fj;
    bf16x8 wrf[2], wif[2];
    {   const float* wr = PIN(16) + (size_t)(d * 16 + hd) * 4096 + 16 * hw + fj; const float* wi = PIN(18) + (size_t)(d * 16 + hd) * 4096 + 16 * hw + fj;
#pragma unroll
        for (int s = 0; s < 2; ++s)
#pragma unroll
            for (int e = 0; e < 8; ++e) { const int k = 32 * s + 8 * fq + e; wrf[s][e] = (short)f2bf(wr[k * 64]); wif[s][e] = (short)f2bf(wi[k * 64]); } }
    const float br = PIN(17)[d * 1024 + chg], bi = PIN(19)[d * 1024 + chg];
    const float sp8 = -8.0f * 1.44269504089f * log1pf(__expf(-PIN(20)[d * 1024 + chg]));
    const int cp = ht & 31, tg = ht >> 5, cc0 = hd * 64 + 2 * cp;
    float cw0[4], cw1[4];
#pragma unroll
    for (int j = 0; j < 4; ++j) { cw0[j] = PIN(14)[j * 1024 + cc0]; cw1[j] = PIN(14)[j * 1024 + cc0 + 1]; }
    const float cb0 = PIN(15)[cc0], cb1 = PIN(15)[cc0 + 1];
    const int chs = hd * 64 + lane;
    if (ht < 64) CAR[lane] = sample ? PIN(3)[(size_t)(b * 2 + d) * 1024 + chs] : 0.f;
    float hfin = 0.f;
    __syncthreads();
    unsigned xw[11];
#define LRU_LOADX(kk) do { const int c_ = d ? nch - 1 - (kk) : (kk); _Pragma("unroll") for (int i = 0; i < 11; ++i) { const int t = 64 * c_ + 8 * tg - 2 + i; unsigned w = 0u; if (t >= 0 && t < T) w = *(const unsigned*)(XA + (size_t)(row0 + t) * 1024 + cc0); xw[i] = w; } } while (0)
    LRU_LOADX(0);
    for (int k = 0; k < nch; ++k) {
        const int c = d ? nch - 1 - k : k, t0 = 64 * c; const bool second = (2 * k >= nch);
        {   float x0[11], x1[11];
#pragma unroll
            for (int i = 0; i < 11; ++i) { x0[i] = bf_lo(xw[i]); x1[i] = bf_hi(xw[i]); }
#pragma unroll
            for (int i = 0; i < 8; ++i) { const float u0 = cb0 + cw0[0] * x0[i] + cw0[1] * x0[i + 1] + cw0[2] * x0[i + 2] + cw0[3] * x0[i + 3];
                const float u1 = cb1 + cw1[0] * x1[i] + cw1[1] * x1[i + 1] + cw1[2] * x1[i + 2] + cw1[3] * x1[i + 3]; const int tl = 8 * tg + i;
                *(LAS unsigned*)(U16 + tl * 72 + 2 * cp) = pk2(u0, u1); *(LAS f32x2*)(UB + tl * 68 + 2 * cp) = (f32x2){u0, u1}; } }
        if (k + 1 < nch) LRU_LOADX(k + 1);
        unsigned short hf16[16], g16[16];
        if (second) {
#pragma unroll
            for (int i = 0; i < 16; ++i) { const int pi = 16 * hw + i, tl = d ? 63 - pi : pi; const size_t ix = (size_t)(row0 + t0 + tl) * 1024 + chs; hf16[i] = YA[ix]; g16[i] = GA[ix]; } }
        __syncthreads();
        {   f32x4 ar[4], ai[4];
#pragma unroll
            for (int m = 0; m < 4; ++m) { ar[m] = (f32x4){0.f, 0.f, 0.f, 0.f}; ai[m] = ar[m];
#pragma unroll
                for (int s = 0; s < 2; ++s) { const bf16x8 a = *(const LAS bf16x8*)(U16 + (16 * m + fj) * 72 + 32 * s + 8 * fq);
                    ar[m] = __builtin_amdgcn_mfma_f32_16x16x32_bf16(a, wrf[s], ar[m], 0, 0, 0); ai[m] = __builtin_amdgcn_mfma_f32_16x16x32_bf16(a, wif[s], ai[m], 0, 0, 0); } }
#pragma unroll
            for (int m = 0; m < 4; ++m)
#pragma unroll
                for (int r4 = 0; r4 < 4; ++r4) { const int tok = 16 * m + 4 * fq + r4, ix = tok * 68 + 16 * hw + fj;
                    const float rg = sigmoidf_(ar[m][r4] + br), a = __builtin_amdgcn_exp2f(sp8 * rg);
                    const float ei = 1.0f + __builtin_amdgcn_exp2f(-1.44269504089f * (ai[m][r4] + bi)), om = fmaxf(1.0f - a * a, 1e-30f);
                    const float bb = om * __builtin_amdgcn_rsqf(om * ei * ei) * UB[ix]; AA[ix] = a; UB[ix] = bb; } }
        __syncthreads();
        float av[16], bv[16]; float P = 1.f, h = 0.f;
#pragma unroll
        for (int i = 0; i < 16; ++i) { const int pi = 16 * hw + i, tl = d ? 63 - pi : pi; av[i] = AA[tl * 68 + lane]; bv[i] = UB[tl * 68 + lane]; h = av[i] * h + bv[i]; P *= av[i]; }
        AGG[hw * 64 + lane] = (f32x2){P, h};
        __syncthreads();
        h = CAR[(k & 1) * 64 + lane];
        for (int s2 = 0; s2 < hw; ++s2) { const f32x2 ag = AGG[s2 * 64 + lane]; h = ag.x * h + ag.y; }
#pragma unroll
        for (int i = 0; i < 16; ++i) { const int pi = 16 * hw + i, tl = d ? 63 - pi : pi; const size_t ix = (size_t)(row0 + t0 + tl) * 1024 + chs; h = av[i] * h + bv[i];
            YA[ix] = f2bf1(second ? bf2f(g16[i]) * (bf2f(hf16[i]) + h) : h); }
        if (hw == 3) { CAR[((k + 1) & 1) * 64 + lane] = h; hfin = h; }
        if (2 * k + 2 == nch) asm volatile("s_waitcnt vmcnt(0)" ::: "memory");
        __syncthreads();
    }
#undef LRU_LOADX
    if (!sample && hw == 3) p.out[OFF_LRU + (size_t)(b * 2 + d) * 1024 + chs] = hfin;
}

__device__ __forceinline__ void sincos_f(float x, float& s, float& c) {
    const float jf = rintf(x * 0.636619772f); const int j = (int)jf;
    float r = x - jf * 1.5703125f; r -= jf * 4.837512969970703125e-4f; r -= jf * 7.54978995489188216e-8f;
    const float z = r * r;
    const float sp = r + r * z * (-1.6666654611e-1f + z * (8.3321608736e-3f + z * (-1.9515295891e-4f)));
    const float cp = 1.0f - 0.5f * z + z * z * (4.166664568298827e-2f + z * (-1.388731625493765e-3f + z * 2.443315711809948e-5f));
    const int q = j & 3;
    s = (q == 0) ? sp : (q == 1) ? cp : (q == 2) ? -sp : -cp;
    c = (q == 0) ? cp : (q == 1) ? -sp : (q == 2) ? -cp : sp;
}
__device__ __forceinline__ void s5_disc(const Ctx p, int d, int g, int ps, float& abr, float& abi, float& fre, float& fim) {
    const float lr = PIN(21)[(d * 32 + g) * 64 + ps], li = PIN(22)[(d * 32 + g) * 64 + ps], dt = __expf(PIN(23)[d * 32 + g]);
    const float mag = __expf(lr * dt); float sn, cs; sincos_f(li * dt, sn, cs);
    abr = mag * cs; abi = mag * sn;
    const float den = lr * lr + li * li, nr = abr - 1.0f, ni = abi;
    fre = (nr * lr + ni * li) / den; fim = (ni * lr - nr * li) / den;
}
constexpr int S5_HS_STRIDE = 272, S5_HS_WAVE = 32 * S5_HS_STRIDE;
__device__ __forceinline__ void s5_item(const Ctx p, LAS unsigned char* lds, int sample, int b, int g0) {
    int tid_ = threadIdx.x; asm volatile("" : "+v"(tid_)); const int tid = tid_, w = tid >> 6, lane = tid & 63, d = w & 1, g = g0 + (w >> 1);
    const int T = sample ? T_S : T_CTX, row0 = sample ? MC + b * T_S : b * T_CTX, nch = T / 32;
    LAS unsigned char* Hs = lds + w * S5_HS_WAVE;
    const bf16_t* XS = (const bf16_t*)(p.ws + WS_XS); bf16_t* VS = (bf16_t*)(p.ws + WS_VS);
    const int j31 = lane & 31, hi = lane >> 5;
    float abr1, abi1, fr1, fi1, abr2, abi2, fr2, fi2;
    s5_disc(p, d, g, j31, abr1, abi1, fr1, fi1); s5_disc(p, d, g, 32 + j31, abr2, abi2, fr2, fi2);
    const float abr = hi ? abr2 : abr1, abi = hi ? abi2 : abi1;
    bf16x8 bfr[4];
#pragma unroll
    for (int st = 0; st < 2; ++st) { const int ps = 32 * st + j31; const float fr = st ? fr2 : fr1, fi = st ? fi2 : fi1;
        const float* bre = PIN(24) + ((size_t)(d * 32 + g) * 64 + ps) * 16 + 8 * hi; const float* bim = PIN(25) + ((size_t)(d * 32 + g) * 64 + ps) * 16 + 8 * hi;
#pragma unroll
        for (int e = 0; e < 8; ++e) { const float vr = bre[e], vi = bim[e]; bfr[2 * st][e] = (short)f2bf(fr * vr - fi * vi); bfr[2 * st + 1][e] = (short)f2bf(fr * vi + fi * vr); } }
    const int fh = lane & 15, kq = lane >> 4;
    bf16x8 cfr[4];
#pragma unroll
    for (int ks = 0; ks < 4; ++ks)
#pragma unroll
        for (int e = 0; e < 8; ++e) { const int pp = 16 * ks + 4 * kq + (e >> 1); const size_t ix = ((size_t)(d * 32 + g) * 16 + fh) * 64 + pp;
            cfr[ks][e] = (short)f2bf((e & 1) ? -PIN(27)[ix] : PIN(26)[ix]); }
    const float dsk = PIN(28)[g * 16 + fh];
    const float one = __builtin_fmaf(dsk, 0.f, 1.0f);
    float hr = 0.f, hi_ = 0.f;
    if (sample) { const size_t ix = ((size_t)(b * 2 + d) * 32 + g) * 64 + lane; hr = PIN(4)[ix]; hi_ = PIN(5)[ix]; }
    const int step = (d ? -1 : 1) * (sample ? 64 : 1);
    const int ua_off = step * 512 * j31 + g * 16 + 8 * hi;
    int eoff[8];
#pragma unroll
    for (int e = 0; e < 8; ++e) eoff[e] = step * 512 * (16 * (e >> 2) + 4 * kq + (e & 3)) + g * 16 + fh;
#define S5_CBASE(kk) ({ const int s0_ = d ? T - 1 - 32 * (kk) : 32 * (kk); const int t0_ = sample ? ((s0_ & 63) * 64 + (s0_ >> 6)) : s0_; (size_t)(row0 + t0_) * 512; })
    bf16x8 ua_next = *(const bf16x8*)(XS + S5_CBASE(0) + ua_off);
    for (int k = 0; k < nch; ++k) {
        const bool second = (2 * k >= nch);
        const size_t cbase = S5_CBASE(k);
        const bf16x8 ua = ua_next;
        if (k + 1 < nch) ua_next = *(const bf16x8*)(XS + S5_CBASE(k + 1) + ua_off);
        unsigned short vf16[8], xs16[8];
        if (second) {
#pragma unroll
            for (int mt = 0; mt < 2; ++mt)
#pragma unroll
                for (int r4 = 0; r4 < 4; ++r4) { const size_t ix = cbase + eoff[mt * 4 + r4]; vf16[mt * 4 + r4] = VS[ix]; xs16[mt * 4 + r4] = XS[ix]; } }
        f32x16 acc[4];
#pragma unroll
        for (int nt = 0; nt < 4; ++nt) { f32x16 z;
#pragma unroll
            for (int v = 0; v < 16; ++v) z[v] = 0.f;
            acc[nt] = __builtin_amdgcn_mfma_f32_32x32x16_bf16(ua, bfr[nt], z, 0, 0, 0); }
        float bur[32], bui[32];
#pragma unroll
        for (int v = 0; v < 16; ++v) {
            unsigned r0 = __builtin_bit_cast(unsigned, acc[0][v] * one), r1 = __builtin_bit_cast(unsigned, acc[2][v] * one);
            unsigned q0 = __builtin_bit_cast(unsigned, acc[1][v] * one), q1 = __builtin_bit_cast(unsigned, acc[3][v] * one);
            asm volatile("s_nop 1\n\tv_permlane32_swap_b32 %0, %1" : "+v"(r0), "+v"(r1));
            asm volatile("s_nop 1\n\tv_permlane32_swap_b32 %0, %1" : "+v"(q0), "+v"(q1));
            const int ta = 8 * (v >> 2) + (v & 3);
            bur[ta] = __builtin_bit_cast(float, r0); bur[ta + 4] = __builtin_bit_cast(float, r1);
            bui[ta] = __builtin_bit_cast(float, q0); bui[ta + 4] = __builtin_bit_cast(float, q1); }
#pragma unroll
        for (int tt = 0; tt < 32; ++tt) { const float nr = abr * hr - abi * hi_ + bur[tt], ni = abr * hi_ + abi * hr + bui[tt]; hr = nr; hi_ = ni;
            *(LAS unsigned*)(Hs + tt * S5_HS_STRIDE + 4 * lane) = pk2(hr, hi_); }
        f32x4 ya[2];
#pragma unroll
        for (int mt = 0; mt < 2; ++mt) { ya[mt] = (f32x4){0.f, 0.f, 0.f, 0.f};
#pragma unroll
            for (int ks = 0; ks < 4; ++ks) { const bf16x8 a = *(const LAS bf16x8*)(Hs + (16 * mt + fh) * S5_HS_STRIDE + (32 * ks + 8 * kq) * 2);
                ya[mt] = __builtin_amdgcn_mfma_f32_16x16x32_bf16(a, cfr[ks], ya[mt], 0, 0, 0); } }
#pragma unroll
        for (int mt = 0; mt < 2; ++mt)
#pragma unroll
            for (int r4 = 0; r4 < 4; ++r4) { const size_t ix = cbase + eoff[mt * 4 + r4]; float y = ya[mt][r4];
                if (second) { y = gelu_tanh(y + bf2f(vf16[mt * 4 + r4]) + dsk * bf2f(xs16[mt * 4 + r4])); }
                VS[ix] = f2bf1(y); }
        if (2 * k + 2 == nch) { asm volatile("s_waitcnt vmcnt(0)" ::: "memory"); __syncthreads(); }
    }
#undef S5_CBASE
    if (!sample) { const size_t ix = ((size_t)(b * 2 + d) * 32 + g) * 64 + lane; p.out[OFF_RE + ix] = hr; p.out[OFF_IM + ix] = hi_; }
}
__device__ __forceinline__ void p3_scans(const Ctx p, LAS unsigned char* lds) {
    const int bx = blockIdx.x;
    if (bx < 128) { lru_unit(p, lds, 1, bx >> 4, bx & 15); }
    else if (bx < 192) { const int i = bx - 128; s5_item(p, lds, 1, i >> 3, 4 * (i & 7)); }
    else { const int i = bx - 192;
        for (int e = 0; e < 8; ++e) { const int c = 8 * i + e; lru_unit(p, lds, 0, c >> 4, c & 15); __syncthreads(); }
        for (int e = 0; e < 4; ++e) { const int c = 4 * i + e; s5_item(p, lds, 0, c >> 3, 4 * (c & 7)); __syncthreads(); } }
}

#define XB_TMO      128
#define XB_XCNT(j)  (256  + 64 * (j))
#define XB_XSUB(j)  (1280 + 64 * (j))
#define XB_XGEN(j)  (2304 + 64 * (j))
#define XB_TOP      3328
#define XB_TOPGEN   3392
#define XCD_BAR_WORDS 3456
#define XB_SPIN_CAP (1u << 18)

__device__ __forceinline__ unsigned xb_ld(unsigned* p)              { return __hip_atomic_load(p, __ATOMIC_RELAXED, __HIP_MEMORY_SCOPE_AGENT); }
__device__ __forceinline__ unsigned xb_add(unsigned* p, unsigned v) { return __hip_atomic_fetch_add(p, v, __ATOMIC_RELAXED, __HIP_MEMORY_SCOPE_AGENT); }
__device__ __forceinline__ unsigned xb_xcc_id() { return (unsigned)__builtin_amdgcn_s_getreg((3 << 11) | 20) & 0xFu; }
#define XB_SPIN(cond, bar) do { unsigned _sp = 0; while (cond) { __builtin_amdgcn_s_sleep(1); \
    if ((++_sp & 255u) == 0u) { if (xb_ld(&(bar)[XB_TMO])) break; if (_sp > XB_SPIN_CAP) { atomicAdd(&(bar)[XB_TMO], 1u); break; } } } } while (0)

struct XcdBarrier {
    unsigned* bar; unsigned x;
    volatile LAS unsigned* st;
};

__device__ __forceinline__ XcdBarrier xcd_barrier_post(unsigned* bar, volatile LAS unsigned* st) {
    XcdBarrier b; b.bar = bar; b.x = xb_xcc_id(); b.st = st;
    if (threadIdx.x == 0) (void)xb_add(&bar[XB_XCNT(b.x)], 1u);
    return b;
}
__device__ __forceinline__ void xcd_barrier_complete(unsigned* bar, unsigned x, unsigned& nloc, unsigned& nx) {
    const unsigned G = gridDim.x * gridDim.y * gridDim.z;
    unsigned sum, cnt, mine, sp = 0u;
    for (;;) {
        sum = 0u; cnt = 0u; mine = 0u;
#pragma unroll
        for (unsigned j = 0; j < 16; ++j) { const unsigned c = xb_ld(&bar[XB_XCNT(j)]); sum += c; cnt += (c > 0u) ? 1u : 0u; mine = (j == x) ? c : mine; }
        if (sum == G) break;
        __builtin_amdgcn_s_sleep(1);
        if ((++sp & 255u) == 0u) { if (xb_ld(&bar[XB_TMO])) break; if (sp > XB_SPIN_CAP) { atomicAdd(&bar[XB_TMO], 1u); break; } }
    }
    nloc = mine > 0u ? mine : 1u; nx = cnt > 0u ? cnt : 1u;
}

__device__ __forceinline__ void xcd_barrier(const XcdBarrier& b) {
    asm volatile("s_waitcnt vmcnt(0)" ::: "memory");
    __syncthreads();
    if (threadIdx.x == 0) {
        unsigned* bar = b.bar;
        __builtin_amdgcn_s_waitcnt(0);
        unsigned nloc = b.st[0], nx = b.st[1];
        if (nloc == 0u) { xcd_barrier_complete(bar, b.x, nloc, nx); b.st[0] = nloc; b.st[1] = nx; }
        const unsigned old = xb_add(&bar[XB_XSUB(b.x)], 1u);
        const unsigned gen = old / nloc;
        if (old + 1u == (gen + 1u) * nloc) {
            __builtin_amdgcn_fence(__ATOMIC_RELEASE, "agent");
            asm volatile("s_waitcnt vmcnt(0)" ::: "memory");
            const unsigned og = xb_add(&bar[XB_TOP], 1u);
            const unsigned tg = og / nx;
            if (og + 1u == (tg + 1u) * nx) xb_add(&bar[XB_TOPGEN], 1u);
            else XB_SPIN(xb_ld(&bar[XB_TOPGEN]) == tg, bar);
            __builtin_amdgcn_fence(__ATOMIC_ACQUIRE, "agent");
            xb_add(&bar[XB_XGEN(b.x)], 1u);
            asm volatile("s_waitcnt vmcnt(0)" ::: "memory");
        } else {
            XB_SPIN(xb_ld(&bar[XB_XGEN(b.x)]) == gen, bar);
            __builtin_amdgcn_fence(__ATOMIC_ACQUIRE, "agent");
            asm volatile("s_waitcnt vmcnt(0)" ::: "memory");
        }
    }
    __syncthreads();
}

#define GRID_SYNC() do { asm volatile("s_waitcnt vmcnt(0)" ::: "memory"); grid.sync(); if (threadIdx.x < 64) { __builtin_amdgcn_fence(__ATOMIC_ACQUIRE, "agent"); asm volatile("s_waitcnt vmcnt(0)" ::: "memory"); } __syncthreads(); } while (0)
__global__ void __launch_bounds__(512, 2) fwd_mega(Params kp) {
    extern __shared__ __attribute__((aligned(16))) unsigned char lds_raw[];
    LAS unsigned char* lds = (LAS unsigned char*)lds_raw;
    {   LAS unsigned long long* t_ = (LAS unsigned long long*)(lds + LDS_BYTES - 512);
        if (threadIdx.x == 0) { t_[0] = (unsigned long long)kp.in[0]; t_[1] = (unsigned long long)kp.in[1]; t_[2] = (unsigned long long)kp.in[2]; t_[3] = (unsigned long long)kp.in[3]; t_[4] = (unsigned long long)kp.in[4]; t_[5] = (unsigned long long)kp.in[5]; t_[6] = (unsigned long long)kp.in[6]; t_[7] = (unsigned long long)kp.in[7]; t_[8] = (unsigned long long)kp.in[8]; t_[9] = (unsigned long long)kp.in[9]; t_[10] = (unsigned long long)kp.in[10]; t_[11] = (unsigned long long)kp.in[11]; t_[12] = (unsigned long long)kp.in[12]; t_[13] = (unsigned long long)kp.in[13]; t_[14] = (unsigned long long)kp.in[14]; t_[15] = (unsigned long long)kp.in[15]; t_[16] = (unsigned long long)kp.in[16]; t_[17] = (unsigned long long)kp.in[17]; t_[18] = (unsigned long long)kp.in[18]; t_[19] = (unsigned long long)kp.in[19]; t_[20] = (unsigned long long)kp.in[20]; t_[21] = (unsigned long long)kp.in[21]; t_[22] = (unsigned long long)kp.in[22]; t_[23] = (unsigned long long)kp.in[23]; t_[24] = (unsigned long long)kp.in[24]; t_[25] = (unsigned long long)kp.in[25]; t_[26] = (unsigned long long)kp.in[26]; t_[27] = (unsigned long long)kp.in[27]; t_[28] = (unsigned long long)kp.in[28]; t_[29] = (unsigned long long)kp.in[29]; t_[30] = (unsigned long long)kp.in[30]; t_[31] = (unsigned long long)kp.in[31]; t_[32] = (unsigned long long)kp.in[32]; t_[33] = (unsigned long long)kp.in[33]; t_[34] = (unsigned long long)kp.in[34]; t_[35] = (unsigned long long)kp.in[35]; t_[36] = (unsigned long long)kp.in[36]; t_[37] = (unsigned long long)kp.in[37]; }
        __syncthreads(); }
    Ctx p; p.tbl = (const LAS unsigned long long*)(lds + LDS_BYTES - 512); p.out = kp.out; p.ws = kp.ws;
    cg::grid_group grid = cg::this_grid();
    unsigned char* ws = p.ws; const int G = gridDim.x, bx = blockIdx.x;
    bf16_t* GATE = (bf16_t*)p.out;
    volatile LAS unsigned* xst = (volatile LAS unsigned*)(lds + LDS_BYTES - 512 - 16);
    if (threadIdx.x < 4) xst[threadIdx.x] = 0u;
    __syncthreads();
    const XcdBarrier xb = xcd_barrier_post((unsigned*)(ws + 768 * 1024), xst);
#define GRID_BAR() xcd_barrier(xb)
    p0_prologue(p, lds);
    if (G == 0x7fffffff) GRID_SYNC();
    GRID_BAR();
    p1_hn(p);
    GRID_BAR();
    {   pg8::Gemm g{(const bf16_t*)(ws + WS_HN), (const bf16_t*)(ws + WS_W1T), MT, 2560, 1024}; pg8::StaticOrder S; S.init(MT, 2560, G, bx);
        pg8::Epi1 E{(bf16_t*)(ws + WS_XA), (bf16_t*)(ws + WS_GA), (bf16_t*)(ws + WS_XS)};
        pg8::gemm_phase<pg8::Epi1, pg8::StaticOrder>(lds, g, S, E);
        pg8::Gemm g2{(const bf16_t*)(ws + WS_HN), (const bf16_t*)(ws + WS_W1T) + (size_t)2560 * 1024, MT, 2048, 1024}; pg8::ListOrder S2; S2.init(MT, 2048, G, bx); S2.base = bx; S2.stride = 256; S2.count = 3; S2.extra = bx >= 64 ? 768 + (bx - 64) : -1;
        pg8::EpiGate E2{GATE, PIN(34)};
        pg8::gemm_phase<pg8::EpiGate, pg8::ListOrder>(lds, g2, S2, E2); }
    GRID_BAR();
    p3_scans(p, lds);
    if (bx < 128 || bx >= 192) {
        __syncthreads();
        pg8::Gemm g2{(const bf16_t*)(ws + WS_HN), (const bf16_t*)(ws + WS_W1T) + (size_t)2560 * 1024, MT, 2048, 1024}; pg8::ListOrder S2; S2.init(MT, 2048, G, bx);
        S2.extra = -1; if (bx >= 192) { S2.base = 1088 + (bx - 192); S2.stride = 64; S2.count = 3; } else { S2.base = 960 + bx; S2.stride = 1; S2.count = 1; }
        pg8::EpiGate E2{GATE, PIN(34)};
        pg8::gemm_phase<pg8::EpiGate, pg8::ListOrder>(lds, g2, S2, E2);
    }
    GRID_BAR();
    {
        pg8::StaticOrder S; S.init(MT, 1024, G, bx);
        pg8::Gemm ga{(const bf16_t*)(ws + WS_YA), (const bf16_t*)(ws + WS_WPL), MT, 1024, 1024};
        pg8::EpiMerge<0> Ea{GATE, (bf16_t*)(ws + WS_TMP), (bf16_t*)(ws + WS_MPRE)};
        pg8::gemm_phase<pg8::EpiMerge<0>, pg8::StaticOrder>(lds, ga, S, Ea);
        pg8::Gemm g{(const bf16_t*)(ws + WS_VS), (const bf16_t*)(ws + WS_WGLU), MT, 512, 512}; pg8::StaticOrder S4; S4.init(MT, 512, G, (bx + 128) & 255);
        pg8::EpiGlu E{(const bf16_t*)(ws + WS_VS), (bf16_t*)(ws + WS_YS), PIN(30)};
        pg8::gemm_phase<pg8::EpiGlu, pg8::StaticOrder>(lds, g, S4, E); }
    GRID_BAR();
    {   pg8::StaticOrder S; S.init(MT, 1024, G, bx);
        pg8::Gemm gb{(const bf16_t*)(ws + WS_YS), (const bf16_t*)(ws + WS_WPS), MT, 1024, 512};
        pg8::EpiMerge<1> Eb{GATE, (bf16_t*)(ws + WS_TMP), (bf16_t*)(ws + WS_MPRE)};
        pg8::gemm_phase<pg8::EpiMerge<1>, pg8::StaticOrder>(lds, gb, S, Eb);
        if (bx >= 128) copy_tiles(p, lds, 3200, 3904, bx - 128, 128); }
    GRID_BAR();
    {   pg8::Gemm g{(const bf16_t*)(ws + WS_MPRE), (const bf16_t*)(ws + WS_WOUT), MT, 1024, 1024}; pg8::StaticOrder S; S.init(MT, 1024, G, bx);
        pg8::EpiOutSS E{(bf16_t*)(ws + WS_MO), (float*)(ws + WS_SSP1)};
        pg8::gemm_phase<pg8::EpiOutSS, pg8::StaticOrder>(lds, g, S, E);
        if (bx >= 128) copy_tiles(p, lds, 1792, 3200, bx - 128, 128); }
    GRID_BAR();
    p7_x1(p);
    GRID_BAR();
    {   pg8::Gemm g{(const bf16_t*)(ws + WS_HN2), (const bf16_t*)(ws + WS_WFI), MT, 2 * DFF, 1024}; pg8::StaticOrder S; S.init(MT, 2 * DFF, G, bx);
        pg8::EpiFF E{(bf16_t*)(ws + WS_HID)};
        pg8::gemm_phase<pg8::EpiFF, pg8::StaticOrder>(lds, g, S, E); }
    GRID_BAR();
    {
        pg8::Gemm g{(const bf16_t*)(ws + WS_HID), (const bf16_t*)(ws + WS_WFO), MT, 1024, DFF}; pg8::StaticOrder S; S.init(128 * 256, 1024, G, bx);
        pg8::EpiPlain E{(bf16_t*)(ws + WS_FO)};
        pg8::gemm_phase<pg8::EpiPlain, pg8::StaticOrder>(lds, g, S, E);
        const int tile = bx >> 1, kh = bx & 1;
        pg8::Gemm gh{(const bf16_t*)(ws + WS_HID) + kh * (DFF / 2), (const bf16_t*)(ws + WS_WFO) + kh * (DFF / 2), MT, 1024, DFF / 2, DFF};
        pg8::OneUnit S1{128 + (tile >> 2), tile & 3};
        pg8::EpiPlain Eh{(bf16_t*)(ws + (kh ? WS_FOB : WS_FO))};
        pg8::gemm_phase<pg8::EpiPlain, pg8::OneUnit>(lds, gh, S1, Eh); }
    GRID_BAR();
    p10_out(p);
}

extern "C" void kernel_launch(void* const* d_in, const int* in_sizes, int n_in, void* d_out, int out_size, void* d_ws, size_t ws_size, hipStream_t stream) {
    static int grid = 0;
    if (grid == 0) {
        if (n_in != 38 || (size_t)out_size != OFF_IM + 32 * 2 * 32 * 64 || ws_size < WS_END) { fprintf(stderr, "kernel_launch: unexpected shapes (n_in %d out %d ws %zu)\n", n_in, out_size, ws_size); grid = -1; return; }
        int dev = 0, cus = 0, per_cu = 0;
        hipGetDevice(&dev); hipDeviceGetAttribute(&cus, hipDeviceAttributeMultiprocessorCount, dev);
        if (hipFuncSetAttribute((const void*)fwd_mega, hipFuncAttributeMaxDynamicSharedMemorySize, LDS_BYTES) != hipSuccess) { fprintf(stderr, "kernel_launch: hipFuncSetAttribute failed\n"); grid = -1; return; }
        if (hipOccupancyMaxActiveBlocksPerMultiprocessor(&per_cu, (const void*)fwd_mega, 512, LDS_BYTES) != hipSuccess || per_cu < 1) { fprintf(stderr, "kernel_launch: occupancy query says %d blocks/CU\n", per_cu); grid = -1; return; }
        if (cus < 256) { fprintf(stderr, "kernel_launch: needs 256 CUs, device has %d\n", cus); grid = -1; return; }
        grid = 256;
    }
    if (grid < 0) return;
    Params p{};
    for (int i = 0; i < 38; ++i) p.in[i] = (const float*)d_in[i];
    p.out = (float*)d_out; p.ws = (unsigned char*)d_ws;
    if (hipMemsetAsync((char*)d_ws + 768 * 1024, 0, XCD_BAR_WORDS * 4, stream) != hipSuccess) { fprintf(stderr, "kernel_launch: hipMemsetAsync of the barrier word failed\n"); return; }
    void* args[] = {&p};
    hipError_t e = hipLaunchCooperativeKernel((const void*)fwd_mega, dim3(grid), dim3(512), args, LDS_BYTES, stream);
    if (e != hipSuccess) fprintf(stderr, "cooperative launch failed: %s\n", hipGetErrorString(e));
}
```

```cpp
#include <hip/hip_runtime.h>
#include <hip/hip_cooperative_groups.h>
#include <cstdio>
#include <cstdint>
namespace cg = cooperative_groups;

#define LAS __attribute__((address_space(3)))
typedef unsigned short bf16_t;
typedef short bf16x8 __attribute__((ext_vector_type(8)));
typedef float f32x4 __attribute__((ext_vector_type(4)));
typedef float f32x16 __attribute__((ext_vector_type(16)));
typedef float f32x2 __attribute__((ext_vector_type(2)));
typedef unsigned u32x4 __attribute__((ext_vector_type(4)));
typedef unsigned u32x2 __attribute__((ext_vector_type(2)));

constexpr int DM = 1024, MC = 8192, MS = 32768, MT = MC + MS;
constexpr int NB_CTX = 32, T_CTX = 256, NB_S = 8, T_S = 4096;
constexpr int DFF = 2816, DS5 = 512;
constexpr float EPS = 1e-6f;
constexpr size_t OFF_LRU = (size_t)MT * DM, OFF_RE = OFF_LRU + 32 * 2 * 1024, OFF_IM = OFF_RE + 32 * 2 * 32 * 64;
constexpr size_t MiB = 1u << 20;
constexpr size_t WS_MOD = 512 * 1024;
constexpr size_t WS_W1T = 1 * MiB, WS_WPL = 10 * MiB, WS_WPS = 12 * MiB, WS_WOUT = 13 * MiB, WS_WFI = 15 * MiB, WS_WFO = 26 * MiB, WS_WGLU = 31 * MiB + 512 * 1024;
constexpr size_t WS_HN = 32 * MiB, WS_XA = 112 * MiB, WS_XS = 192 * MiB, WS_VS = 232 * MiB, WS_YA = 272 * MiB, WS_GA = 352 * MiB, WS_SSP1 = 432 * MiB, WS_SSP2 = 435 * MiB, WS_X1A = 252 * MiB  , WS_X1B = 438 * MiB  , WS_END = 498 * MiB;
constexpr size_t WS_TMP = WS_HN, WS_MPRE = WS_GA, WS_MO = WS_HN, WS_HN2 = WS_GA, WS_HID = WS_HN, WS_FO = WS_YA, WS_FOB = WS_GA, WS_YS = WS_XS;
constexpr int LDS_BYTES = 147456;

struct Params { const float* in[38]; float* out; unsigned char* ws; };
struct Ctx { const LAS unsigned long long* tbl; float* out; unsigned char* ws; };
__device__ __forceinline__ const float* inp_(const LAS unsigned long long* tbl, int i) { const unsigned long long v = tbl[i];
    const unsigned lo = __builtin_amdgcn_readfirstlane((unsigned)v), hi = __builtin_amdgcn_readfirstlane((unsigned)(v >> 32)); return (const float*)(const __attribute__((address_space(1))) float*)(((unsigned long long)hi << 32) | lo); }
#define PIN(i) inp_(p.tbl, (i))

__device__ __forceinline__ unsigned f2bf(float f) { unsigned u = __builtin_bit_cast(unsigned, f); return (u + 0x7fffu + ((u >> 16) & 1u)) >> 16; }
__device__ __forceinline__ unsigned pk2(float lo, float hi) { unsigned r; asm volatile("s_nop 1\n\tv_cvt_pk_bf16_f32 %0, %1, %2" : "=v"(r) : "v"(lo), "v"(hi)); return r; }
__device__ __forceinline__ bf16_t f2bf1(float x) { return (bf16_t)(pk2(x, 0.f) & 0xffffu); }
__device__ __forceinline__ float bf_lo(unsigned w) { return __builtin_bit_cast(float, w << 16); }
__device__ __forceinline__ float bf_hi(unsigned w) { return __builtin_bit_cast(float, w & 0xffff0000u); }
__device__ __forceinline__ float bf2f(bf16_t h) { return __builtin_bit_cast(float, ((unsigned)h) << 16); }
__device__ __forceinline__ float sigmoidf_(float x) { return __builtin_amdgcn_rcpf(1.0f + __builtin_amdgcn_exp2f(-1.44269504089f * x)); }
__device__ __forceinline__ float siluf_(float x) { return x * sigmoidf_(x); }
__device__ __forceinline__ float gelu_tanh(float x) { const float u = x + 0.044715f * x * x * x; return x * __builtin_amdgcn_rcpf(1.0f + __builtin_amdgcn_exp2f(-2.30220819f * u)); }
__device__ __forceinline__ const float* xrow(const Ctx p, int r) { return r < MC ? PIN(0) + (size_t)r * DM : PIN(1) + (size_t)(r - MC) * DM; }
__device__ __forceinline__ int mod_index(int r) { return r < MC ? 0 : 1 + ((r - MC) >> 12); }
namespace pg8 {
#define PG8_LAS __attribute__((address_space(3)))
constexpr int BM = 256, BK = 64, HALF = 128, HTB = HALF * BK * 2  , STAGE_BYTES = 8 * HTB, NXCD = 8, WGM = 8;
__host__ __device__ __forceinline__ int lds_byte(int r, int c) { const int st = (r >> 4) * 2 + (c >> 5), rr = r & 15, cc = c & 31, ob = rr * 64 + cc * 2; return st * 1024 + (ob ^ (((ob >> 9) & 1) << 5)); }
__host__ __device__ __forceinline__ void stage_rc(int b, int& R, int& C) { const int st = b / 1024, sb = b % 1024, swz = sb ^ (((sb >> 9) & 1) << 5); R = (st >> 1) * 16 + swz / 64; C = (st & 1) * 32 + (swz % 64) / 2; }
__host__ __device__ __forceinline__ int perm32(int rho) { const int n = rho >> 4, i = rho & 15; return 8 * (i >> 2) + 4 * n + (i & 3); }
struct Unit { int pm, pn; };
struct Gemm { const bf16_t* A; const bf16_t* Bt; int M, N, K; int ld = 0; };
struct StaticOrder {
    int nM, nN, nwg, G, c;
    __host__ __device__ void init(int M, int N, int G_, int c_) { nM = M / BM; nN = N / BM; nwg = nM * nN; G = G_; c = c_; }
    __host__ __device__ bool next(int i, Unit& u) const {
        const long L = (long)i * G + c; if (L >= nwg) return false;
        int wgid = (int)L; { const int q = nwg / NXCD, r = nwg % NXCD, xcd = wgid % NXCD, off = wgid / NXCD; wgid = (xcd < r ? xcd * (q + 1) : r * (q + 1) + (xcd - r) * q) + off; }
        const int nig = WGM * nN, gid = wgid / nig, fm = gid * WGM, gsz = (nM - fm) < WGM ? (nM - fm) : WGM;
        u.pm = fm + ((wgid % nig) % gsz); u.pn = (wgid % nig) / gsz; return true;
    }
    __device__ __forceinline__ void a_ready(const Unit&) const {}
    __device__ __forceinline__ void done(const Unit&) const {}
};
struct ListOrder : StaticOrder {
    int base, stride, count, extra;
    __host__ __device__ bool next(int i, Unit& u) const {
        if (i > count || (i == count && extra < 0)) return false;
        const long L = (i < count) ? (long)base + (long)i * stride : (long)extra; if (L >= nwg) return false;
        int wgid = (int)L; { const int q = nwg / NXCD, r = nwg % NXCD, xcd = wgid % NXCD, off = wgid / NXCD; wgid = (xcd < r ? xcd * (q + 1) : r * (q + 1) + (xcd - r) * q) + off; }
        const int nig = WGM * nN, gid = wgid / nig, fm = gid * WGM, gsz = (nM - fm) < WGM ? (nM - fm) : WGM;
        u.pm = fm + ((wgid % nig) % gsz); u.pn = (wgid % nig) / gsz; return true;
    }
};
__device__ __forceinline__ unsigned cvt_pk_bf16(float lo, float hi) { unsigned r; asm volatile("s_nop 1\n\tv_cvt_pk_bf16_f32 %0, %1, %2" : "=v"(r) : "v"(lo), "v"(hi)); return r; }
__device__ __forceinline__ u32x4 pack8(const f32x4 a, const f32x4 b) { u32x4 w; w.x = cvt_pk_bf16(a[0], a[1]); w.y = cvt_pk_bf16(a[2], a[3]); w.z = cvt_pk_bf16(b[0], b[1]); w.w = cvt_pk_bf16(b[2], b[3]); return w; }
__device__ __forceinline__ void unpack8(const u32x4 w, f32x4& a, f32x4& b) { a = (f32x4){bf_lo(w.x), bf_hi(w.x), bf_lo(w.y), bf_hi(w.y)}; b = (f32x4){bf_lo(w.z), bf_hi(w.z), bf_lo(w.w), bf_hi(w.w)}; }

#define EPI_LOOP_BEGIN \
    _Pragma("unroll") for (int ai = 0; ai < 2; ++ai) _Pragma("unroll") for (int m = 0; m < 4; ++m) { const int row = u.pm * BM + ai * HALF + wr * 64 + m * 16 + fr; \
    _Pragma("unroll") for (int bj = 0; bj < 2; ++bj) { const int ct = bj * HALF + wc * 32 + 8 * fq; f32x4 v0 = acc[ai][bj][m][0], v1 = acc[ai][bj][m][1];
#define EPI_LOOP_END } }

struct Epi1 {
    static constexpr bool PERM = true, AFTER_DRAIN = false;
    bf16_t* XA; bf16_t* GA; bf16_t* XS;
    __device__ __forceinline__ void operator()(const f32x4 (&acc)[2][2][4][2], const Unit& u, int wr, int wc, int fr, int fq) const {
        const int pn = u.pn;
        if (pn < 4) {
            EPI_LOOP_BEGIN *(u32x4*)(XA + (size_t)row * 1024 + pn * 256 + ct) = pack8(v0, v1); EPI_LOOP_END
        } else if (pn < 8) {
            EPI_LOOP_BEGIN
#pragma unroll
                for (int j = 0; j < 4; ++j) { v0[j] = gelu_tanh(v0[j]); v1[j] = gelu_tanh(v1[j]); }
                *(u32x4*)(GA + (size_t)row * 1024 + (pn - 4) * 256 + ct) = pack8(v0, v1); EPI_LOOP_END
        } else {
            EPI_LOOP_BEGIN *(u32x4*)(XS + (size_t)row * 512 + (pn - 8) * 256 + ct) = pack8(v0, v1); EPI_LOOP_END
        }
    }
};
struct EpiGate {
    static constexpr bool PERM = true, AFTER_DRAIN = false;
    bf16_t* GATE; const float* bgate;
    __device__ __forceinline__ void operator()(const f32x4 (&acc)[2][2][4][2], const Unit& u, int wr, int wc, int fr, int fq) const {
        const int cb = u.pn * 256;
#pragma unroll
        for (int bj = 0; bj < 2; ++bj) { const int ct = bj * HALF + wc * 32 + 8 * fq;
            const f32x4 b0 = *(const f32x4*)(bgate + cb + ct), b1 = *(const f32x4*)(bgate + cb + ct + 4);
#pragma unroll
            for (int ai = 0; ai < 2; ++ai)
#pragma unroll
                for (int m = 0; m < 4; ++m) { const int row = u.pm * BM + ai * HALF + wr * 64 + m * 16 + fr; f32x4 v0 = acc[ai][bj][m][0], v1 = acc[ai][bj][m][1];
#pragma unroll
                    for (int j = 0; j < 4; ++j) { v0[j] = 1.0f - sigmoidf_(-(v0[j] + b0[j])); v1[j] = 1.0f - sigmoidf_(-(v1[j] + b1[j])); }
                    *(u32x4*)(GATE + (size_t)row * 2048 + cb + ct) = pack8(v0, v1); } }
    }
};
struct EpiGlu {
    static constexpr bool PERM = true, AFTER_DRAIN = false;
    const bf16_t* VS; bf16_t* YS; const float* bglu;
    __device__ __forceinline__ void operator()(const f32x4 (&acc)[2][2][4][2], const Unit& u, int wr, int wc, int fr, int fq) const {
        const int cb = u.pn * 256;
        f32x4 bb[2][2];
#pragma unroll
        for (int bj = 0; bj < 2; ++bj) { const int ct = bj * HALF + wc * 32 + 8 * fq; bb[bj][0] = *(const f32x4*)(bglu + cb + ct); bb[bj][1] = *(const f32x4*)(bglu + cb + ct + 4); }
#pragma unroll
        for (int ai = 0; ai < 2; ++ai) { u32x4 sv[4][2];
#pragma unroll
            for (int m = 0; m < 4; ++m)
#pragma unroll
                for (int bj = 0; bj < 2; ++bj) sv[m][bj] = *(const u32x4*)(VS + (size_t)(u.pm * BM + ai * HALF + wr * 64 + m * 16 + fr) * 512 + cb + bj * HALF + wc * 32 + 8 * fq);
            asm volatile("s_waitcnt vmcnt(0)" ::: "memory");
#pragma unroll
            for (int m = 0; m < 4; ++m)
#pragma unroll
                for (int bj = 0; bj < 2; ++bj) { const int row = u.pm * BM + ai * HALF + wr * 64 + m * 16 + fr, ct = bj * HALF + wc * 32 + 8 * fq; f32x4 v0 = acc[ai][bj][m][0], v1 = acc[ai][bj][m][1], s0, s1; unpack8(sv[m][bj], s0, s1);
#pragma unroll
                    for (int j = 0; j < 4; ++j) { v0[j] = s0[j] * sigmoidf_(v0[j] + bb[bj][0][j]); v1[j] = s1[j] * sigmoidf_(v1[j] + bb[bj][1][j]); }
                    *(u32x4*)(YS + (size_t)row * 512 + cb + ct) = pack8(v0, v1); } }
    }
};
template <int STEP> struct EpiMerge {
    static constexpr bool PERM = true, AFTER_DRAIN = false;
    const bf16_t* GATE; bf16_t* TMP; bf16_t* MPRE;
    __device__ __forceinline__ void operator()(const f32x4 (&acc)[2][2][4][2], const Unit& u, int wr, int wc, int fr, int fq) const {
        const int cb = u.pn * 256;
#pragma unroll
        for (int ai = 0; ai < 2; ++ai) { u32x4 gv[4][2], tv[4][2];
#pragma unroll
            for (int m = 0; m < 4; ++m)
#pragma unroll
                for (int bj = 0; bj < 2; ++bj) { const size_t row = (size_t)(u.pm * BM + ai * HALF + wr * 64 + m * 16 + fr); const int ct = bj * HALF + wc * 32 + 8 * fq;
                    gv[m][bj] = __builtin_nontemporal_load((const u32x4*)(GATE + row * 2048 + STEP * 1024 + cb + ct)); if (STEP == 1) tv[m][bj] = __builtin_nontemporal_load((const u32x4*)(TMP + row * 1024 + cb + ct)); }
            asm volatile("s_waitcnt vmcnt(0)" ::: "memory");
#pragma unroll
            for (int m = 0; m < 4; ++m)
#pragma unroll
                for (int bj = 0; bj < 2; ++bj) { const size_t row = (size_t)(u.pm * BM + ai * HALF + wr * 64 + m * 16 + fr); const int ct = bj * HALF + wc * 32 + 8 * fq;
                    const f32x4 v0 = acc[ai][bj][m][0], v1 = acc[ai][bj][m][1]; f32x4 g0, g1; unpack8(gv[m][bj], g0, g1);
                    if (STEP == 0) { *(u32x4*)(TMP + row * 1024 + cb + ct) = pack8(g0 * v0, g1 * v1); }
                    else { f32x4 t0, t1; unpack8(tv[m][bj], t0, t1); *(u32x4*)(MPRE + row * 1024 + cb + ct) = pack8(t0 + g0 * v0, t1 + g1 * v1); } } }
    }
};
struct EpiOutSS {
    static constexpr bool PERM = true, AFTER_DRAIN = false;
    bf16_t* O; float* rowss;
    __device__ __forceinline__ void operator()(const f32x4 (&acc)[2][2][4][2], const Unit& u, int wr, int wc, int fr, int fq) const {
        const int cb = u.pn * 256;
#pragma unroll
        for (int ai = 0; ai < 2; ++ai)
#pragma unroll
            for (int m = 0; m < 4; ++m) { const int row = u.pm * BM + ai * HALF + wr * 64 + m * 16 + fr; float ss = 0.f;
#pragma unroll
                for (int bj = 0; bj < 2; ++bj) { const int ct = bj * HALF + wc * 32 + 8 * fq; const f32x4 v0 = acc[ai][bj][m][0], v1 = acc[ai][bj][m][1];
                    ss += (v0[0] * v0[0] + v0[1] * v0[1]) + (v0[2] * v0[2] + v0[3] * v0[3]) + (v1[0] * v1[0] + v1[1] * v1[1]) + (v1[2] * v1[2] + v1[3] * v1[3]);
                    *(u32x4*)(O + (size_t)row * 1024 + cb + ct) = pack8(v0, v1); }
                ss += __shfl_xor(ss, 16); ss += __shfl_xor(ss, 32);
                if (fq == 0) rowss[((size_t)u.pn * MT + row) * 4 + wc] = ss; }
    }
};
struct EpiPlain {
    static constexpr bool PERM = true, AFTER_DRAIN = false;
    bf16_t* O;
    __device__ __forceinline__ void operator()(const f32x4 (&acc)[2][2][4][2], const Unit& u, int wr, int wc, int fr, int fq) const {
        const int cb = u.pn * 256;
        EPI_LOOP_BEGIN *(u32x4*)(O + (size_t)row * 1024 + cb + ct) = pack8(v0, v1); EPI_LOOP_END
    }
};
struct OneUnit { int pm, pn;
    __device__ __forceinline__ bool next(int i, Unit& u) const { if (i) return false; u.pm = pm; u.pn = pn; return true; }
    __device__ __forceinline__ void a_ready(const Unit&) const {}
    __device__ __forceinline__ void done(const Unit&) const {} };
struct EpiFF {
    static constexpr bool PERM = true, AFTER_DRAIN = false;
    bf16_t* HID;
    __device__ __forceinline__ void operator()(const f32x4 (&acc)[2][2][4][2], const Unit& u, int wr, int wc, int fr, int fq) const {
#pragma unroll
        for (int ai = 0; ai < 2; ++ai)
#pragma unroll
            for (int m = 0; m < 4; ++m) { const int row = u.pm * BM + ai * HALF + wr * 64 + m * 16 + fr;
                f32x4 a0 = acc[ai][0][m][0], a1 = acc[ai][0][m][1]; const f32x4 g0 = acc[ai][1][m][0], g1 = acc[ai][1][m][1];
#pragma unroll
                for (int j = 0; j < 4; ++j) { a0[j] = siluf_(a0[j]) * g0[j]; a1[j] = siluf_(a1[j]) * g1[j]; }
                *(u32x4*)(HID + (size_t)row * DFF + u.pn * 128 + wc * 32 + 8 * fq) = pack8(a0, a1); }
    }
};
template <class Epi, class Sched>
__device__ __forceinline__ void gemm_phase(PG8_LAS unsigned char* lds, const Gemm g, const Sched& S, const Epi& E) {
    int tid_ = threadIdx.x; asm volatile("" : "+v"(tid_));
    const int tid = tid_, wid = __builtin_amdgcn_readfirstlane(tid >> 6), lane = tid & 63, wr = wid >> 2, wc = wid & 3, fr = lane & 15, fq = lane >> 4;
    const int K = g.K, nt = K / BK, LD = g.ld ? g.ld : g.K;
    unsigned voffA[2], voffB[2];
#pragma unroll
    for (int i = 0; i < 2; ++i) { int R, C; stage_rc(tid * 16 + i * 8192, R, C); const int Rb = Epi::PERM ? ((R & ~31) + perm32(R & 31)) : R;
        voffA[i] = (unsigned)(R * LD + C) * 2u; voffB[i] = (unsigned)(Rb * LD + C) * 2u; }
    const size_t kstep = (size_t)(BK * 2);
    const size_t hstep = (size_t)HALF * LD * 2;
    const size_t tstep = 2 * hstep;
    const unsigned ldsw = (unsigned)wid * 1024u;
    const int aoff = lds_byte(wr * 64 + fr, fq * 8), boff = lds_byte(wc * 32 + fr, fq * 8);
#define PG8_SA(b, h) (((b) * 2 + (h)) * HTB)
#define PG8_SB(b, h) ((4 + (b) * 2 + (h)) * HTB)
#define PG8_STAGE(bufoff, gbase, voff) do { _Pragma("unroll") for (int _i = 0; _i < 2; ++_i) \
        __builtin_amdgcn_global_load_lds((const unsigned*)((const char*)(gbase) + (voff)[_i]), (PG8_LAS unsigned*)(lds + (bufoff) + ldsw + _i * 8192), 16, 0, 0); } while (0)
#define PG8_LDA(dst, b, h) do { _Pragma("unroll") for (int m = 0; m < 4; ++m) _Pragma("unroll") for (int k = 0; k < 2; ++k) dst[m][k] = *(const PG8_LAS bf16x8*)(lds + PG8_SA(b, h) + aoff + m * 2048 + k * 1024); } while (0)
#define PG8_LDB(dst, b, h) do { _Pragma("unroll") for (int n = 0; n < 2; ++n) _Pragma("unroll") for (int k = 0; k < 2; ++k) dst[n][k] = *(const PG8_LAS bf16x8*)(lds + PG8_SB(b, h) + boff + n * 2048 + k * 1024); } while (0)
#define PG8_MMA(ai, bj, At, Bt) do { __builtin_amdgcn_s_setprio(1); _Pragma("unroll") for (int m = 0; m < 4; ++m) _Pragma("unroll") for (int n = 0; n < 2; ++n) _Pragma("unroll") for (int k = 0; k < 2; ++k) \
        acc[ai][bj][m][n] = __builtin_amdgcn_mfma_f32_16x16x32_bf16(Bt[n][k], At[m][k], acc[ai][bj][m][n], 0, 0, 0); __builtin_amdgcn_s_setprio(0); } while (0)
#define PG8_WAIT_V(n) asm volatile("s_waitcnt vmcnt(" #n ")" ::: "memory")
#define PG8_WAIT_L(n) asm volatile("s_waitcnt lgkmcnt(" #n ")" ::: "memory")
#define PG8_BAR __builtin_amdgcn_s_barrier()
#define PG8_SCHED __builtin_amdgcn_sched_barrier(0)
    Unit cur, nxt; int ui = 0;
    if (!S.next(0, cur)) return;
    f32x4 acc[2][2][4][2];
#pragma unroll
    for (int a = 0; a < 2; ++a)
#pragma unroll
        for (int b = 0; b < 2; ++b)
#pragma unroll
            for (int m = 0; m < 4; ++m)
#pragma unroll
                for (int n = 0; n < 2; ++n) acc[a][b][m][n] = (f32x4){0.f, 0.f, 0.f, 0.f};
    bf16x8 At[4][2], B0[2][2], B1[2][2];
    const char* cA = (const char*)g.A + (size_t)cur.pm * tstep; const char* cB = (const char*)g.Bt + (size_t)cur.pn * tstep;
    S.a_ready(cur);
    PG8_STAGE(PG8_SB(0, 0), cB, voffB); PG8_STAGE(PG8_SA(0, 0), cA, voffA); PG8_STAGE(PG8_SB(0, 1), cB + hstep, voffB); PG8_STAGE(PG8_SA(0, 1), cA + hstep, voffA);
    if (wr == 1) PG8_BAR;
    PG8_WAIT_V(4); PG8_BAR;
    PG8_STAGE(PG8_SB(1, 0), cB + kstep, voffB); PG8_STAGE(PG8_SA(1, 0), cA + kstep, voffA); PG8_STAGE(PG8_SB(1, 1), cB + hstep + kstep, voffB);
    PG8_WAIT_V(6); PG8_BAR;
    for (;;) {
        const bool has_next = S.next(ui + 1, nxt);
        const char* nA = has_next ? (const char*)g.A + (size_t)nxt.pm * tstep : cA; const char* nB = has_next ? (const char*)g.Bt + (size_t)nxt.pn * tstep : cB;
        for (int t = 0; t < nt; t += 2) {
            const bool last = (t == nt - 2);
            const char* a1 = cA + (size_t)(t + 1) * kstep;
            const char* a2 = last ? nA : cA + (size_t)(t + 2) * kstep; const char* b2 = last ? nB : cB + (size_t)(t + 2) * kstep;
            const char* a3 = a2 + kstep; const char* b3 = b2 + kstep;
            if (last && has_next) S.a_ready(nxt);
            PG8_LDB(B0, 0, 0); PG8_SCHED; PG8_LDA(At, 0, 0); PG8_STAGE(PG8_SA(1, 1), a1 + hstep, voffA);
            PG8_WAIT_L(8); PG8_BAR; PG8_WAIT_L(0); PG8_MMA(0, 0, At, B0); PG8_BAR; PG8_SCHED;
            PG8_LDB(B1, 0, 1); PG8_STAGE(PG8_SB(0, 0), b2, voffB);
            PG8_BAR; PG8_WAIT_L(0); PG8_MMA(0, 1, At, B1); PG8_BAR;
            PG8_LDA(At, 0, 1); PG8_STAGE(PG8_SA(0, 0), a2, voffA);
            PG8_BAR; PG8_WAIT_L(0); PG8_MMA(1, 0, At, B0); PG8_BAR; PG8_SCHED;
            PG8_STAGE(PG8_SB(0, 1), b2 + hstep, voffB);
            PG8_WAIT_V(6); PG8_BAR; PG8_MMA(1, 1, At, B1); PG8_BAR;
            PG8_LDB(B0, 1, 0); PG8_SCHED; PG8_LDA(At, 1, 0); PG8_STAGE(PG8_SA(0, 1), a2 + hstep, voffA);
            PG8_WAIT_L(8); PG8_BAR; PG8_WAIT_L(0); PG8_MMA(0, 0, At, B0); PG8_BAR; PG8_SCHED;
            PG8_LDB(B1, 1, 1); PG8_STAGE(PG8_SB(1, 0), b3, voffB);
            PG8_BAR; PG8_WAIT_L(0); PG8_MMA(0, 1, At, B1); PG8_BAR;
            PG8_LDA(At, 1, 1); PG8_STAGE(PG8_SA(1, 0), a3, voffA);
            PG8_BAR; PG8_WAIT_L(0); PG8_MMA(1, 0, At, B0); PG8_BAR; PG8_SCHED;
            PG8_STAGE(PG8_SB(1, 1), b3 + hstep, voffB);
            PG8_WAIT_V(6); PG8_BAR; PG8_MMA(1, 1, At, B1); PG8_BAR;
        }
        if constexpr (!Epi::AFTER_DRAIN) { E(acc, cur, wr, wc, fr, fq); S.done(cur); }
        if (!has_next) break;
#pragma unroll
        for (int a = 0; a < 2; ++a)
#pragma unroll
            for (int b = 0; b < 2; ++b)
#pragma unroll
                for (int m = 0; m < 4; ++m)
#pragma unroll
                    for (int n = 0; n < 2; ++n) acc[a][b][m][n] = (f32x4){0.f, 0.f, 0.f, 0.f};
        cur = nxt; cA = nA; cB = nB; ++ui;
    }
    PG8_WAIT_V(0);
    if (wr == 0) PG8_BAR;
    PG8_BAR;
    if constexpr (Epi::AFTER_DRAIN) { E.fused(acc, cur, wr, wc, fr, fq, lds, wid, lane); S.done(cur); }
#undef PG8_SA
#undef PG8_SB
#undef PG8_STAGE
#undef PG8_LDA
#undef PG8_LDB
#undef PG8_MMA
#undef PG8_WAIT_V
#undef PG8_WAIT_L
#undef PG8_BAR
#undef PG8_SCHED
}
}

__device__ __forceinline__ int ffin_row(int n) { const int half = n >= DFF, j = half ? n - DFF : n; return (j >> 7) * 256 + half * 128 + (j & 127); }
__device__ __forceinline__ void copy_tiles(const Ctx p, LAS unsigned char* lds, int tbeg, int tend, int first, int stride) {
    int tid_ = threadIdx.x; asm volatile("" : "+v"(tid_)); const int tid = tid_;
    unsigned char* ws = p.ws;
    LAS float* tile = (LAS float*)lds;
    const float* src; bf16_t* dst; int K, N, k0, n0; bool perm;
#define TILE_INFO(T) do { int t_ = (T), tk_; \
        if (t_ < 640) { src = PIN(13); K = 1024; N = 2560; dst = (bf16_t*)(ws + WS_W1T); perm = false; } \
        else if (t_ < 1152) { t_ -= 640; src = PIN(33); K = 1024; N = 2048; dst = (bf16_t*)(ws + WS_W1T) + (size_t)2560 * 1024; perm = false; } \
        else if (t_ < 1408) { t_ -= 1152; src = PIN(31); K = 1024; N = 1024; dst = (bf16_t*)(ws + WS_WPL); perm = false; } \
        else if (t_ < 1536) { t_ -= 1408; src = PIN(32); K = 512; N = 1024; dst = (bf16_t*)(ws + WS_WPS); perm = false; } \
        else if (t_ < 1792) { t_ -= 1536; src = PIN(35); K = 1024; N = 1024; dst = (bf16_t*)(ws + WS_WOUT); perm = false; } \
        else if (t_ < 3200) { t_ -= 1792; src = PIN(36); K = 1024; N = 2 * DFF; dst = (bf16_t*)(ws + WS_WFI); perm = true; } \
        else if (t_ < 3904) { t_ -= 3200; src = PIN(37); K = DFF; N = 1024; dst = (bf16_t*)(ws + WS_WFO); perm = false; } \
        else { t_ -= 3904; src = PIN(29); K = 512; N = 512; dst = (bf16_t*)(ws + WS_WGLU); perm = false; } \
        tk_ = K / 64; k0 = (t_ % tk_) * 64; n0 = (t_ / tk_) * 64; } while (0)
    {   const int r = tid >> 4, c4 = tid & 15, n = tid >> 3, kc = tid & 7;
        f32x4 v0, v1; int T = tbeg + first;
        if (T < tend) { TILE_INFO(T); v0 = *(const f32x4*)(src + (size_t)(k0 + r) * N + n0 + 4 * c4); v1 = *(const f32x4*)(src + (size_t)(k0 + r + 32) * N + n0 + 4 * c4); }
        for (; T < tend; T += stride) {
            TILE_INFO(T);
            bf16_t* const cdst = dst; const int cK = K, ck0 = k0, cdrow = perm ? ffin_row(n0 + n) : n0 + n;
            {   LAS float* t = tile + r * 65 + 4 * c4; t[0] = v0[0]; t[1] = v0[1]; t[2] = v0[2]; t[3] = v0[3]; t += 32 * 65; t[0] = v1[0]; t[1] = v1[1]; t[2] = v1[2]; t[3] = v1[3]; }
            __syncthreads();
            if (T + stride < tend) { TILE_INFO(T + stride); v0 = *(const f32x4*)(src + (size_t)(k0 + r) * N + n0 + 4 * c4); v1 = *(const f32x4*)(src + (size_t)(k0 + r + 32) * N + n0 + 4 * c4); }
            {   const LAS float* t = tile + (8 * kc) * 65 + n; u32x4 w;
                w.x = pk2(t[0], t[65]); w.y = pk2(t[130], t[195]); w.z = pk2(t[260], t[325]); w.w = pk2(t[390], t[455]);
                *(u32x4*)(cdst + (size_t)cdrow * cK + ck0 + 8 * kc) = w; }
            __syncthreads();
        }
    }
#undef TILE_INFO
}
__device__ __forceinline__ void p0_prologue(const Ctx p, LAS unsigned char* lds) {
    const int tid = threadIdx.x, G = gridDim.x, bx = blockIdx.x;
    unsigned char* ws = p.ws;
    if (bx >= G - 96) {
        const int item = bx - (G - 96), n0 = item * 64, w = tid >> 6, lane = tid & 63;
        LAS float* sc = (LAS float*)lds;
        LAS float* red = (LAS float*)(lds + 9 * 1024 * 4);
        for (int i = tid; i < 9 * 1024; i += 512) { const int j = i >> 10, k = i & 1023; const float v = j == 0 ? PIN(6)[k] : PIN(2)[(j - 1) * 1024 + k]; sc[i] = siluf_(v); }
        __syncthreads();
        float a[9];
#pragma unroll
        for (int j = 0; j < 9; ++j) a[j] = 0.f;
        const float* wm = PIN(7) + n0 + lane;
#pragma unroll 8
        for (int k = 128 * w; k < 128 * w + 128; ++k) { const float wv = wm[(size_t)k * 6144];
#pragma unroll
            for (int j = 0; j < 9; ++j) a[j] += sc[j * 1024 + k] * wv; }
#pragma unroll
        for (int j = 0; j < 9; ++j) red[(w * 9 + j) * 64 + lane] = a[j];
        __syncthreads();
        for (int i = tid; i < 9 * 64; i += 512) { const int j = i >> 6, l = i & 63; float s = PIN(8)[n0 + l];
#pragma unroll
            for (int ww = 0; ww < 8; ++ww) s += red[(ww * 9 + j) * 64 + l];
            ((float*)(ws + WS_MOD))[j * 6144 + n0 + l] = s; }
        __syncthreads();
    }
    if (bx < G - 96) { copy_tiles(p, lds, 0, 1792, bx, G - 96); copy_tiles(p, lds, 3904, 3968, bx, G - 96); }
}

#define ROW_SS(v) ((v[0][0] * v[0][0] + v[0][1] * v[0][1]) + (v[0][2] * v[0][2] + v[0][3] * v[0][3]) + (v[1][0] * v[1][0] + v[1][1] * v[1][1]) + (v[1][2] * v[1][2] + v[1][3] * v[1][3]) + \
                   (v[2][0] * v[2][0] + v[2][1] * v[2][1]) + (v[2][2] * v[2][2] + v[2][3] * v[2][3]) + (v[3][0] * v[3][0] + v[3][1] * v[3][1]) + (v[3][2] * v[3][2] + v[3][3] * v[3][3]))
__device__ __forceinline__ float wave_sum(float x) {
#pragma unroll
    for (int o = 1; o < 64; o <<= 1) x += __shfl_xor(x, o);
    return x; }
__device__ __forceinline__ f32x4 bf4(const u32x2 w) { return (f32x4){bf_lo(w.x), bf_hi(w.x), bf_lo(w.y), bf_hi(w.y)}; }
__device__ __forceinline__ bf16_t* x1_row(const Ctx p, int r) { return r < 10240 ? (bf16_t*)(p.ws + WS_X1A) + (size_t)r * 1024 : (bf16_t*)(p.ws + WS_X1B) + (size_t)(r - 10240) * 1024; }
__device__ __forceinline__ void p1_hn(const Ctx p) {
    int tid_ = threadIdx.x; asm volatile("" : "+v"(tid_)); const int tid = tid_, w = tid >> 6, lane = tid & 63, r0 = blockIdx.x * 160 + w * 20;
    bf16_t* HN = (bf16_t*)(p.ws + WS_HN);
    f32x4 gs[4], sh[4]; int cur = -1;
    for (int it = 0; it < 10; ++it) { const int r = r0 + 2 * it, mi = mod_index(r);
        if (mi != cur) { cur = mi; const float* mod = (const float*)(p.ws + WS_MOD) + mi * 6144;
#pragma unroll
            for (int j = 0; j < 4; ++j) { const int c = 4 * lane + 256 * j; gs[j] = *(const f32x4*)(PIN(9) + c) * (*(const f32x4*)(mod + 1024 + c) + 1.0f); sh[j] = *(const f32x4*)(mod + c); } }
        const float* xa = xrow(p, r); const float* xb = xrow(p, r + 1); f32x4 va[4], vb[4];
#pragma unroll
        for (int j = 0; j < 4; ++j) { va[j] = __builtin_nontemporal_load((const f32x4*)(xa + 4 * lane + 256 * j)); vb[j] = __builtin_nontemporal_load((const f32x4*)(xb + 4 * lane + 256 * j)); }
        const float ra = __builtin_amdgcn_rsqf(wave_sum(ROW_SS(va)) * (1.0f / 1024.0f) + EPS), rb = __builtin_amdgcn_rsqf(wave_sum(ROW_SS(vb)) * (1.0f / 1024.0f) + EPS);
#pragma unroll
        for (int j = 0; j < 4; ++j) { const f32x4 ya = va[j] * ra * gs[j] + sh[j], yb = vb[j] * rb * gs[j] + sh[j]; u32x2 oa, ob; oa.x = pk2(ya[0], ya[1]); oa.y = pk2(ya[2], ya[3]); ob.x = pk2(yb[0], yb[1]); ob.y = pk2(yb[2], yb[3]);
            *(u32x2*)(HN + (size_t)r * 1024 + 4 * lane + 256 * j) = oa; *(u32x2*)(HN + (size_t)(r + 1) * 1024 + 4 * lane + 256 * j) = ob; }
    }
}
__device__ __forceinline__ float row_rs(const float* ssp, int r, int lane) { float q = ssp[((size_t)((lane >> 2) & 3) * MT + r) * 4 + (lane & 3)]; q += __shfl_xor(q, 1); q += __shfl_xor(q, 2); q += __shfl_xor(q, 4); q += __shfl_xor(q, 8);
    return __builtin_amdgcn_rsqf(q * (1.0f / 1024.0f) + EPS); }
__device__ __forceinline__ void p7_x1(const Ctx p) {
    int tid_ = threadIdx.x; asm volatile("" : "+v"(tid_)); const int tid = tid_, w = tid >> 6, lane = tid & 63, r0 = blockIdx.x * 160 + w * 20;
    const bf16_t* MO = (const bf16_t*)(p.ws + WS_MO); bf16_t* HN2 = (bf16_t*)(p.ws + WS_HN2); const float* ss1 = (const float*)(p.ws + WS_SSP1);
    f32x4 gg[4], gs[4], sh[4]; int cur = -1;
    for (int it = 0; it < 10; ++it) { const int r = r0 + 2 * it, mi = mod_index(r);
        if (mi != cur) { cur = mi; const float* mod = (const float*)(p.ws + WS_MOD) + mi * 6144;
#pragma unroll
            for (int j = 0; j < 4; ++j) { const int c = 4 * lane + 256 * j; gg[j] = *(const f32x4*)(mod + 2048 + c) * *(const f32x4*)(PIN(10) + c);
                gs[j] = *(const f32x4*)(PIN(11) + c) * (*(const f32x4*)(mod + 4096 + c) + 1.0f); sh[j] = *(const f32x4*)(mod + 3072 + c); } }
        const float* xa = xrow(p, r); const float* xb = xrow(p, r + 1); f32x4 va[4], vb[4]; u32x2 ma[4], mb[4];
#pragma unroll
        for (int j = 0; j < 4; ++j) { const int c = 4 * lane + 256 * j; va[j] = __builtin_nontemporal_load((const f32x4*)(xa + c)); vb[j] = __builtin_nontemporal_load((const f32x4*)(xb + c)); ma[j] = *(const u32x2*)(MO + (size_t)r * 1024 + c); mb[j] = *(const u32x2*)(MO + (size_t)(r + 1) * 1024 + c); }
        const float sa = row_rs(ss1, r, lane), sb = row_rs(ss1, r + 1, lane);
#pragma unroll
        for (int j = 0; j < 4; ++j) { const int c = 4 * lane + 256 * j; va[j] = va[j] + gg[j] * bf4(ma[j]) * sa; vb[j] = vb[j] + gg[j] * bf4(mb[j]) * sb;
            { u32x2 oa, ob; oa.x = pk2(va[j][0], va[j][1]); oa.y = pk2(va[j][2], va[j][3]); ob.x = pk2(vb[j][0], vb[j][1]); ob.y = pk2(vb[j][2], vb[j][3]); __builtin_nontemporal_store(oa, (u32x2*)(x1_row(p, r) + c)); __builtin_nontemporal_store(ob, (u32x2*)(x1_row(p, r + 1) + c)); } }
        const float ra = __builtin_amdgcn_rsqf(wave_sum(ROW_SS(va)) * (1.0f / 1024.0f) + EPS), rb = __builtin_amdgcn_rsqf(wave_sum(ROW_SS(vb)) * (1.0f / 1024.0f) + EPS);
#pragma unroll
        for (int j = 0; j < 4; ++j) { const f32x4 ya = va[j] * ra * gs[j] + sh[j], yb = vb[j] * rb * gs[j] + sh[j]; u32x2 oa, ob; oa.x = pk2(ya[0], ya[1]); oa.y = pk2(ya[2], ya[3]); ob.x = pk2(yb[0], yb[1]); ob.y = pk2(yb[2], yb[3]);
            *(u32x2*)(HN2 + (size_t)r * 1024 + 4 * lane + 256 * j) = oa; *(u32x2*)(HN2 + (size_t)(r + 1) * 1024 + 4 * lane + 256 * j) = ob; }
    }
}
__device__ __forceinline__ void p10_out(const Ctx p) {
    int tid_ = threadIdx.x; asm volatile("" : "+v"(tid_)); const int tid = tid_, w = tid >> 6, lane = tid & 63, r0 = blockIdx.x * 160 + w * 20;
    const bf16_t* FO = (const bf16_t*)(p.ws + WS_FO); const bf16_t* FOB = (const bf16_t*)(p.ws + WS_FOB);
    f32x4 gg[4]; int cur = -1;
    for (int it = 0; it < 10; ++it) { const int r = r0 + 2 * it, mi = mod_index(r); const bool split = r >= 128 * 256;
        if (mi != cur) { cur = mi; const float* mod = (const float*)(p.ws + WS_MOD) + mi * 6144;
#pragma unroll
            for (int j = 0; j < 4; ++j) { const int c = 4 * lane + 256 * j; gg[j] = *(const f32x4*)(mod + 5120 + c) * *(const f32x4*)(PIN(12) + c); } }
        f32x4 va[4], vb[4], fa[4], fb[4];
#pragma unroll
        for (int j = 0; j < 4; ++j) { const int c = 4 * lane + 256 * j; va[j] = bf4(__builtin_nontemporal_load((const u32x2*)(x1_row(p, r) + c))); vb[j] = bf4(__builtin_nontemporal_load((const u32x2*)(x1_row(p, r + 1) + c)));
            fa[j] = bf4(*(const u32x2*)(FO + (size_t)r * 1024 + c)); fb[j] = bf4(*(const u32x2*)(FO + (size_t)(r + 1) * 1024 + c));
            if (split) { fa[j] = fa[j] + bf4(*(const u32x2*)(FOB + (size_t)r * 1024 + c)); fb[j] = fb[j] + bf4(*(const u32x2*)(FOB + (size_t)(r + 1) * 1024 + c)); } }
        const float sa = __builtin_amdgcn_rsqf(wave_sum(ROW_SS(fa)) * (1.0f / 1024.0f) + EPS), sb = __builtin_amdgcn_rsqf(wave_sum(ROW_SS(fb)) * (1.0f / 1024.0f) + EPS);
#pragma unroll
        for (int j = 0; j < 4; ++j) { const int c = 4 * lane + 256 * j; __builtin_nontemporal_store(va[j] + gg[j] * fa[j] * sa, (f32x4*)(p.out + (size_t)r * 1024 + c)); __builtin_nontemporal_store(vb[j] + gg[j] * fb[j] * sb, (f32x4*)(p.out + (size_t)(r + 1) * 1024 + c)); }
    }
}

constexpr int LRU_U16 = 0, LRU_UB = 9216, LRU_AA = LRU_UB + 17408, LRU_AGG = LRU_AA + 17408, LRU_CAR = LRU_AGG + 2048, LRU_HALF = 46592;
__device__ __forceinline__ void lru_unit(const Ctx p, LAS unsigned char* lds, int sample, int b, int hd) {
    int tid_ = threadIdx.x; asm volatile("" : "+v"(tid_)); const int tid = tid_, d = tid >> 8, ht = tid & 255, hw = ht >> 6, lane = tid & 63;
    const int T = sample ? T_S : T_CTX, row0 = sample ? MC + b * T_S : b * T_CTX, nch = T / 64;
    LAS unsigned char* L = lds + d * LRU_HALF;
    LAS bf16_t* U16 = (LAS bf16_t*)(L + LRU_U16); LAS float* UB = (LAS float*)(L + LRU_UB); LAS float* AA = (LAS float*)(L + LRU_AA);
    LAS f32x2* AGG = (LAS f32x2*)(L + LRU_AGG); LAS float* CAR = (LAS float*)(L + LRU_CAR);
    const bf16_t* XA = (const bf16_t*)(p.ws + WS_XA); const bf16_t* GA = (const bf16_t*)(p.ws + WS_GA); bf16_t* YA = (bf16_t*)(p.ws + WS_YA);
    const int fj = lane & 15, fq = lane >> 4, chg = hd * 64 + 16 * hw + fj;
    bf16x8 wrf[2], wif[2];
    {   const float* wr = PIN(16) + (size_t)(d * 16 + hd) * 4096 + 16 * hw + fj; const float* wi = PIN(18) + (size_t)(d * 16 + hd) * 4096 + 16 * hw + fj;
#pragma unroll
        for (int s = 0; s < 2; ++s)
#pragma unroll
            for (int e = 0; e < 8; ++e) { const int k = 32 * s + 8 * fq + e; wrf[s][e] = (short)f2bf(wr[k * 64]); wif[s][e] = (short)f2bf(wi[k * 64]); } }
    const float br = PIN(17)[d * 1024 + chg], bi = PIN(19)[d * 1024 + chg];
    const float sp8 = -8.0f * 1.44269504089f * log1pf(__expf(-PIN(20)[d * 1024 + chg]));
    const int cp = ht & 31, tg = ht >> 5, cc0 = hd * 64 + 2 * cp;
    float cw0[4], cw1[4];
#pragma unroll
    for (int j = 0; j < 4; ++j) { cw0[j] = PIN(14)[j * 1024 + cc0]; cw1[j] = PIN(14)[j * 1024 + cc0 + 1]; }
    const float cb0 = PIN(15)[cc0], cb1 = PIN(15)[cc0 + 1];
    const int chs = hd * 64 + lane;
    if (ht < 64) CAR[lane] = sample ? PIN(3)[(size_t)(b * 2 + d) * 1024 + chs] : 0.f;
    float hfin = 0.f;
    __syncthreads();
    unsigned xw[11];
#define LRU_LOADX(kk) do { const int c_ = d ? nch - 1 - (kk) : (kk); _Pragma("unroll") for (int i = 0; i < 11; ++i) { const int t = 64 * c_ + 8 * tg - 2 + i; unsigned w = 0u; if (t >= 0 && t < T) w = *(const unsigned*)(XA + (size_t)(row0 + t) * 1024 + cc0); xw[i] = w; } } while (0)
    LRU_LOADX(0);
    for (int k = 0; k < nch; ++k) {
        const int c = d ? nch - 1 - k : k, t0 = 64 * c; const bool second = (2 * k >= nch);
        {   float x0[11], x1[11];
#pragma unroll
            for (int i = 0; i < 11; ++i) { x0[i] = bf_lo(xw[i]); x1[i] = bf_hi(xw[i]); }
#pragma unroll
            for (int i = 0; i < 8; ++i) { const float u0 = cb0 + cw0[0] * x0[i] + cw0[1] * x0[i + 1] + cw0[2] * x0[i + 2] + cw0[3] * x0[i + 3];
                const float u1 = cb1 + cw1[0] * x1[i] + cw1[1] * x1[i + 1] + cw1[2] * x1[i + 2] + cw1[3] * x1[i + 3]; const int tl = 8 * tg + i;
                *(LAS unsigned*)(U16 + tl * 72 + 2 * cp) = pk2(u0, u1); *(LAS f32x2*)(UB + tl * 68 + 2 * cp) = (f32x2){u0, u1}; } }
        if (k + 1 < nch) LRU_LOADX(k + 1);
        unsigned short hf16[16], g16[16];
        if (second) {
#pragma unroll
            for (int i = 0; i < 16; ++i) { const int pi = 16 * hw + i, tl = d ? 63 - pi : pi; const size_t ix = (size_t)(row0 + t0 + tl) * 1024 + chs; hf16[i] = YA[ix]; g16[i] = GA[ix]; } }
        __syncthreads();
        {   f32x4 ar[4], ai[4];
#pragma unroll
            for (int m = 0; m < 4; ++m) { ar[m] = (f32x4){0.f, 0.f, 0.f, 0.f}; ai[m] = ar[m];
#pragma unroll
                for (int s = 0; s < 2; ++s) { const bf16x8 a = *(const LAS bf16x8*)(U16 + (16 * m + fj) * 72 + 32 * s + 8 * fq);
                    ar[m] = __builtin_amdgcn_mfma_f32_16x16x32_bf16(a, wrf[s], ar[m], 0, 0, 0); ai[m] = __builtin_amdgcn_mfma_f32_16x16x32_bf16(a, wif[s], ai[m], 0, 0, 0); } }
#pragma unroll
            for (int m = 0; m < 4; ++m)
#pragma unroll
                for (int r4 = 0; r4 < 4; ++r4) { const int tok = 16 * m + 4 * fq + r4, ix = tok * 68 + 16 * hw + fj;
                    const float rg = sigmoidf_(ar[m][r4] + br), a = __builtin_amdgcn_exp2f(sp8 * rg);
                    const float ei = 1.0f + __builtin_amdgcn_exp2f(-1.44269504089f * (ai[m][r4] + bi)), om = fmaxf(1.0f - a * a, 1e-30f);
                    const float bb = om * __builtin_amdgcn_rsqf(om * ei * ei) * UB[ix]; AA[ix] = a; UB[ix] = bb; } }
        __syncthreads();
        float av[16], bv[16]; float P = 1.f, h = 0.f;
#pragma unroll
        for (int i = 0; i < 16; ++i) { const int pi = 16 * hw + i, tl = d ? 63 - pi : pi; av[i] = AA[tl * 68 + lane]; bv[i] = UB[tl * 68 + lane]; h = av[i] * h + bv[i]; P *= av[i]; }
        AGG[hw * 64 + lane] = (f32x2){P, h};
        __syncthreads();
        h = CAR[(k & 1) * 64 + lane];
        for (int s2 = 0; s2 < hw; ++s2) { const f32x2 ag = AGG[s2 * 64 + lane]; h = ag.x * h + ag.y; }
#pragma unroll
        for (int i = 0; i < 16; ++i) { const int pi = 16 * hw + i, tl = d ? 63 - pi : pi; const size_t ix = (size_t)(row0 + t0 + tl) * 1024 + chs; h = av[i] * h + bv[i];
            YA[ix] = f2bf1(second ? bf2f(g16[i]) * (bf2f(hf16[i]) + h) : h); }
        if (hw == 3) { CAR[((k + 1) & 1) * 64 + lane] = h; hfin = h; }
        if (2 * k + 2 == nch) asm volatile("s_waitcnt vmcnt(0)" ::: "memory");
        __syncthreads();
    }
#undef LRU_LOADX
    if (!sample && hw == 3) p.out[OFF_LRU + (size_t)(b * 2 + d) * 1024 + chs] = hfin;
}

__device__ __forceinline__ void sincos_f(float x, float& s, float& c) {
    const float jf = rintf(x * 0.636619772f); const int j = (int)jf;
    float r = x - jf * 1.5703125f; r -= jf * 4.837512969970703125e-4f; r -= jf * 7.54978995489188216e-8f;
    const float z = r * r;
    const float sp = r + r * z * (-1.6666654611e-1f + z * (8.3321608736e-3f + z * (-1.9515295891e-4f)));
    const float cp = 1.0f - 0.5f * z + z * z * (4.166664568298827e-2f + z * (-1.388731625493765e-3f + z * 2.443315711809948e-5f));
    const int q = j & 3;
    s = (q == 0) ? sp : (q == 1) ? cp : (q == 2) ? -sp : -cp;
    c = (q == 0) ? cp : (q == 1) ? -sp : (q == 2) ? -cp : sp;
}
__device__ __forceinline__ void s5_disc(const Ctx p, int d, int g, int ps, float& abr, float& abi, float& fre, float& fim) {
    const float lr = PIN(21)[(d * 32 + g) * 64 + ps], li = PIN(22)[(d * 32 + g) * 64 + ps], dt = __expf(PIN(23)[d * 32 + g]);
    const float mag = __expf(lr * dt); float sn, cs; sincos_f(li * dt, sn, cs);
    abr = mag * cs; abi = mag * sn;
    const float den = lr * lr + li * li, nr = abr - 1.0f, ni = abi;
    fre = (nr * lr + ni * li) / den; fim = (ni * lr - nr * li) / den;
}
constexpr int S5_HS_STRIDE = 272, S5_HS_WAVE = 32 * S5_HS_STRIDE;
__device__ __forceinline__ void s5_item(const Ctx p, LAS unsigned char* lds, int sample, int b, int g0) {
    int tid_ = threadIdx.x; asm volatile("" : "+v"(tid_)); const int tid = tid_, w = tid >> 6, lane = tid & 63, d = w & 1, g = g0 + (w >> 1);
    const int T = sample ? T_S : T_CTX, row0 = sample ? MC + b * T_S : b * T_CTX, nch = T / 32;
    LAS unsigned char* Hs = lds + w * S5_HS_WAVE;
    const bf16_t* XS = (const bf16_t*)(p.ws + WS_XS); bf16_t* VS = (bf16_t*)(p.ws + WS_VS);
    const int j31 = lane & 31, hi = lane >> 5;
    float abr1, abi1, fr1, fi1, abr2, abi2, fr2, fi2;
    s5_disc(p, d, g, j31, abr1, abi1, fr1, fi1); s5_disc(p, d, g, 32 + j31, abr2, abi2, fr2, fi2);
    const float abr = hi ? abr2 : abr1, abi = hi ? abi2 : abi1;
    bf16x8 bfr[4];
#pragma unroll
    for (int st = 0; st < 2; ++st) { const int ps = 32 * st + j31; const float fr = st ? fr2 : fr1, fi = st ? fi2 : fi1;
        const float* bre = PIN(24) + ((size_t)(d * 32 + g) * 64 + ps) * 16 + 8 * hi; const float* bim = PIN(25) + ((size_t)(d * 32 + g) * 64 + ps) * 16 + 8 * hi;
#pragma unroll
        for (int e = 0; e < 8; ++e) { const float vr = bre[e], vi = bim[e]; bfr[2 * st][e] = (short)f2bf(fr * vr - fi * vi); bfr[2 * st + 1][e] = (short)f2bf(fr * vi + fi * vr); } }
    const int fh = lane & 15, kq = lane >> 4;
    bf16x8 cfr[4];
#pragma unroll
    for (int ks = 0; ks < 4; ++ks)
#pragma unroll
        for (int e = 0; e < 8; ++e) { const int pp = 16 * ks + 4 * kq + (e >> 1); const size_t ix = ((size_t)(d * 32 + g) * 16 + fh) * 64 + pp;
            cfr[ks][e] = (short)f2bf((e & 1) ? -PIN(27)[ix] : PIN(26)[ix]); }
    const float dsk = PIN(28)[g * 16 + fh];
    const float one = __builtin_fmaf(dsk, 0.f, 1.0f);
    float hr = 0.f, hi_ = 0.f;
    if (sample) { const size_t ix = ((size_t)(b * 2 + d) * 32 + g) * 64 + lane; hr = PIN(4)[ix]; hi_ = PIN(5)[ix]; }
    const int step = (d ? -1 : 1) * (sample ? 64 : 1);
    const int ua_off = step * 512 * j31 + g * 16 + 8 * hi;
    int eoff[8];
#pragma unroll
    for (int e = 0; e < 8; ++e) eoff[e] = step * 512 * (16 * (e >> 2) + 4 * kq + (e & 3)) + g * 16 + fh;
#define S5_CBASE(kk) ({ const int s0_ = d ? T - 1 - 32 * (kk) : 32 * (kk); const int t0_ = sample ? ((s0_ & 63) * 64 + (s0_ >> 6)) : s0_; (size_t)(row0 + t0_) * 512; })
    bf16x8 ua_next = *(const bf16x8*)(XS + S5_CBASE(0) + ua_off);
    for (int k = 0; k < nch; ++k) {
        const bool second = (2 * k >= nch);
        const size_t cbase = S5_CBASE(k);
        const bf16x8 ua = ua_next;
        if (k + 1 < nch) ua_next = *(const bf16x8*)(XS + S5_CBASE(k + 1) + ua_off);
        unsigned short vf16[8], xs16[8];
        if (second) {
#pragma unroll
            for (int mt = 0; mt < 2; ++mt)
#pragma unroll
                for (int r4 = 0; r4 < 4; ++r4) { const size_t ix = cbase + eoff[mt * 4 + r4]; vf16[mt * 4 + r4] = VS[ix]; xs16[mt * 4 + r4] = XS[ix]; } }
        f32x16 acc[4];
#pragma unroll
        for (int nt = 0; nt < 4; ++nt) { f32x16 z;
#pragma unroll
            for (int v = 0; v < 16; ++v) z[v] = 0.f;
            acc[nt] = __builtin_amdgcn_mfma_f32_32x32x16_bf16(ua, bfr[nt], z, 0, 0, 0); }
        float bur[32], bui[32];
#pragma unroll
        for (int v = 0; v < 16; ++v) {
            unsigned r0 = __builtin_bit_cast(unsigned, acc[0][v] * one), r1 = __builtin_bit_cast(unsigned, acc[2][v] * one);
            unsigned q0 = __builtin_bit_cast(unsigned, acc[1][v] * one), q1 = __builtin_bit_cast(unsigned, acc[3][v] * one);
            asm volatile("s_nop 1\n\tv_permlane32_swap_b32 %0, %1" : "+v"(r0), "+v"(r1));
            asm volatile("s_nop 1\n\tv_permlane32_swap_b32 %0, %1" : "+v"(q0), "+v"(q1));
            const int ta = 8 * (v >> 2) + (v & 3);
            bur[ta] = __builtin_bit_cast(float, r0); bur[ta + 4] = __builtin_bit_cast(float, r1);
            bui[ta] = __builtin_bit_cast(float, q0); bui[ta + 4] = __builtin_bit_cast(float, q1); }
#pragma unroll
        for (int tt = 0; tt < 32; ++tt) { const float nr = abr * hr - abi * hi_ + bur[tt], ni = abr * hi_ + abi * hr + bui[tt]; hr = nr; hi_ = ni;
            *(LAS unsigned*)(Hs + tt * S5_HS_STRIDE + 4 * lane) = pk2(hr, hi_); }
        f32x4 ya[2];
#pragma unroll
        for (int mt = 0; mt < 2; ++mt) { ya[mt] = (f32x4){0.f, 0.f, 0.f, 0.f};
#pragma unroll
            for (int ks = 0; ks < 4; ++ks) { const bf16x8 a = *(const LAS bf16x8*)(Hs + (16 * mt + fh) * S5_HS_STRIDE + (32 * ks + 8 * kq) * 2);
                ya[mt] = __builtin_amdgcn_mfma_f32_16x16x32_bf16(a, cfr[ks], ya[mt], 0, 0, 0); } }
#pragma unroll
        for (int mt = 0; mt < 2; ++mt)
#pragma unroll
            for (int r4 = 0; r4 < 4; ++r4) { const size_t ix = cbase + eoff[mt * 4 + r4]; float y = ya[mt][r4];
                if (second) { y = gelu_tanh(y + bf2f(vf16[mt * 4 + r4]) + dsk * bf2f(xs16[mt * 4 + r4])); }
                VS[ix] = f2bf1(y); }
        if (2 * k + 2 == nch) { asm volatile("s_waitcnt vmcnt(0)" ::: "memory"); __syncthreads(); }
    }
#undef S5_CBASE
    if (!sample) { const size_t ix = ((size_t)(b * 2 + d) * 32 + g) * 64 + lane; p.out[OFF_RE + ix] = hr; p.out[OFF_IM + ix] = hi_; }
}
__device__ __forceinline__ void p3_scans(const Ctx p, LAS unsigned char* lds) {
    const int bx = blockIdx.x;
    if (bx < 128) { lru_unit(p, lds, 1, bx >> 4, bx & 15); }
    else if (bx < 192) { const int i = bx - 128; s5_item(p, lds, 1, i >> 3, 4 * (i & 7)); }
    else { const int i = bx - 192;
        for (int e = 0; e < 8; ++e) { const int c = 8 * i + e; lru_unit(p, lds, 0, c >> 4, c & 15); __syncthreads(); }
        for (int e = 0; e < 4; ++e) { const int c = 4 * i + e; s5_item(p, lds, 0, c >> 3, 4 * (c & 7)); __syncthreads(); } }
}

#define XB_TMO      128
#define XB_XCNT(j)  (256  + 64 * (j))
#define XB_XSUB(j)  (1280 + 64 * (j))
#define XB_XGEN(j)  (2304 + 64 * (j))
#define XB_TOP      3328
#define XB_TOPGEN   3392
#define XCD_BAR_WORDS 3456
#define XB_SPIN_CAP (1u << 18)

__device__ __forceinline__ unsigned xb_ld(unsigned* p)              { return __hip_atomic_load(p, __ATOMIC_RELAXED, __HIP_MEMORY_SCOPE_AGENT); }
__device__ __forceinline__ unsigned xb_add(unsigned* p, unsigned v) { return __hip_atomic_fetch_add(p, v, __ATOMIC_RELAXED, __HIP_MEMORY_SCOPE_AGENT); }
__device__ __forceinline__ unsigned xb_xcc_id() { return (unsigned)__builtin_amdgcn_s_getreg((3 << 11) | 20) & 0xFu; }
#define XB_SPIN(cond, bar) do { unsigned _sp = 0; while (cond) { __builtin_amdgcn_s_sleep(1); \
    if ((++_sp & 255u) == 0u) { if (xb_ld(&(bar)[XB_TMO])) break; if (_sp > XB_SPIN_CAP) { atomicAdd(&(bar)[XB_TMO], 1u); break; } } } } while (0)

struct XcdBarrier {
    unsigned* bar; unsigned x;
    volatile LAS unsigned* st;
};

__device__ __forceinline__ XcdBarrier xcd_barrier_post(unsigned* bar, volatile LAS unsigned* st) {
    XcdBarrier b; b.bar = bar; b.x = xb_xcc_id(); b.st = st;
    if (threadIdx.x == 0) (void)xb_add(&bar[XB_XCNT(b.x)], 1u);
    return b;
}
__device__ __forceinline__ void xcd_barrier_complete(unsigned* bar, unsigned x, unsigned& nloc, unsigned& nx) {
    const unsigned G = gridDim.x * gridDim.y * gridDim.z;
    unsigned sum, cnt, mine, sp = 0u;
    for (;;) {
        sum = 0u; cnt = 0u; mine = 0u;
#pragma unroll
        for (unsigned j = 0; j < 16; ++j) { const unsigned c = xb_ld(&bar[XB_XCNT(j)]); sum += c; cnt += (c > 0u) ? 1u : 0u; mine = (j == x) ? c : mine; }
        if (sum == G) break;
        __builtin_amdgcn_s_sleep(1);
        if ((++sp & 255u) == 0u) { if (xb_ld(&bar[XB_TMO])) break; if (sp > XB_SPIN_CAP) { atomicAdd(&bar[XB_TMO], 1u); break; } }
    }
    nloc = mine > 0u ? mine : 1u; nx = cnt > 0u ? cnt : 1u;
}

__device__ __forceinline__ void xcd_barrier(const XcdBarrier& b) {
    asm volatile("s_waitcnt vmcnt(0)" ::: "memory");
    __syncthreads();
    if (threadIdx.x == 0) {
        unsigned* bar = b.bar;
        __builtin_amdgcn_s_waitcnt(0);
        unsigned nloc = b.st[0], nx = b.st[1];
        if (nloc == 0u) { xcd_barrier_complete(bar, b.x, nloc, nx); b.st[0] = nloc; b.st[1] = nx; }
        const unsigned old = xb_add(&bar[XB_XSUB(b.x)], 1u);
        const unsigned gen = old / nloc;
        if (old + 1u == (gen + 1u) * nloc) {
            __builtin_amdgcn_fence(__ATOMIC_RELEASE, "agent");
            asm volatile("s_waitcnt vmcnt(0)" ::: "memory");
            const unsigned og = xb_add(&bar[XB_TOP], 1u);
            const unsigned tg = og / nx;
            if (og + 1u == (tg + 1u) * nx) xb_add(&bar[XB_TOPGEN], 1u);
            else XB_SPIN(xb_ld(&bar[XB_TOPGEN]) == tg, bar);
            __builtin_amdgcn_fence(__ATOMIC_ACQUIRE, "agent");
            xb_add(&bar[XB_XGEN(b.x)], 1u);
            asm volatile("s_waitcnt vmcnt(0)" ::: "memory");
        } else {
            XB_SPIN(xb_ld(&bar[XB_XGEN(b.x)]) == gen, bar);
            __builtin_amdgcn_fence(__ATOMIC_ACQUIRE, "agent");
            asm volatile("s_waitcnt vmcnt(0)" ::: "memory");
        }
    }
    __syncthreads();
}

#define GRID_SYNC() do { asm volatile("s_waitcnt vmcnt(0)" ::: "memory"); grid.sync(); if (threadIdx.x < 64) { __builtin_amdgcn_fence(__ATOMIC_ACQUIRE, "agent"); asm volatile("s_waitcnt vmcnt(0)" ::: "memory"); } __syncthreads(); } while (0)
__global__ void __launch_bounds__(512, 2) fwd_mega(Params kp) {
    extern __shared__ __attribute__((aligned(16))) unsigned char lds_raw[];
    LAS unsigned char* lds = (LAS unsigned char*)lds_raw;
    {   LAS unsigned long long* t_ = (LAS unsigned long long*)(lds + LDS_BYTES - 512);
        if (threadIdx.x == 0) { t_[0] = (unsigned long long)kp.in[0]; t_[1] = (unsigned long long)kp.in[1]; t_[2] = (unsigned long long)kp.in[2]; t_[3] = (unsigned long long)kp.in[3]; t_[4] = (unsigned long long)kp.in[4]; t_[5] = (unsigned long long)kp.in[5]; t_[6] = (unsigned long long)kp.in[6]; t_[7] = (unsigned long long)kp.in[7]; t_[8] = (unsigned long long)kp.in[8]; t_[9] = (unsigned long long)kp.in[9]; t_[10] = (unsigned long long)kp.in[10]; t_[11] = (unsigned long long)kp.in[11]; t_[12] = (unsigned long long)kp.in[12]; t_[13] = (unsigned long long)kp.in[13]; t_[14] = (unsigned long long)kp.in[14]; t_[15] = (unsigned long long)kp.in[15]; t_[16] = (unsigned long long)kp.in[16]; t_[17] = (unsigned long long)kp.in[17]; t_[18] = (unsigned long long)kp.in[18]; t_[19] = (unsigned long long)kp.in[19]; t_[20] = (unsigned long long)kp.in[20]; t_[21] = (unsigned long long)kp.in[21]; t_[22] = (unsigned long long)kp.in[22]; t_[23] = (unsigned long long)kp.in[23]; t_[24] = (unsigned long long)kp.in[24]; t_[25] = (unsigned long long)kp.in[25]; t_[26] = (unsigned long long)kp.in[26]; t_[27] = (unsigned long long)kp.in[27]; t_[28] = (unsigned long long)kp.in[28]; t_[29] = (unsigned long long)kp.in[29]; t_[30] = (unsigned long long)kp.in[30]; t_[31] = (unsigned long long)kp.in[31]; t_[32] = (unsigned long long)kp.in[32]; t_[33] = (unsigned long long)kp.in[33]; t_[34] = (unsigned long long)kp.in[34]; t_[35] = (unsigned long long)kp.in[35]; t_[36] = (unsigned long long)kp.in[36]; t_[37] = (unsigned long long)kp.in[37]; }
        __syncthreads(); }
    Ctx p; p.tbl = (const LAS unsigned long long*)(lds + LDS_BYTES - 512); p.out = kp.out; p.ws = kp.ws;
    cg::grid_group grid = cg::this_grid();
    unsigned char* ws = p.ws; const int G = gridDim.x, bx = blockIdx.x;
    bf16_t* GATE = (bf16_t*)p.out;
    volatile LAS unsigned* xst = (volatile LAS unsigned*)(lds + LDS_BYTES - 512 - 16);
    if (threadIdx.x < 4) xst[threadIdx.x] = 0u;
    __syncthreads();
    const XcdBarrier xb = xcd_barrier_post((unsigned*)(ws + 768 * 1024), xst);
#define GRID_BAR() xcd_barrier(xb)
    p0_prologue(p, lds);
    if (G == 0x7fffffff) GRID_SYNC();
    GRID_BAR();
    p1_hn(p);
    GRID_BAR();
    {   pg8::Gemm g{(const bf16_t*)(ws + WS_HN), (const bf16_t*)(ws + WS_W1T), MT, 2560, 1024}; pg8::StaticOrder S; S.init(MT, 2560, G, bx);
        pg8::Epi1 E{(bf16_t*)(ws + WS_XA), (bf16_t*)(ws + WS_GA), (bf16_t*)(ws + WS_XS)};
        pg8::gemm_phase<pg8::Epi1, pg8::StaticOrder>(lds, g, S, E);
        pg8::Gemm g2{(const bf16_t*)(ws + WS_HN), (const bf16_t*)(ws + WS_W1T) + (size_t)2560 * 1024, MT, 2048, 1024}; pg8::ListOrder S2; S2.init(MT, 2048, G, bx); S2.base = bx; S2.stride = 256; S2.count = 3; S2.extra = bx >= 64 ? 768 + (bx - 64) : -1;
        pg8::EpiGate E2{GATE, PIN(34)};
        pg8::gemm_phase<pg8::EpiGate, pg8::ListOrder>(lds, g2, S2, E2); }
    GRID_BAR();
    p3_scans(p, lds);
    if (bx < 128 || bx >= 192) {
        __syncthreads();
        pg8::Gemm g2{(const bf16_t*)(ws + WS_HN), (const bf16_t*)(ws + WS_W1T) + (size_t)2560 * 1024, MT, 2048, 1024}; pg8::ListOrder S2; S2.init(MT, 2048, G, bx);
        S2.extra = -1; if (bx >= 192) { S2.base = 1088 + (bx - 192); S2.stride = 64; S2.count = 3; } else { S2.base = 960 + bx; S2.stride = 1; S2.count = 1; }
        pg8::EpiGate E2{GATE, PIN(34)};
        pg8::gemm_phase<pg8::EpiGate, pg8::ListOrder>(lds, g2, S2, E2);
    }
    GRID_BAR();
    {
        pg8::StaticOrder S; S.init(MT, 1024, G, bx);
        pg8::Gemm ga{(const bf16_t*)(ws + WS_YA), (const bf16_t*)(ws + WS_WPL), MT, 1024, 1024};
        pg8::EpiMerge<0> Ea{GATE, (bf16_t*)(ws + WS_TMP), (bf16_t*)(ws + WS_MPRE)};
        pg8::gemm_phase<pg8::EpiMerge<0>, pg8::StaticOrder>(lds, ga, S, Ea);
        pg8::Gemm g{(const bf16_t*)(ws + WS_VS), (const bf16_t*)(ws + WS_WGLU), MT, 512, 512}; pg8::StaticOrder S4; S4.init(MT, 512, G, (bx + 128) & 255);
        pg8::EpiGlu E{(const bf16_t*)(ws + WS_VS), (bf16_t*)(ws + WS_YS), PIN(30)};
        pg8::gemm_phase<pg8::EpiGlu, pg8::StaticOrder>(lds, g, S4, E); }
    GRID_BAR();
    {   pg8::StaticOrder S; S.init(MT, 1024, G, bx);
        pg8::Gemm gb{(const bf16_t*)(ws + WS_YS), (const bf16_t*)(ws + WS_WPS), MT, 1024, 512};
        pg8::EpiMerge<1> Eb{GATE, (bf16_t*)(ws + WS_TMP), (bf16_t*)(ws + WS_MPRE)};
        pg8::gemm_phase<pg8::EpiMerge<1>, pg8::StaticOrder>(lds, gb, S, Eb);
        if (bx >= 128) copy_tiles(p, lds, 3200, 3904, bx - 128, 128); }
    GRID_BAR();
    {   pg8::Gemm g{(const bf16_t*)(ws + WS_MPRE), (const bf16_t*)(ws + WS_WOUT), MT, 1024, 1024}; pg8::StaticOrder S; S.init(MT, 1024, G, bx);
        pg8::EpiOutSS E{(bf16_t*)(ws + WS_MO), (float*)(ws + WS_SSP1)};
        pg8::gemm_phase<pg8::EpiOutSS, pg8::StaticOrder>(lds, g, S, E);
        if (bx >= 128) copy_tiles(p, lds, 1792, 3200, bx - 128, 128); }
    GRID_BAR();
    p7_x1(p);
    GRID_BAR();
    {   pg8::Gemm g{(const bf16_t*)(ws + WS_HN2), (const bf16_t*)(ws + WS_WFI), MT, 2 * DFF, 1024}; pg8::StaticOrder S; S.init(MT, 2 * DFF, G, bx);
        pg8::EpiFF E{(bf16_t*)(ws + WS_HID)};
        pg8::gemm_phase<pg8::EpiFF, pg8::StaticOrder>(lds, g, S, E); }
    GRID_BAR();
    {
        pg8::Gemm g{(const bf16_t*)(ws + WS_HID), (const bf16_t*)(ws + WS_WFO), MT, 1024, DFF}; pg8::StaticOrder S; S.init(128 * 256, 1024, G, bx);
        pg8::EpiPlain E{(bf16_t*)(ws + WS_FO)};
        pg8::gemm_phase<pg8::EpiPlain, pg8::StaticOrder>(lds, g, S, E);
        const int tile = bx >> 1, kh = bx & 1;
        pg8::Gemm gh{(const bf16_t*)(ws + WS_HID) + kh * (DFF / 2), (const bf16_t*)(ws + WS_WFO) + kh * (DFF / 2), MT, 1024, DFF / 2, DFF};
        pg8::OneUnit S1{128 + (tile >> 2), tile & 3};
        pg8::EpiPlain Eh{(bf16_t*)(ws + (kh ? WS_FOB : WS_FO))};
        pg8::gemm_phase<pg8::EpiPlain, pg8::OneUnit>(lds, gh, S1, Eh); }
    GRID_BAR();
    p10_out(p);
}

extern "C" void kernel_launch(void* const* d_in, const int* in_sizes, int n_in, void* d_out, int out_size, void* d_ws, size_t ws_size, hipStream_t stream) {
    static int grid = 0;
    if (grid == 0) {
        if (n_in != 38 || (size_t)out_size != OFF_IM + 32 * 2 * 32 * 64 || ws_size < WS_END) { fprintf(stderr, "kernel_launch: unexpected shapes (n_in %d out %d ws %zu)\n", n_in, out_size, ws_size); grid = -1; return; }
        int dev = 0, cus = 0, per_cu = 0;
        hipGetDevice(&dev); hipDeviceGetAttribute(&cus, hipDeviceAttributeMultiprocessorCount, dev);
        if (hipFuncSetAttribute((const void*)fwd_mega, hipFuncAttributeMaxDynamicSharedMemorySize, LDS_BYTES) != hipSuccess) { fprintf(stderr, "kernel_launch: hipFuncSetAttribute failed\n"); grid = -1; return; }
        if (hipOccupancyMaxActiveBlocksPerMultiprocessor(&per_cu, (const void*)fwd_mega, 512, LDS_BYTES) != hipSuccess || per_cu < 1) { fprintf(stderr, "kernel_launch: occupancy query says %d blocks/CU\n", per_cu); grid = -1; return; }
        if (cus < 256) { fprintf(stderr, "kernel_launch: needs 256 CUs, device has %d\n", cus); grid = -1; return; }
        grid = 256;
    }
    if (grid < 0) return;
    Params p{};
    for (int i = 0; i < 38; ++i) p.in[i] = (const float*)d_in[i];
    p.out = (float*)d_out; p.ws = (unsigned char*)d_ws;
    if (hipMemsetAsync((char*)d_ws + 768 * 1024, 0, XCD_BAR_WORDS * 4, stream) != hipSuccess) { fprintf(stderr, "kernel_launch: hipMemsetAsync of the barrier word failed\n"); return; }
    void* args[] = {&p};
    hipError_t e = hipLaunchCooperativeKernel((const void*)fwd_mega, dim3(grid), dim3(512), args, LDS_BYTES, stream);
    if (e != hipSuccess) fprintf(stderr, "cooperative launch failed: %s\n", hipGetErrorString(e));
}
```

```cpp
#include <hip/hip_runtime.h>
#include <hip/hip_cooperative_groups.h>
#include <cstdio>
#include <cstdint>
namespace cg = cooperative_groups;

#define LAS __attribute__((address_space(3)))
typedef unsigned short bf16_t;
typedef short bf16x8 __attribute__((ext_vector_type(8)));
typedef float f32x4 __attribute__((ext_vector_type(4)));
typedef float f32x16 __attribute__((ext_vector_type(16)));
typedef float f32x2 __attribute__((ext_vector_type(2)));
typedef unsigned u32x4 __attribute__((ext_vector_type(4)));
typedef unsigned u32x2 __attribute__((ext_vector_type(2)));

constexpr int DM = 1024, MC = 8192, MS = 32768, MT = MC + MS;
constexpr int NB_CTX = 32, T_CTX = 256, NB_S = 8, T_S = 4096;
constexpr int DFF = 2816, DS5 = 512;
constexpr float EPS = 1e-6f;
constexpr size_t OFF_LRU = (size_t)MT * DM, OFF_RE = OFF_LRU + 32 * 2 * 1024, OFF_IM = OFF_RE + 32 * 2 * 32 * 64;
constexpr size_t MiB = 1u << 20;
constexpr size_t WS_MOD = 512 * 1024;
constexpr size_t WS_W1T = 1 * MiB, WS_WPL = 10 * MiB, WS_WPS = 12 * MiB, WS_WOUT = 13 * MiB, WS_WFI = 15 * MiB, WS_WFO = 26 * MiB, WS_WGLU = 31 * MiB + 512 * 1024;
constexpr size_t WS_HN = 32 * MiB, WS_XA = 112 * MiB, WS_XS = 192 * MiB, WS_VS = 232 * MiB, WS_YA = 272 * MiB, WS_GA = 352 * MiB, WS_SSP1 = 432 * MiB, WS_SSP2 = 435 * MiB, WS_X1A = 252 * MiB  , WS_X1B = 438 * MiB  , WS_END = 498 * MiB;
constexpr size_t WS_TMP = WS_HN, WS_MPRE = WS_GA, WS_MO = WS_HN, WS_HN2 = WS_GA, WS_HID = WS_HN, WS_FO = WS_YA, WS_FOB = WS_GA, WS_YS = WS_XS;
constexpr int LDS_BYTES = 147456;

struct Params { const float* in[38]; float* out; unsigned char* ws; };
struct Ctx { const LAS unsigned long long* tbl; float* out; unsigned char* ws; };
__device__ __forceinline__ const float* inp_(const LAS unsigned long long* tbl, int i) { const unsigned long long v = tbl[i];
    const unsigned lo = __builtin_amdgcn_readfirstlane((unsigned)v), hi = __builtin_amdgcn_readfirstlane((unsigned)(v >> 32)); return (const float*)(const __attribute__((address_space(1))) float*)(((unsigned long long)hi << 32) | lo); }
#define PIN(i) inp_(p.tbl, (i))

__device__ __forceinline__ unsigned f2bf(float f) { unsigned u = __builtin_bit_cast(unsigned, f); return (u + 0x7fffu + ((u >> 16) & 1u)) >> 16; }
__device__ __forceinline__ unsigned pk2(float lo, float hi) { unsigned r; asm volatile("s_nop 1\n\tv_cvt_pk_bf16_f32 %0, %1, %2" : "=v"(r) : "v"(lo), "v"(hi)); return r; }
__device__ __forceinline__ bf16_t f2bf1(float x) { return (bf16_t)(pk2(x, 0.f) & 0xffffu); }
__device__ __forceinline__ float bf_lo(unsigned w) { return __builtin_bit_cast(float, w << 16); }
__device__ __forceinline__ float bf_hi(unsigned w) { return __builtin_bit_cast(float, w & 0xffff0000u); }
__device__ __forceinline__ float bf2f(bf16_t h) { return __builtin_bit_cast(float, ((unsigned)h) << 16); }
__device__ __forceinline__ float sigmoidf_(float x) { return __builtin_amdgcn_rcpf(1.0f + __builtin_amdgcn_exp2f(-1.44269504089f * x)); }
__device__ __forceinline__ float siluf_(float x) { return x * sigmoidf_(x); }
__device__ __forceinline__ float gelu_tanh(float x) { const float u = x + 0.044715f * x * x * x; return x * __builtin_amdgcn_rcpf(1.0f + __builtin_amdgcn_exp2f(-2.30220819f * u)); }
__device__ __forceinline__ const float* xrow(const Ctx p, int r) { return r < MC ? PIN(0) + (size_t)r * DM : PIN(1) + (size_t)(r - MC) * DM; }
__device__ __forceinline__ int mod_index(int r) { return r < MC ? 0 : 1 + ((r - MC) >> 12); }
namespace pg8 {
#define PG8_LAS __attribute__((address_space(3)))
constexpr int BM = 256, BK = 64, HALF = 128, HTB = HALF * BK * 2  , STAGE_BYTES = 8 * HTB, NXCD = 8, WGM = 8;
__host__ __device__ __forceinline__ int lds_byte(int r, int c) { const int st = (r >> 4) * 2 + (c >> 5), rr = r & 15, cc = c & 31, ob = rr * 64 + cc * 2; return st * 1024 + (ob ^ (((ob >> 9) & 1) << 5)); }
__host__ __device__ __forceinline__ void stage_rc(int b, int& R, int& C) { const int st = b / 1024, sb = b % 1024, swz = sb ^ (((sb >> 9) & 1) << 5); R = (st >> 1) * 16 + swz / 64; C = (st & 1) * 32 + (swz % 64) / 2; }
__host__ __device__ __forceinline__ int perm32(int rho) { const int n = rho >> 4, i = rho & 15; return 8 * (i >> 2) + 4 * n + (i & 3); }
struct Unit { int pm, pn; };
struct Gemm { const bf16_t* A; const bf16_t* Bt; int M, N, K; int ld = 0; };
struct StaticOrder {
    int nM, nN, nwg, G, c;
    __host__ __device__ void init(int M, int N, int G_, int c_) { nM = M / BM; nN = N / BM; nwg = nM * nN; G = G_; c = c_; }
    __host__ __device__ bool next(int i, Unit& u) const {
        const long L = (long)i * G + c; if (L >= nwg) return false;
        int wgid = (int)L; { const int q = nwg / NXCD, r = nwg % NXCD, xcd = wgid % NXCD, off = wgid / NXCD; wgid = (xcd < r ? xcd * (q + 1) : r * (q + 1) + (xcd - r) * q) + off; }
        const int nig = WGM * nN, gid = wgid / nig, fm = gid * WGM, gsz = (nM - fm) < WGM ? (nM - fm) : WGM;
        u.pm = fm + ((wgid % nig) % gsz); u.pn = (wgid % nig) / gsz; return true;
    }
    __device__ __forceinline__ void a_ready(const Unit&) const {}
    __device__ __forceinline__ void done(const Unit&) const {}
};
struct ListOrder : StaticOrder {
    int base, stride, count, extra;
    __host__ __device__ bool next(int i, Unit& u) const {
        if (i > count || (i == count && extra < 0)) return false;
        const long L = (i < count) ? (long)base + (long)i * stride : (long)extra; if (L >= nwg) return false;
        int wgid = (int)L; { const int q = nwg / NXCD, r = nwg % NXCD, xcd = wgid % NXCD, off = wgid / NXCD; wgid = (xcd < r ? xcd * (q + 1) : r * (q + 1) + (xcd - r) * q) + off; }
        const int nig = WGM * nN, gid = wgid / nig, fm = gid * WGM, gsz = (nM - fm) < WGM ? (nM - fm) : WGM;
        u.pm = fm + ((wgid % nig) % gsz); u.pn = (wgid % nig) / gsz; return true;
    }
};
__device__ __forceinline__ unsigned cvt_pk_bf16(float lo, float hi) { unsigned r; asm volatile("s_nop 1\n\tv_cvt_pk_bf16_f32 %0, %1, %2" : "=v"(r) : "v"(lo), "v"(hi)); return r; }
__device__ __forceinline__ u32x4 pack8(const f32x4 a, const f32x4 b) { u32x4 w; w.x = cvt_pk_bf16(a[0], a[1]); w.y = cvt_pk_bf16(a[2], a[3]); w.z = cvt_pk_bf16(b[0], b[1]); w.w = cvt_pk_bf16(b[2], b[3]); return w; }
__device__ __forceinline__ void unpack8(const u32x4 w, f32x4& a, f32x4& b) { a = (f32x4){bf_lo(w.x), bf_hi(w.x), bf_lo(w.y), bf_hi(w.y)}; b = (f32x4){bf_lo(w.z), bf_hi(w.z), bf_lo(w.w), bf_hi(w.w)}; }

#define EPI_LOOP_BEGIN \
    _Pragma("unroll") for (int ai = 0; ai < 2; ++ai) _Pragma("unroll") for (int m = 0; m < 4; ++m) { const int row = u.pm * BM + ai * HALF + wr * 64 + m * 16 + fr; \
    _Pragma("unroll") for (int bj = 0; bj < 2; ++bj) { const int ct = bj * HALF + wc * 32 + 8 * fq; f32x4 v0 = acc[ai][bj][m][0], v1 = acc[ai][bj][m][1];
#define EPI_LOOP_END } }

struct Epi1 {
    static constexpr bool PERM = true, AFTER_DRAIN = false;
    bf16_t* XA; bf16_t* GA; bf16_t* XS;
    __device__ __forceinline__ void operator()(const f32x4 (&acc)[2][2][4][2], const Unit& u, int wr, int wc, int fr, int fq) const {
        const int pn = u.pn;
        if (pn < 4) {
            EPI_LOOP_BEGIN *(u32x4*)(XA + (size_t)row * 1024 + pn * 256 + ct) = pack8(v0, v1); EPI_LOOP_END
        } else if (pn < 8) {
            EPI_LOOP_BEGIN
#pragma unroll
                for (int j = 0; j < 4; ++j) { v0[j] = gelu_tanh(v0[j]); v1[j] = gelu_tanh(v1[j]); }
                *(u32x4*)(GA + (size_t)row * 1024 + (pn - 4) * 256 + ct) = pack8(v0, v1); EPI_LOOP_END
        } else {
            EPI_LOOP_BEGIN *(u32x4*)(XS + (size_t)row * 512 + (pn - 8) * 256 + ct) = pack8(v0, v1); EPI_LOOP_END
        }
    }
};
struct EpiGate {
    static constexpr bool PERM = true, AFTER_DRAIN = false;
    bf16_t* GATE; const float* bgate;
    __device__ __forceinline__ void operator()(const f32x4 (&acc)[2][2][4][2], const Unit& u, int wr, int wc, int fr, int fq) const {
        const int cb = u.pn * 256;
#pragma unroll
        for (int bj = 0; bj < 2; ++bj) { const int ct = bj * HALF + wc * 32 + 8 * fq;
            const f32x4 b0 = *(const f32x4*)(bgate + cb + ct), b1 = *(const f32x4*)(bgate + cb + ct + 4);
#pragma unroll
            for (int ai = 0; ai < 2; ++ai)
#pragma unroll
                for (int m = 0; m < 4; ++m) { const int row = u.pm * BM + ai * HALF + wr * 64 + m * 16 + fr; f32x4 v0 = acc[ai][bj][m][0], v1 = acc[ai][bj][m][1];
#pragma unroll
                    for (int j = 0; j < 4; ++j) { v0[j] = 1.0f - sigmoidf_(-(v0[j] + b0[j])); v1[j] = 1.0f - sigmoidf_(-(v1[j] + b1[j])); }
                    *(u32x4*)(GATE + (size_t)row * 2048 + cb + ct) = pack8(v0, v1); } }
    }
};
struct EpiGlu {
    static constexpr bool PERM = true, AFTER_DRAIN = false;
    const bf16_t* VS; bf16_t* YS; const float* bglu;
    __device__ __forceinline__ void operator()(const f32x4 (&acc)[2][2][4][2], const Unit& u, int wr, int wc, int fr, int fq) const {
        const int cb = u.pn * 256;
        f32x4 bb[2][2];
#pragma unroll
        for (int bj = 0; bj < 2; ++bj) { const int ct = bj * HALF + wc * 32 + 8 * fq; bb[bj][0] = *(const f32x4*)(bglu + cb + ct); bb[bj][1] = *(const f32x4*)(bglu + cb + ct + 4); }
#pragma unroll
        for (int ai = 0; ai < 2; ++ai) { u32x4 sv[4][2];
#pragma unroll
            for (int m = 0; m < 4; ++m)
#pragma unroll
                for (int bj = 0; bj < 2; ++bj) sv[m][bj] = *(const u32x4*)(VS + (size_t)(u.pm * BM + ai * HALF + wr * 64 + m * 16 + fr) * 512 + cb + bj * HALF + wc * 32 + 8 * fq);
            asm volatile("s_waitcnt vmcnt(0)" ::: "memory");
#pragma unroll
            for (int m = 0; m < 4; ++m)
#pragma unroll
                for (int bj = 0; bj < 2; ++bj) { const int row = u.pm * BM + ai * HALF + wr * 64 + m * 16 + fr, ct = bj * HALF + wc * 32 + 8 * fq; f32x4 v0 = acc[ai][bj][m][0], v1 = acc[ai][bj][m][1], s0, s1; unpack8(sv[m][bj], s0, s1);
#pragma unroll
                    for (int j = 0; j < 4; ++j) { v0[j] = s0[j] * sigmoidf_(v0[j] + bb[bj][0][j]); v1[j] = s1[j] * sigmoidf_(v1[j] + bb[bj][1][j]); }
                    *(u32x4*)(YS + (size_t)row * 512 + cb + ct) = pack8(v0, v1); } }
    }
};
template <int STEP> struct EpiMerge {
    static constexpr bool PERM = true, AFTER_DRAIN = false;
    const bf16_t* GATE; bf16_t* TMP; bf16_t* MPRE;
    __device__ __forceinline__ void operator()(const f32x4 (&acc)[2][2][4][2], const Unit& u, int wr, int wc, int fr, int fq) const {
        const int cb = u.pn * 256;
#pragma unroll
        for (int ai = 0; ai < 2; ++ai) { u32x4 gv[4][2], tv[4][2];
#pragma unroll
            for (int m = 0; m < 4; ++m)
#pragma unroll
                for (int bj = 0; bj < 2; ++bj) { const size_t row = (size_t)(u.pm * BM + ai * HALF + wr * 64 + m * 16 + fr); const int ct = bj * HALF + wc * 32 + 8 * fq;
                    gv[m][bj] = *(const u32x4*)(GATE + row * 2048 + STEP * 1024 + cb + ct); if (STEP == 1) tv[m][bj] = *(const u32x4*)(TMP + row * 1024 + cb + ct); }
            asm volatile("s_waitcnt vmcnt(0)" ::: "memory");
#pragma unroll
            for (int m = 0; m < 4; ++m)
#pragma unroll
                for (int bj = 0; bj < 2; ++bj) { const size_t row = (size_t)(u.pm * BM + ai * HALF + wr * 64 + m * 16 + fr); const int ct = bj * HALF + wc * 32 + 8 * fq;
                    const f32x4 v0 = acc[ai][bj][m][0], v1 = acc[ai][bj][m][1]; f32x4 g0, g1; unpack8(gv[m][bj], g0, g1);
                    if (STEP == 0) { *(u32x4*)(TMP + row * 1024 + cb + ct) = pack8(g0 * v0, g1 * v1); }
                    else { f32x4 t0, t1; unpack8(tv[m][bj], t0, t1); *(u32x4*)(MPRE + row * 1024 + cb + ct) = pack8(t0 + g0 * v0, t1 + g1 * v1); } } }
    }
};
struct EpiOutSS {
    static constexpr bool PERM = true, AFTER_DRAIN = false;
    bf16_t* O; float* rowss;
    __device__ __forceinline__ void operator()(const f32x4 (&acc)[2][2][4][2], const Unit& u, int wr, int wc, int fr, int fq) const {
        const int cb = u.pn * 256;
#pragma unroll
        for (int ai = 0; ai < 2; ++ai)
#pragma unroll
            for (int m = 0; m < 4; ++m) { const int row = u.pm * BM + ai * HALF + wr * 64 + m * 16 + fr; float ss = 0.f;
#pragma unroll
                for (int bj = 0; bj < 2; ++bj) { const int ct = bj * HALF + wc * 32 + 8 * fq; const f32x4 v0 = acc[ai][bj][m][0], v1 = acc[ai][bj][m][1];
                    ss += (v0[0] * v0[0] + v0[1] * v0[1]) + (v0[2] * v0[2] + v0[3] * v0[3]) + (v1[0] * v1[0] + v1[1] * v1[1]) + (v1[2] * v1[2] + v1[3] * v1[3]);
                    *(u32x4*)(O + (size_t)row * 1024 + cb + ct) = pack8(v0, v1); }
                ss += __shfl_xor(ss, 16); ss += __shfl_xor(ss, 32);
                if (fq == 0) rowss[((size_t)u.pn * MT + row) * 4 + wc] = ss; }
    }
};
struct EpiPlain {
    static constexpr bool PERM = true, AFTER_DRAIN = false;
    bf16_t* O;
    __device__ __forceinline__ void operator()(const f32x4 (&acc)[2][2][4][2], const Unit& u, int wr, int wc, int fr, int fq) const {
        const int cb = u.pn * 256;
        EPI_LOOP_BEGIN *(u32x4*)(O + (size_t)row * 1024 + cb + ct) = pack8(v0, v1); EPI_LOOP_END
    }
};
struct OneUnit { int pm, pn;
    __device__ __forceinline__ bool next(int i, Unit& u) const { if (i) return false; u.pm = pm; u.pn = pn; return true; }
    __device__ __forceinline__ void a_ready(const Unit&) const {}
    __device__ __forceinline__ void done(const Unit&) const {} };
struct EpiFF {
    static constexpr bool PERM = true, AFTER_DRAIN = false;
    bf16_t* HID;
    __device__ __forceinline__ void operator()(const f32x4 (&acc)[2][2][4][2], const Unit& u, int wr, int wc, int fr, int fq) const {
#pragma unroll
        for (int ai = 0; ai < 2; ++ai)
#pragma unroll
            for (int m = 0; m < 4; ++m) { const int row = u.pm * BM + ai * HALF + wr * 64 + m * 16 + fr;
                f32x4 a0 = acc[ai][0][m][0], a1 = acc[ai][0][m][1]; const f32x4 g0 = acc[ai][1][m][0], g1 = acc[ai][1][m][1];
#pragma unroll
                for (int j = 0; j < 4; ++j) { a0[j] = siluf_(a0[j]) * g0[j]; a1[j] = siluf_(a1[j]) * g1[j]; }
                *(u32x4*)(HID + (size_t)row * DFF + u.pn * 128 + wc * 32 + 8 * fq) = pack8(a0, a1); }
    }
};
template <class Epi, class Sched>
__device__ __forceinline__ void gemm_phase(PG8_LAS unsigned char* lds, const Gemm g, const Sched& S, const Epi& E) {
    int tid_ = threadIdx.x; asm volatile("" : "+v"(tid_));
    const int tid = tid_, wid = __builtin_amdgcn_readfirstlane(tid >> 6), lane = tid & 63, wr = wid >> 2, wc = wid & 3, fr = lane & 15, fq = lane >> 4;
    const int K = g.K, nt = K / BK, LD = g.ld ? g.ld : g.K;
    unsigned voffA[2], voffB[2];
#pragma unroll
    for (int i = 0; i < 2; ++i) { int R, C; stage_rc(tid * 16 + i * 8192, R, C); const int Rb = Epi::PERM ? ((R & ~31) + perm32(R & 31)) : R;
        voffA[i] = (unsigned)(R * LD + C) * 2u; voffB[i] = (unsigned)(Rb * LD + C) * 2u; }
    const size_t kstep = (size_t)(BK * 2);
    const size_t hstep = (size_t)HALF * LD * 2;
    const size_t tstep = 2 * hstep;
    const unsigned ldsw = (unsigned)wid * 1024u;
    const int aoff = lds_byte(wr * 64 + fr, fq * 8), boff = lds_byte(wc * 32 + fr, fq * 8);
#define PG8_SA(b, h) (((b) * 2 + (h)) * HTB)
#define PG8_SB(b, h) ((4 + (b) * 2 + (h)) * HTB)
#define PG8_STAGE(bufoff, gbase, voff) do { _Pragma("unroll") for (int _i = 0; _i < 2; ++_i) \
        __builtin_amdgcn_global_load_lds((const unsigned*)((const char*)(gbase) + (voff)[_i]), (PG8_LAS unsigned*)(lds + (bufoff) + ldsw + _i * 8192), 16, 0, 0); } while (0)
#define PG8_LDA(dst, b, h) do { _Pragma("unroll") for (int m = 0; m < 4; ++m) _Pragma("unroll") for (int k = 0; k < 2; ++k) dst[m][k] = *(const PG8_LAS bf16x8*)(lds + PG8_SA(b, h) + aoff + m * 2048 + k * 1024); } while (0)
#define PG8_LDB(dst, b, h) do { _Pragma("unroll") for (int n = 0; n < 2; ++n) _Pragma("unroll") for (int k = 0; k < 2; ++k) dst[n][k] = *(const PG8_LAS bf16x8*)(lds + PG8_SB(b, h) + boff + n * 2048 + k * 1024); } while (0)
#define PG8_MMA(ai, bj, At, Bt) do { __builtin_amdgcn_s_setprio(1); _Pragma("unroll") for (int m = 0; m < 4; ++m) _Pragma("unroll") for (int n = 0; n < 2; ++n) _Pragma("unroll") for (int k = 0; k < 2; ++k) \
        acc[ai][bj][m][n] = __builtin_amdgcn_mfma_f32_16x16x32_bf16(Bt[n][k], At[m][k], acc[ai][bj][m][n], 0, 0, 0); __builtin_amdgcn_s_setprio(0); } while (0)
#define PG8_WAIT_V(n) asm volatile("s_waitcnt vmcnt(" #n ")" ::: "memory")
#define PG8_WAIT_L(n) asm volatile("s_waitcnt lgkmcnt(" #n ")" ::: "memory")
#define PG8_BAR __builtin_amdgcn_s_barrier()
#define PG8_SCHED __builtin_amdgcn_sched_barrier(0)
    Unit cur, nxt; int ui = 0;
    if (!S.next(0, cur)) return;
    f32x4 acc[2][2][4][2];
#pragma unroll
    for (int a = 0; a < 2; ++a)
#pragma unroll
        for (int b = 0; b < 2; ++b)
#pragma unroll
            for (int m = 0; m < 4; ++m)
#pragma unroll
                for (int n = 0; n < 2; ++n) acc[a][b][m][n] = (f32x4){0.f, 0.f, 0.f, 0.f};
    bf16x8 At[4][2], B0[2][2], B1[2][2];
    const char* cA = (const char*)g.A + (size_t)cur.pm * tstep; const char* cB = (const char*)g.Bt + (size_t)cur.pn * tstep;
    S.a_ready(cur);
    PG8_STAGE(PG8_SB(0, 0), cB, voffB); PG8_STAGE(PG8_SA(0, 0), cA, voffA); PG8_STAGE(PG8_SB(0, 1), cB + hstep, voffB); PG8_STAGE(PG8_SA(0, 1), cA + hstep, voffA);
    if (wr == 1) PG8_BAR;
    PG8_WAIT_V(4); PG8_BAR;
    PG8_STAGE(PG8_SB(1, 0), cB + kstep, voffB); PG8_STAGE(PG8_SA(1, 0), cA + kstep, voffA); PG8_STAGE(PG8_SB(1, 1), cB + hstep + kstep, voffB);
    PG8_WAIT_V(6); PG8_BAR;
    for (;;) {
        const bool has_next = S.next(ui + 1, nxt);
        const char* nA = has_next ? (const char*)g.A + (size_t)nxt.pm * tstep : cA; const char* nB = has_next ? (const char*)g.Bt + (size_t)nxt.pn * tstep : cB;
        for (int t = 0; t < nt; t += 2) {
            const bool last = (t == nt - 2);
            const char* a1 = cA + (size_t)(t + 1) * kstep;
            const char* a2 = last ? nA : cA + (size_t)(t + 2) * kstep; const char* b2 = last ? nB : cB + (size_t)(t + 2) * kstep;
            const char* a3 = a2 + kstep; const char* b3 = b2 + kstep;
            if (last && has_next) S.a_ready(nxt);
            PG8_LDB(B0, 0, 0); PG8_SCHED; PG8_LDA(At, 0, 0); PG8_STAGE(PG8_SA(1, 1), a1 + hstep, voffA);
            PG8_WAIT_L(8); PG8_BAR; PG8_WAIT_L(0); PG8_MMA(0, 0, At, B0); PG8_BAR; PG8_SCHED;
            PG8_LDB(B1, 0, 1); PG8_STAGE(PG8_SB(0, 0), b2, voffB);
            PG8_BAR; PG8_WAIT_L(0); PG8_MMA(0, 1, At, B1); PG8_BAR;
            PG8_LDA(At, 0, 1); PG8_STAGE(PG8_SA(0, 0), a2, voffA);
            PG8_BAR; PG8_WAIT_L(0); PG8_MMA(1, 0, At, B0); PG8_BAR; PG8_SCHED;
            PG8_STAGE(PG8_SB(0, 1), b2 + hstep, voffB);
            PG8_WAIT_V(6); PG8_BAR; PG8_MMA(1, 1, At, B1); PG8_BAR;
            PG8_LDB(B0, 1, 0); PG8_SCHED; PG8_LDA(At, 1, 0); PG8_STAGE(PG8_SA(0, 1), a2 + hstep, voffA);
            PG8_WAIT_L(8); PG8_BAR; PG8_WAIT_L(0); PG8_MMA(0, 0, At, B0); PG8_BAR; PG8_SCHED;
            PG8_LDB(B1, 1, 1); PG8_STAGE(PG8_SB(1, 0), b3, voffB);
            PG8_BAR; PG8_WAIT_L(0); PG8_MMA(0, 1, At, B1); PG8_BAR;
            PG8_LDA(At, 1, 1); PG8_STAGE(PG8_SA(1, 0), a3, voffA);
            PG8_BAR; PG8_WAIT_L(0); PG8_MMA(1, 0, At, B0); PG8_BAR; PG8_SCHED;
            PG8_STAGE(PG8_SB(1, 1), b3 + hstep, voffB);
            PG8_WAIT_V(6); PG8_BAR; PG8_MMA(1, 1, At, B1); PG8_BAR;
        }
        if constexpr (!Epi::AFTER_DRAIN) { E(acc, cur, wr, wc, fr, fq); S.done(cur); }
        if (!has_next) break;
#pragma unroll
        for (int a = 0; a < 2; ++a)
#pragma unroll
            for (int b = 0; b < 2; ++b)
#pragma unroll
                for (int m = 0; m < 4; ++m)
#pragma unroll
                    for (int n = 0; n < 2; ++n) acc[a][b][m][n] = (f32x4){0.f, 0.f, 0.f, 0.f};
        cur = nxt; cA = nA; cB = nB; ++ui;
    }
    PG8_WAIT_V(0);
    if (wr == 0) PG8_BAR;
    PG8_BAR;
    if constexpr (Epi::AFTER_DRAIN) { E.fused(acc, cur, wr, wc, fr, fq, lds, wid, lane); S.done(cur); }
#undef PG8_SA
#undef PG8_SB
#undef PG8_STAGE
#undef PG8_LDA
#undef PG8_LDB
#undef PG8_MMA
#undef PG8_WAIT_V
#undef PG8_WAIT_L
#undef PG8_BAR
#undef PG8_SCHED
}
}

__device__ __forceinline__ int ffin_row(int n) { const int half = n >= DFF, j = half ? n - DFF : n; return (j >> 7) * 256 + half * 128 + (j & 127); }
__device__ __forceinline__ void copy_tiles(const Ctx p, LAS unsigned char* lds, int tbeg, int tend, int first, int stride) {
    int tid_ = threadIdx.x; asm volatile("" : "+v"(tid_)); const int tid = tid_;
    unsigned char* ws = p.ws;
    LAS float* tile = (LAS float*)lds;
    const float* src; bf16_t* dst; int K, N, k0, n0; bool perm;
#define TILE_INFO(T) do { int t_ = (T), tk_; \
        if (t_ < 640) { src = PIN(13); K = 1024; N = 2560; dst = (bf16_t*)(ws + WS_W1T); perm = false; } \
        else if (t_ < 1152) { t_ -= 640; src = PIN(33); K = 1024; N = 2048; dst = (bf16_t*)(ws + WS_W1T) + (size_t)2560 * 1024; perm = false; } \
        else if (t_ < 1408) { t_ -= 1152; src = PIN(31); K = 1024; N = 1024; dst = (bf16_t*)(ws + WS_WPL); perm = false; } \
        else if (t_ < 1536) { t_ -= 1408; src = PIN(32); K = 512; N = 1024; dst = (bf16_t*)(ws + WS_WPS); perm = false; } \
        else if (t_ < 1792) { t_ -= 1536; src = PIN(35); K = 1024; N = 1024; dst = (bf16_t*)(ws + WS_WOUT); perm = false; } \
        else if (t_ < 3200) { t_ -= 1792; src = PIN(36); K = 1024; N = 2 * DFF; dst = (bf16_t*)(ws + WS_WFI); perm = true; } \
        else if (t_ < 3904) { t_ -= 3200; src = PIN(37); K = DFF; N = 1024; dst = (bf16_t*)(ws + WS_WFO); perm = false; } \
        else { t_ -= 3904; src = PIN(29); K = 512; N = 512; dst = (bf16_t*)(ws + WS_WGLU); perm = false; } \
        tk_ = K / 64; k0 = (t_ % tk_) * 64; n0 = (t_ / tk_) * 64; } while (0)
    {   const int r = tid >> 4, c4 = tid & 15, n = tid >> 3, kc = tid & 7;
        f32x4 v0, v1; int T = tbeg + first;
        if (T < tend) { TILE_INFO(T); v0 = __builtin_nontemporal_load((const f32x4*)(src + (size_t)(k0 + r) * N + n0 + 4 * c4)); v1 = __builtin_nontemporal_load((const f32x4*)(src + (size_t)(k0 + r + 32) * N + n0 + 4 * c4)); }
        for (; T < tend; T += stride) {
            TILE_INFO(T);
            bf16_t* const cdst = dst; const int cK = K, ck0 = k0, cdrow = perm ? ffin_row(n0 + n) : n0 + n;
            {   LAS float* t = tile + r * 65 + 4 * c4; t[0] = v0[0]; t[1] = v0[1]; t[2] = v0[2]; t[3] = v0[3]; t += 32 * 65; t[0] = v1[0]; t[1] = v1[1]; t[2] = v1[2]; t[3] = v1[3]; }
            __syncthreads();
            if (T + stride < tend) { TILE_INFO(T + stride); v0 = __builtin_nontemporal_load((const f32x4*)(src + (size_t)(k0 + r) * N + n0 + 4 * c4)); v1 = __builtin_nontemporal_load((const f32x4*)(src + (size_t)(k0 + r + 32) * N + n0 + 4 * c4)); }
            {   const LAS float* t = tile + (8 * kc) * 65 + n; u32x4 w;
                w.x = pk2(t[0], t[65]); w.y = pk2(t[130], t[195]); w.z = pk2(t[260], t[325]); w.w = pk2(t[390], t[455]);
                *(u32x4*)(cdst + (size_t)cdrow * cK + ck0 + 8 * kc) = w; }
            __syncthreads();
        }
    }
#undef TILE_INFO
}
__device__ __forceinline__ void p0_prologue(const Ctx p, LAS unsigned char* lds) {
    const int tid = threadIdx.x, G = gridDim.x, bx = blockIdx.x;
    unsigned char* ws = p.ws;
    if (bx >= G - 96) {
        const int item = bx - (G - 96), n0 = item * 64, w = tid >> 6, lane = tid & 63;
        LAS float* sc = (LAS float*)lds;
        LAS float* red = (LAS float*)(lds + 9 * 1024 * 4);
        for (int i = tid; i < 9 * 1024; i += 512) { const int j = i >> 10, k = i & 1023; const float v = j == 0 ? PIN(6)[k] : PIN(2)[(j - 1) * 1024 + k]; sc[i] = siluf_(v); }
        __syncthreads();
        float a[9];
#pragma unroll
        for (int j = 0; j < 9; ++j) a[j] = 0.f;
        const float* wm = PIN(7) + n0 + lane;
#pragma unroll 16
        for (int k = 128 * w; k < 128 * w + 128; ++k) { const float wv = __builtin_nontemporal_load(wm + (size_t)k * 6144);
#pragma unroll
            for (int j = 0; j < 9; ++j) a[j] += sc[j * 1024 + k] * wv; }
#pragma unroll
        for (int j = 0; j < 9; ++j) red[(w * 9 + j) * 64 + lane] = a[j];
        __syncthreads();
        for (int i = tid; i < 9 * 64; i += 512) { const int j = i >> 6, l = i & 63; float s = PIN(8)[n0 + l];
#pragma unroll
            for (int ww = 0; ww < 8; ++ww) s += red[(ww * 9 + j) * 64 + l];
            ((float*)(ws + WS_MOD))[j * 6144 + n0 + l] = s; }
        __syncthreads();
    }
    if (bx < G - 96) { copy_tiles(p, lds, 0, 1792, bx, G - 96); copy_tiles(p, lds, 3904, 3968, bx, G - 96); }
}

#define ROW_SS(v) ((v[0][0] * v[0][0] + v[0][1] * v[0][1]) + (v[0][2] * v[0][2] + v[0][3] * v[0][3]) + (v[1][0] * v[1][0] + v[1][1] * v[1][1]) + (v[1][2] * v[1][2] + v[1][3] * v[1][3]) + \
                   (v[2][0] * v[2][0] + v[2][1] * v[2][1]) + (v[2][2] * v[2][2] + v[2][3] * v[2][3]) + (v[3][0] * v[3][0] + v[3][1] * v[3][1]) + (v[3][2] * v[3][2] + v[3][3] * v[3][3]))
__device__ __forceinline__ float wave_sum(float x) {
#pragma unroll
    for (int o = 1; o < 64; o <<= 1) x += __shfl_xor(x, o);
    return x; }
__device__ __forceinline__ f32x4 bf4(const u32x2 w) { return (f32x4){bf_lo(w.x), bf_hi(w.x), bf_lo(w.y), bf_hi(w.y)}; }
__device__ __forceinline__ bf16_t* x1_row(const Ctx p, int r) { return r < 10240 ? (bf16_t*)(p.ws + WS_X1A) + (size_t)r * 1024 : (bf16_t*)(p.ws + WS_X1B) + (size_t)(r - 10240) * 1024; }
__device__ __forceinline__ void p1_hn(const Ctx p) {
    int tid_ = threadIdx.x; asm volatile("" : "+v"(tid_)); const int tid = tid_, w = tid >> 6, lane = tid & 63, r0 = blockIdx.x * 160 + w * 20;
    bf16_t* HN = (bf16_t*)(p.ws + WS_HN);
    f32x4 gs[4], sh[4]; int cur = -1;
    for (int it = 0; it < 10; ++it) { const int r = r0 + 2 * it, mi = mod_index(r);
        if (mi != cur) { cur = mi; const float* mod = (const float*)(p.ws + WS_MOD) + mi * 6144;
#pragma unroll
            for (int j = 0; j < 4; ++j) { const int c = 4 * lane + 256 * j; gs[j] = *(const f32x4*)(PIN(9) + c) * (*(const f32x4*)(mod + 1024 + c) + 1.0f); sh[j] = *(const f32x4*)(mod + c); } }
        const float* xa = xrow(p, r); const float* xb = xrow(p, r + 1); f32x4 va[4], vb[4];
#pragma unroll
        for (int j = 0; j < 4; ++j) { va[j] = __builtin_nontemporal_load((const f32x4*)(xa + 4 * lane + 256 * j)); vb[j] = __builtin_nontemporal_load((const f32x4*)(xb + 4 * lane + 256 * j)); }
        const float ra = __builtin_amdgcn_rsqf(wave_sum(ROW_SS(va)) * (1.0f / 1024.0f) + EPS), rb = __builtin_amdgcn_rsqf(wave_sum(ROW_SS(vb)) * (1.0f / 1024.0f) + EPS);
#pragma unroll
        for (int j = 0; j < 4; ++j) { const f32x4 ya = va[j] * ra * gs[j] + sh[j], yb = vb[j] * rb * gs[j] + sh[j]; u32x2 oa, ob; oa.x = pk2(ya[0], ya[1]); oa.y = pk2(ya[2], ya[3]); ob.x = pk2(yb[0], yb[1]); ob.y = pk2(yb[2], yb[3]);
            *(u32x2*)(HN + (size_t)r * 1024 + 4 * lane + 256 * j) = oa; *(u32x2*)(HN + (size_t)(r + 1) * 1024 + 4 * lane + 256 * j) = ob; }
    }
}
__device__ __forceinline__ float row_rs(const float* ssp, int r, int lane) { float q = ssp[((size_t)((lane >> 2) & 3) * MT + r) * 4 + (lane & 3)]; q += __shfl_xor(q, 1); q += __shfl_xor(q, 2); q += __shfl_xor(q, 4); q += __shfl_xor(q, 8);
    return __builtin_amdgcn_rsqf(q * (1.0f / 1024.0f) + EPS); }
__device__ __forceinline__ void p7_x1(const Ctx p) {
    int tid_ = threadIdx.x; asm volatile("" : "+v"(tid_)); const int tid = tid_, w = tid >> 6, lane = tid & 63, r0 = blockIdx.x * 160 + w * 20;
    const bf16_t* MO = (const bf16_t*)(p.ws + WS_MO); bf16_t* HN2 = (bf16_t*)(p.ws + WS_HN2); const float* ss1 = (const float*)(p.ws + WS_SSP1);
    f32x4 gg[4], gs[4], sh[4]; int cur = -1;
    for (int it = 0; it < 10; ++it) { const int r = r0 + 2 * it, mi = mod_index(r);
        if (mi != cur) { cur = mi; const float* mod = (const float*)(p.ws + WS_MOD) + mi * 6144;
#pragma unroll
            for (int j = 0; j < 4; ++j) { const int c = 4 * lane + 256 * j; gg[j] = *(const f32x4*)(mod + 2048 + c) * *(const f32x4*)(PIN(10) + c);
                gs[j] = *(const f32x4*)(PIN(11) + c) * (*(const f32x4*)(mod + 4096 + c) + 1.0f); sh[j] = *(const f32x4*)(mod + 3072 + c); } }
        const float* xa = xrow(p, r); const float* xb = xrow(p, r + 1); f32x4 va[4], vb[4]; u32x2 ma[4], mb[4];
#pragma unroll
        for (int j = 0; j < 4; ++j) { const int c = 4 * lane + 256 * j; va[j] = __builtin_nontemporal_load((const f32x4*)(xa + c)); vb[j] = __builtin_nontemporal_load((const f32x4*)(xb + c)); ma[j] = *(const u32x2*)(MO + (size_t)r * 1024 + c); mb[j] = *(const u32x2*)(MO + (size_t)(r + 1) * 1024 + c); }
        const float sa = row_rs(ss1, r, lane), sb = row_rs(ss1, r + 1, lane);
#pragma unroll
        for (int j = 0; j < 4; ++j) { const int c = 4 * lane + 256 * j; va[j] = va[j] + gg[j] * bf4(ma[j]) * sa; vb[j] = vb[j] + gg[j] * bf4(mb[j]) * sb;
            { u32x2 oa, ob; oa.x = pk2(va[j][0], va[j][1]); oa.y = pk2(va[j][2], va[j][3]); ob.x = pk2(vb[j][0], vb[j][1]); ob.y = pk2(vb[j][2], vb[j][3]); __builtin_nontemporal_store(oa, (u32x2*)(x1_row(p, r) + c)); __builtin_nontemporal_store(ob, (u32x2*)(x1_row(p, r + 1) + c)); } }
        const float ra = __builtin_amdgcn_rsqf(wave_sum(ROW_SS(va)) * (1.0f / 1024.0f) + EPS), rb = __builtin_amdgcn_rsqf(wave_sum(ROW_SS(vb)) * (1.0f / 1024.0f) + EPS);
#pragma unroll
        for (int j = 0; j < 4; ++j) { const f32x4 ya = va[j] * ra * gs[j] + sh[j], yb = vb[j] * rb * gs[j] + sh[j]; u32x2 oa, ob; oa.x = pk2(ya[0], ya[1]); oa.y = pk2(ya[2], ya[3]); ob.x = pk2(yb[0], yb[1]); ob.y = pk2(yb[2], yb[3]);
            *(u32x2*)(HN2 + (size_t)r * 1024 + 4 * lane + 256 * j) = oa; *(u32x2*)(HN2 + (size_t)(r + 1) * 1024 + 4 * lane + 256 * j) = ob; }
    }
}
__device__ __forceinline__ void p10_out(const Ctx p) {
    int tid_ = threadIdx.x; asm volatile("" : "+v"(tid_)); const int tid = tid_, w = tid >> 6, lane = tid & 63, r0 = blockIdx.x * 160 + w * 20;
    const bf16_t* FO = (const bf16_t*)(p.ws + WS_FO); const bf16_t* FOB = (const bf16_t*)(p.ws + WS_FOB);
    f32x4 gg[4]; int cur = -1;
    for (int it = 0; it < 10; ++it) { const int r = r0 + 2 * it, mi = mod_index(r); const bool split = r >= 128 * 256;
        if (mi != cur) { cur = mi; const float* mod = (const float*)(p.ws + WS_MOD) + mi * 6144;
#pragma unroll
            for (int j = 0; j < 4; ++j) { const int c = 4 * lane + 256 * j; gg[j] = *(const f32x4*)(mod + 5120 + c) * *(const f32x4*)(PIN(12) + c); } }
        f32x4 va[4], vb[4], fa[4], fb[4];
#pragma unroll
        for (int j = 0; j < 4; ++j) { const int c = 4 * lane + 256 * j; va[j] = bf4(__builtin_nontemporal_load((const u32x2*)(x1_row(p, r) + c))); vb[j] = bf4(__builtin_nontemporal_load((const u32x2*)(x1_row(p, r + 1) + c)));
            fa[j] = bf4(*(const u32x2*)(FO + (size_t)r * 1024 + c)); fb[j] = bf4(*(const u32x2*)(FO + (size_t)(r + 1) * 1024 + c));
            if (split) { fa[j] = fa[j] + bf4(*(const u32x2*)(FOB + (size_t)r * 1024 + c)); fb[j] = fb[j] + bf4(*(const u32x2*)(FOB + (size_t)(r + 1) * 1024 + c)); } }
        const float sa = __builtin_amdgcn_rsqf(wave_sum(ROW_SS(fa)) * (1.0f / 1024.0f) + EPS), sb = __builtin_amdgcn_rsqf(wave_sum(ROW_SS(fb)) * (1.0f / 1024.0f) + EPS);
#pragma unroll
        for (int j = 0; j < 4; ++j) { const int c = 4 * lane + 256 * j; __builtin_nontemporal_store(va[j] + gg[j] * fa[j] * sa, (f32x4*)(p.out + (size_t)r * 1024 + c)); __builtin_nontemporal_store(vb[j] + gg[j] * fb[j] * sb, (f32x4*)(p.out + (size_t)(r + 1) * 1024 + c)); }
    }
}

constexpr int LRU_U16 = 0, LRU_UB = 9216, LRU_AA = LRU_UB + 17408, LRU_AGG = LRU_AA + 17408, LRU_CAR = LRU_AGG + 2048, LRU_HALF = 46592;
__device__ __forceinline__ void lru_unit(const Ctx p, LAS unsigned char* lds, int sample, int b, int hd) {
    int tid_ = threadIdx.x; asm volatile("" : "+v"(tid_)); const int tid = tid_, d = tid >> 8, ht = tid & 255, hw = ht >> 6, lane = tid & 63;
    const int T = sample ? T_S : T_CTX, row0 = sample ? MC + b * T_S : b * T_CTX, nch = T / 64;
    LAS unsigned char* L = lds + d * LRU_HALF;
    LAS bf16_t* U16 = (LAS bf16_t*)(L + LRU_U16); LAS float* UB = (LAS float*)(L + LRU_UB); LAS float* AA = (LAS float*)(L + LRU_AA);
    LAS f32x2* AGG = (LAS f32x2*)(L + LRU_AGG); LAS float* CAR = (LAS float*)(L + LRU_CAR);
    const bf16_t* XA = (const bf16_t*)(p.ws + WS_XA); const bf16_t* GA = (const bf16_t*)(p.ws + WS_GA); bf16_t* YA = (bf16_t*)(p.ws + WS_YA);
    const int fj = lane & 15, fq = lane >> 4, chg = hd * 64 + 16 * hw + fj;
    bf16x8 wrf[2], wif[2];
    {   const float* wr = PIN(16) + (size_t)(d * 16 + hd) * 4096 + 16 * hw + fj; const float* wi = PIN(18) + (size_t)(d * 16 + hd) * 4096 + 16 * hw + fj;
#pragma unroll
        for (int s = 0; s < 2; ++s)
#pragma unroll
            for (int e = 0; e < 8; ++e) { const int k = 32 * s + 8 * fq + e; wrf[s][e] = (short)f2bf(wr[k * 64]); wif[s][e] = (short)f2bf(wi[k * 64]); } }
    const float br = PIN(17)[d * 1024 + chg], bi = PIN(19)[d * 1024 + chg];
    const float sp8 = -8.0f * 1.44269504089f * log1pf(__expf(-PIN(20)[d * 1024 + chg]));
    const int cp = ht & 31, tg = ht >> 5, cc0 = hd * 64 + 2 * cp;
    float cw0[4], cw1[4];
#pragma unroll
    for (int j = 0; j < 4; ++j) { cw0[j] = PIN(14)[j * 1024 + cc0]; cw1[j] = PIN(14)[j * 1024 + cc0 + 1]; }
    const float cb0 = PIN(15)[cc0], cb1 = PIN(15)[cc0 + 1];
    const int chs = hd * 64 + lane;
    if (ht < 64) CAR[lane] = sample ? PIN(3)[(size_t)(b * 2 + d) * 1024 + chs] : 0.f;
    float hfin = 0.f;
    __syncthreads();
    unsigned xw[11];
#define LRU_LOADX(kk) do { const int c_ = d ? nch - 1 - (kk) : (kk); _Pragma("unroll") for (int i = 0; i < 11; ++i) { const int t = 64 * c_ + 8 * tg - 2 + i; unsigned w = 0u; if (t >= 0 && t < T) w = *(const unsigned*)(XA + (size_t)(row0 + t) * 1024 + cc0); xw[i] = w; } } while (0)
    LRU_LOADX(0);
    for (int k = 0; k < nch; ++k) {
        const int c = d ? nch - 1 - k : k, t0 = 64 * c; const bool second = (2 * k >= nch);
        {   float x0[11], x1[11];
#pragma unroll
            for (int i = 0; i < 11; ++i) { x0[i] = bf_lo(xw[i]); x1[i] = bf_hi(xw[i]); }
#pragma unroll
            for (int i = 0; i < 8; ++i) { const float u0 = cb0 + cw0[0] * x0[i] + cw0[1] * x0[i + 1] + cw0[2] * x0[i + 2] + cw0[3] * x0[i + 3];
                const float u1 = cb1 + cw1[0] * x1[i] + cw1[1] * x1[i + 1] + cw1[2] * x1[i + 2] + cw1[3] * x1[i + 3]; const int tl = 8 * tg + i;
                *(LAS unsigned*)(U16 + tl * 72 + 2 * cp) = pk2(u0, u1); *(LAS f32x2*)(UB + tl * 68 + 2 * cp) = (f32x2){u0, u1}; } }
        if (k + 1 < nch) LRU_LOADX(k + 1);
        unsigned short hf16[16], g16[16];
        if (second) {
#pragma unroll
            for (int i = 0; i < 16; ++i) { const int pi = 16 * hw + i, tl = d ? 63 - pi : pi; const size_t ix = (size_t)(row0 + t0 + tl) * 1024 + chs; hf16[i] = YA[ix]; g16[i] = GA[ix]; } }
        __syncthreads();
        {   f32x4 ar[4], ai[4];
#pragma unroll
            for (int m = 0; m < 4; ++m) { ar[m] = (f32x4){0.f, 0.f, 0.f, 0.f}; ai[m] = ar[m];
#pragma unroll
                for (int s = 0; s < 2; ++s) { const bf16x8 a = *(const LAS bf16x8*)(U16 + (16 * m + fj) * 72 + 32 * s + 8 * fq);
                    ar[m] = __builtin_amdgcn_mfma_f32_16x16x32_bf16(a, wrf[s], ar[m], 0, 0, 0); ai[m] = __builtin_amdgcn_mfma_f32_16x16x32_bf16(a, wif[s], ai[m], 0, 0, 0); } }
#pragma unroll
            for (int m = 0; m < 4; ++m)
#pragma unroll
                for (int r4 = 0; r4 < 4; ++r4) { const int tok = 16 * m + 4 * fq + r4, ix = tok * 68 + 16 * hw + fj;
                    const float rg = sigmoidf_(ar[m][r4] + br), a = __builtin_amdgcn_exp2f(sp8 * rg);
                    const float ei = 1.0f + __builtin_amdgcn_exp2f(-1.44269504089f * (ai[m][r4] + bi)), om = fmaxf(1.0f - a * a, 1e-30f);
                    const float bb = om * __builtin_amdgcn_rsqf(om * ei * ei) * UB[ix]; AA[ix] = a; UB[ix] = bb; } }
        __syncthreads();
        float av[16], bv[16]; float P = 1.f, h = 0.f;
#pragma unroll
        for (int i = 0; i < 16; ++i) { const int pi = 16 * hw + i, tl = d ? 63 - pi : pi; av[i] = AA[tl * 68 + lane]; bv[i] = UB[tl * 68 + lane]; h = av[i] * h + bv[i]; P *= av[i]; }
        AGG[hw * 64 + lane] = (f32x2){P, h};
        __syncthreads();
        h = CAR[(k & 1) * 64 + lane];
        for (int s2 = 0; s2 < hw; ++s2) { const f32x2 ag = AGG[s2 * 64 + lane]; h = ag.x * h + ag.y; }
#pragma unroll
        for (int i = 0; i < 16; ++i) { const int pi = 16 * hw + i, tl = d ? 63 - pi : pi; const size_t ix = (size_t)(row0 + t0 + tl) * 1024 + chs; h = av[i] * h + bv[i];
            YA[ix] = f2bf1(second ? bf2f(g16[i]) * (bf2f(hf16[i]) + h) : h); }
        if (hw == 3) { CAR[((k + 1) & 1) * 64 + lane] = h; hfin = h; }
        if (2 * k + 2 == nch) asm volatile("s_waitcnt vmcnt(0)" ::: "memory");
        __syncthreads();
    }
#undef LRU_LOADX
    if (!sample && hw == 3) p.out[OFF_LRU + (size_t)(b * 2 + d) * 1024 + chs] = hfin;
}

__device__ __forceinline__ void sincos_f(float x, float& s, float& c) {
    const float jf = rintf(x * 0.636619772f); const int j = (int)jf;
    float r = x - jf * 1.5703125f; r -= jf * 4.837512969970703125e-4f; r -= jf * 7.54978995489188216e-8f;
    const float z = r * r;
    const float sp = r + r * z * (-1.6666654611e-1f + z * (8.3321608736e-3f + z * (-1.9515295891e-4f)));
    const float cp = 1.0f - 0.5f * z + z * z * (4.166664568298827e-2f + z * (-1.388731625493765e-3f + z * 2.443315711809948e-5f));
    const int q = j & 3;
    s = (q == 0) ? sp : (q == 1) ? cp : (q == 2) ? -sp : -cp;
    c = (q == 0) ? cp : (q == 1) ? -sp : (q == 2) ? -cp : sp;
}
__device__ __forceinline__ void s5_disc(const Ctx p, int d, int g, int ps, float& abr, float& abi, float& fre, float& fim) {
    const float lr = PIN(21)[(d * 32 + g) * 64 + ps], li = PIN(22)[(d * 32 + g) * 64 + ps], dt = __expf(PIN(23)[d * 32 + g]);
    const float mag = __expf(lr * dt); float sn, cs; sincos_f(li * dt, sn, cs);
    abr = mag * cs; abi = mag * sn;
    const float den = lr * lr + li * li, nr = abr - 1.0f, ni = abi;
    fre = (nr * lr + ni * li) / den; fim = (ni * lr - nr * li) / den;
}
constexpr int S5_HS_STRIDE = 272, S5_HS_WAVE = 32 * S5_HS_STRIDE;
__device__ __forceinline__ void s5_item(const Ctx p, LAS unsigned char* lds, int sample, int b, int g0) {
    int tid_ = threadIdx.x; asm volatile("" : "+v"(tid_)); const int tid = tid_, w = tid >> 6, lane = tid & 63, d = w & 1, g = g0 + (w >> 1);
    const int T = sample ? T_S : T_CTX, row0 = sample ? MC + b * T_S : b * T_CTX, nch = T / 32;
    LAS unsigned char* Hs = lds + w * S5_HS_WAVE;
    const bf16_t* XS = (const bf16_t*)(p.ws + WS_XS); bf16_t* VS = (bf16_t*)(p.ws + WS_VS);
    const int j31 = lane & 31, hi = lane >> 5;
    float abr1, abi1, fr1, fi1, abr2, abi2, fr2, fi2;
    s5_disc(p, d, g, j31, abr1, abi1, fr1, fi1); s5_disc(p, d, g, 32 + j31, abr2, abi2, fr2, fi2);
    const float abr = hi ? abr2 : abr1, abi = hi ? abi2 : abi1;
    bf16x8 bfr[4];
#pragma unroll
    for (int st = 0; st < 2; ++st) { const int ps = 32 * st + j31; const float fr = st ? fr2 : fr1, fi = st ? fi2 : fi1;
        const float* bre = PIN(24) + ((size_t)(d * 32 + g) * 64 + ps) * 16 + 8 * hi; const float* bim = PIN(25) + ((size_t)(d * 32 + g) * 64 + ps) * 16 + 8 * hi;
#pragma unroll
        for (int e = 0; e < 8; ++e) { const float vr = bre[e], vi = bim[e]; bfr[2 * st][e] = (short)f2bf(fr * vr - fi * vi); bfr[2 * st + 1][e] = (short)f2bf(fr * vi + fi * vr); } }
    const int fh = lane & 15, kq = lane >> 4;
    bf16x8 cfr[4];
#pragma unroll
    for (int ks = 0; ks < 4; ++ks)
#pragma unroll
        for (int e = 0; e < 8; ++e) { const int pp = 16 * ks + 4 * kq + (e >> 1); const size_t ix = ((size_t)(d * 32 + g) * 16 + fh) * 64 + pp;
            cfr[ks][e] = (short)f2bf((e & 1) ? -PIN(27)[ix] : PIN(26)[ix]); }
    const float dsk = PIN(28)[g * 16 + fh];
    const float one = __builtin_fmaf(dsk, 0.f, 1.0f);
    float hr = 0.f, hi_ = 0.f;
    if (sample) { const size_t ix = ((size_t)(b * 2 + d) * 32 + g) * 64 + lane; hr = PIN(4)[ix]; hi_ = PIN(5)[ix]; }
    const int step = (d ? -1 : 1) * (sample ? 64 : 1);
    const int ua_off = step * 512 * j31 + g * 16 + 8 * hi;
    int eoff[8];
#pragma unroll
    for (int e = 0; e < 8; ++e) eoff[e] = step * 512 * (16 * (e >> 2) + 4 * kq + (e & 3)) + g * 16 + fh;
#define S5_CBASE(kk) ({ const int s0_ = d ? T - 1 - 32 * (kk) : 32 * (kk); const int t0_ = sample ? ((s0_ & 63) * 64 + (s0_ >> 6)) : s0_; (size_t)(row0 + t0_) * 512; })
    bf16x8 ua_next = *(const bf16x8*)(XS + S5_CBASE(0) + ua_off);
    for (int k = 0; k < nch; ++k) {
        const bool second = (2 * k >= nch);
        const size_t cbase = S5_CBASE(k);
        const bf16x8 ua = ua_next;
        if (k + 1 < nch) ua_next = *(const bf16x8*)(XS + S5_CBASE(k + 1) + ua_off);
        unsigned short vf16[8], xs16[8];
        if (second) {
#pragma unroll
            for (int mt = 0; mt < 2; ++mt)
#pragma unroll
                for (int r4 = 0; r4 < 4; ++r4) { const size_t ix = cbase + eoff[mt * 4 + r4]; vf16[mt * 4 + r4] = VS[ix]; xs16[mt * 4 + r4] = XS[ix]; } }
        f32x16 acc[4];
#pragma unroll
        for (int nt = 0; nt < 4; ++nt) { f32x16 z;
#pragma unroll
            for (int v = 0; v < 16; ++v) z[v] = 0.f;
            acc[nt] = __builtin_amdgcn_mfma_f32_32x32x16_bf16(ua, bfr[nt], z, 0, 0, 0); }
        float bur[32], bui[32];
#pragma unroll
        for (int v = 0; v < 16; ++v) {
            unsigned r0 = __builtin_bit_cast(unsigned, acc[0][v] * one), r1 = __builtin_bit_cast(unsigned, acc[2][v] * one);
            unsigned q0 = __builtin_bit_cast(unsigned, acc[1][v] * one), q1 = __builtin_bit_cast(unsigned, acc[3][v] * one);
            asm volatile("s_nop 1\n\tv_permlane32_swap_b32 %0, %1" : "+v"(r0), "+v"(r1));
            asm volatile("s_nop 1\n\tv_permlane32_swap_b32 %0, %1" : "+v"(q0), "+v"(q1));
            const int ta = 8 * (v >> 2) + (v & 3);
            bur[ta] = __builtin_bit_cast(float, r0); bur[ta + 4] = __builtin_bit_cast(float, r1);
            bui[ta] = __builtin_bit_cast(float, q0); bui[ta + 4] = __builtin_bit_cast(float, q1); }
#pragma unroll
        for (int tt = 0; tt < 32; ++tt) { const float nr = abr * hr - abi * hi_ + bur[tt], ni = abr * hi_ + abi * hr + bui[tt]; hr = nr; hi_ = ni;
            *(LAS unsigned*)(Hs + tt * S5_HS_STRIDE + 4 * lane) = pk2(hr, hi_); }
        f32x4 ya[2];
#pragma unroll
        for (int mt = 0; mt < 2; ++mt) { ya[mt] = (f32x4){0.f, 0.f, 0.f, 0.f};
#pragma unroll
            for (int ks = 0; ks < 4; ++ks) { const bf16x8 a = *(const LAS bf16x8*)(Hs + (16 * mt + fh) * S5_HS_STRIDE + (32 * ks + 8 * kq) * 2);
                ya[mt] = __builtin_amdgcn_mfma_f32_16x16x32_bf16(a, cfr[ks], ya[mt], 0, 0, 0); } }
#pragma unroll
        for (int mt = 0; mt < 2; ++mt)
#pragma unroll
            for (int r4 = 0; r4 < 4; ++r4) { const size_t ix = cbase + eoff[mt * 4 + r4]; float y = ya[mt][r4];
                if (second) { y = gelu_tanh(y + bf2f(vf16[mt * 4 + r4]) + dsk * bf2f(xs16[mt * 4 + r4])); }
                VS[ix] = f2bf1(y); }
        if (2 * k + 2 == nch) { asm volatile("s_waitcnt vmcnt(0)" ::: "memory"); __syncthreads(); }
    }
#undef S5_CBASE
    if (!sample) { const size_t ix = ((size_t)(b * 2 + d) * 32 + g) * 64 + lane; p.out[OFF_RE + ix] = hr; p.out[OFF_IM + ix] = hi_; }
}
__device__ __forceinline__ void p3_scans(const Ctx p, LAS unsigned char* lds) {
    const int bx = blockIdx.x;
    if (bx < 128) { lru_unit(p, lds, 1, bx >> 4, bx & 15); }
    else if (bx < 192) { const int i = bx - 128; s5_item(p, lds, 1, i >> 3, 4 * (i & 7)); }
    else { const int i = bx - 192;
        for (int e = 0; e < 8; ++e) { const int c = 8 * i + e; lru_unit(p, lds, 0, c >> 4, c & 15); __syncthreads(); }
        for (int e = 0; e < 4; ++e) { const int c = 4 * i + e; s5_item(p, lds, 0, c >> 3, 4 * (c & 7)); __syncthreads(); } }
}

#define XB_TMO      128
#define XB_XCNT(j)  (256  + 64 * (j))
#define XB_XSUB(j)  (1280 + 64 * (j))
#define XB_XGEN(j)  (2304 + 64 * (j))
#define XB_TOP      3328
#define XB_TOPGEN   3392
#define XCD_BAR_WORDS 3456
#define XB_SPIN_CAP (1u << 18)

__device__ __forceinline__ unsigned xb_ld(unsigned* p)              { return __hip_atomic_load(p, __ATOMIC_RELAXED, __HIP_MEMORY_SCOPE_AGENT); }
__device__ __forceinline__ unsigned xb_add(unsigned* p, unsigned v) { return __hip_atomic_fetch_add(p, v, __ATOMIC_RELAXED, __HIP_MEMORY_SCOPE_AGENT); }
__device__ __forceinline__ unsigned xb_xcc_id() { return (unsigned)__builtin_amdgcn_s_getreg((3 << 11) | 20) & 0xFu; }
#define XB_SPIN(cond, bar) do { unsigned _sp = 0; while (cond) { __builtin_amdgcn_s_sleep(1); \
    if ((++_sp & 255u) == 0u) { if (xb_ld(&(bar)[XB_TMO])) break; if (_sp > XB_SPIN_CAP) { atomicAdd(&(bar)[XB_TMO], 1u); break; } } } } while (0)

struct XcdBarrier {
    unsigned* bar; unsigned x;
    volatile LAS unsigned* st;
};

__device__ __forceinline__ XcdBarrier xcd_barrier_post(unsigned* bar, volatile LAS unsigned* st) {
    XcdBarrier b; b.bar = bar; b.x = xb_xcc_id(); b.st = st;
    if (threadIdx.x == 0) (void)xb_add(&bar[XB_XCNT(b.x)], 1u);
    return b;
}
__device__ __forceinline__ void xcd_barrier_complete(unsigned* bar, unsigned x, unsigned& nloc, unsigned& nx) {
    const unsigned G = gridDim.x * gridDim.y * gridDim.z;
    unsigned sum, cnt, mine, sp = 0u;
    for (;;) {
        sum = 0u; cnt = 0u; mine = 0u;
#pragma unroll
        for (unsigned j = 0; j < 16; ++j) { const unsigned c = xb_ld(&bar[XB_XCNT(j)]); sum += c; cnt += (c > 0u) ? 1u : 0u; mine = (j == x) ? c : mine; }
        if (sum == G) break;
        __builtin_amdgcn_s_sleep(1);
        if ((++sp & 255u) == 0u) { if (xb_ld(&bar[XB_TMO])) break; if (sp > XB_SPIN_CAP) { atomicAdd(&bar[XB_TMO], 1u); break; } }
    }
    nloc = mine > 0u ? mine : 1u; nx = cnt > 0u ? cnt : 1u;
}

__device__ __forceinline__ void xcd_barrier(const XcdBarrier& b) {
    asm volatile("s_waitcnt vmcnt(0)" ::: "memory");
    __syncthreads();
    if (threadIdx.x == 0) {
        unsigned* bar = b.bar;
        __builtin_amdgcn_s_waitcnt(0);
        unsigned nloc = b.st[0], nx = b.st[1];
        if (nloc == 0u) { xcd_barrier_complete(bar, b.x, nloc, nx); b.st[0] = nloc; b.st[1] = nx; }
        const unsigned old = xb_add(&bar[XB_XSUB(b.x)], 1u);
        const unsigned gen = old / nloc;
        if (old + 1u == (gen + 1u) * nloc) {
            __builtin_amdgcn_fence(__ATOMIC_RELEASE, "agent");
            asm volatile("s_waitcnt vmcnt(0)" ::: "memory");
            const unsigned og = xb_add(&bar[XB_TOP], 1u);
            const unsigned tg = og / nx;
            if (og + 1u == (tg + 1u) * nx) xb_add(&bar[XB_TOPGEN], 1u);
            else XB_SPIN(xb_ld(&bar[XB_TOPGEN]) == tg, bar);
            __builtin_amdgcn_fence(__ATOMIC_ACQUIRE, "agent");
            xb_add(&bar[XB_XGEN(b.x)], 1u);
            asm volatile("s_waitcnt vmcnt(0)" ::: "memory");
        } else {
            XB_SPIN(xb_ld(&bar[XB_XGEN(b.x)]) == gen, bar);
            __builtin_amdgcn_fence(__ATOMIC_ACQUIRE, "agent");
            asm volatile("s_waitcnt vmcnt(0)" ::: "memory");
        }
    }
    __syncthreads();
}

#define GRID_SYNC() do { asm volatile("s_waitcnt vmcnt(0)" ::: "memory"); grid.sync(); if (threadIdx.x < 64) { __builtin_amdgcn_fence(__ATOMIC_ACQUIRE, "agent"); asm volatile("s_waitcnt vmcnt(0)" ::: "memory"); } __syncthreads(); } while (0)
__global__ void __launch_bounds__(512, 2) fwd_mega(Params kp) {
    extern __shared__ __attribute__((aligned(16))) unsigned char lds_raw[];
    LAS unsigned char* lds = (LAS unsigned char*)lds_raw;
    {   LAS unsigned long long* t_ = (LAS unsigned long long*)(lds + LDS_BYTES - 512);
        if (threadIdx.x == 0) { t_[0] = (unsigned long long)kp.in[0]; t_[1] = (unsigned long long)kp.in[1]; t_[2] = (unsigned long long)kp.in[2]; t_[3] = (unsigned long long)kp.in[3]; t_[4] = (unsigned long long)kp.in[4]; t_[5] = (unsigned long long)kp.in[5]; t_[6] = (unsigned long long)kp.in[6]; t_[7] = (unsigned long long)kp.in[7]; t_[8] = (unsigned long long)kp.in[8]; t_[9] = (unsigned long long)kp.in[9]; t_[10] = (unsigned long long)kp.in[10]; t_[11] = (unsigned long long)kp.in[11]; t_[12] = (unsigned long long)kp.in[12]; t_[13] = (unsigned long long)kp.in[13]; t_[14] = (unsigned long long)kp.in[14]; t_[15] = (unsigned long long)kp.in[15]; t_[16] = (unsigned long long)kp.in[16]; t_[17] = (unsigned long long)kp.in[17]; t_[18] = (unsigned long long)kp.in[18]; t_[19] = (unsigned long long)kp.in[19]; t_[20] = (unsigned long long)kp.in[20]; t_[21] = (unsigned long long)kp.in[21]; t_[22] = (unsigned long long)kp.in[22]; t_[23] = (unsigned long long)kp.in[23]; t_[24] = (unsigned long long)kp.in[24]; t_[25] = (unsigned long long)kp.in[25]; t_[26] = (unsigned long long)kp.in[26]; t_[27] = (unsigned long long)kp.in[27]; t_[28] = (unsigned long long)kp.in[28]; t_[29] = (unsigned long long)kp.in[29]; t_[30] = (unsigned long long)kp.in[30]; t_[31] = (unsigned long long)kp.in[31]; t_[32] = (unsigned long long)kp.in[32]; t_[33] = (unsigned long long)kp.in[33]; t_[34] = (unsigned long long)kp.in[34]; t_[35] = (unsigned long long)kp.in[35]; t_[36] = (unsigned long long)kp.in[36]; t_[37] = (unsigned long long)kp.in[37]; }
        __syncthreads(); }
    Ctx p; p.tbl = (const LAS unsigned long long*)(lds + LDS_BYTES - 512); p.out = kp.out; p.ws = kp.ws;
    cg::grid_group grid = cg::this_grid();
    unsigned char* ws = p.ws; const int G = gridDim.x, bx = blockIdx.x;
    bf16_t* GATE = (bf16_t*)p.out;
    volatile LAS unsigned* xst = (volatile LAS unsigned*)(lds + LDS_BYTES - 512 - 16);
    if (threadIdx.x < 4) xst[threadIdx.x] = 0u;
    __syncthreads();
    const XcdBarrier xb = xcd_barrier_post((unsigned*)(ws + 768 * 1024), xst);
#define GRID_BAR() xcd_barrier(xb)
    p0_prologue(p, lds);
    if (G == 0x7fffffff) GRID_SYNC();
    GRID_BAR();
    p1_hn(p);
    GRID_BAR();
    {   pg8::Gemm g{(const bf16_t*)(ws + WS_HN), (const bf16_t*)(ws + WS_W1T), MT, 2560, 1024}; pg8::StaticOrder S; S.init(MT, 2560, G, bx);
        pg8::Epi1 E{(bf16_t*)(ws + WS_XA), (bf16_t*)(ws + WS_GA), (bf16_t*)(ws + WS_XS)};
        pg8::gemm_phase<pg8::Epi1, pg8::StaticOrder>(lds, g, S, E);
        pg8::Gemm g2{(const bf16_t*)(ws + WS_HN), (const bf16_t*)(ws + WS_W1T) + (size_t)2560 * 1024, MT, 2048, 1024}; pg8::ListOrder S2; S2.init(MT, 2048, G, bx); S2.base = bx; S2.stride = 256; S2.count = 3; S2.extra = bx >= 64 ? 768 + (bx - 64) : -1;
        pg8::EpiGate E2{GATE, PIN(34)};
        pg8::gemm_phase<pg8::EpiGate, pg8::ListOrder>(lds, g2, S2, E2); }
    GRID_BAR();
    p3_scans(p, lds);
    if (bx < 128 || bx >= 192) {
        __syncthreads();
        pg8::Gemm g2{(const bf16_t*)(ws + WS_HN), (const bf16_t*)(ws + WS_W1T) + (size_t)2560 * 1024, MT, 2048, 1024}; pg8::ListOrder S2; S2.init(MT, 2048, G, bx);
        S2.extra = -1; if (bx >= 192) { S2.base = 1088 + (bx - 192); S2.stride = 64; S2.count = 3; } else { S2.base = 960 + bx; S2.stride = 1; S2.count = 1; }
        pg8::EpiGate E2{GATE, PIN(34)};
        pg8::gemm_phase<pg8::EpiGate, pg8::ListOrder>(lds, g2, S2, E2);
    }
    GRID_BAR();
    {
        pg8::StaticOrder S; S.init(MT, 1024, G, bx);
        pg8::Gemm ga{(const bf16_t*)(ws + WS_YA), (const bf16_t*)(ws + WS_WPL), MT, 1024, 1024};
        pg8::EpiMerge<0> Ea{GATE, (bf16_t*)(ws + WS_TMP), (bf16_t*)(ws + WS_MPRE)};
        pg8::gemm_phase<pg8::EpiMerge<0>, pg8::StaticOrder>(lds, ga, S, Ea);
        pg8::Gemm g{(const bf16_t*)(ws + WS_VS), (const bf16_t*)(ws + WS_WGLU), MT, 512, 512}; pg8::StaticOrder S4; S4.init(MT, 512, G, (bx + 128) & 255);
        pg8::EpiGlu E{(const bf16_t*)(ws + WS_VS), (bf16_t*)(ws + WS_YS), PIN(30)};
        pg8::gemm_phase<pg8::EpiGlu, pg8::StaticOrder>(lds, g, S4, E); }
    GRID_BAR();
    {   pg8::StaticOrder S; S.init(MT, 1024, G, bx);
        pg8::Gemm gb{(const bf16_t*)(ws + WS_YS), (const bf16_t*)(ws + WS_WPS), MT, 1024, 512};
        pg8::EpiMerge<1> Eb{GATE, (bf16_t*)(ws + WS_TMP), (bf16_t*)(ws + WS_MPRE)};
        pg8::gemm_phase<pg8::EpiMerge<1>, pg8::StaticOrder>(lds, gb, S, Eb);
        if (bx >= 128) copy_tiles(p, lds, 3200, 3904, bx - 128, 128); }
    GRID_BAR();
    {   pg8::Gemm g{(const bf16_t*)(ws + WS_MPRE), (const bf16_t*)(ws + WS_WOUT), MT, 1024, 1024}; pg8::StaticOrder S; S.init(MT, 1024, G, bx);
        pg8::EpiOutSS E{(bf16_t*)(ws + WS_MO), (float*)(ws + WS_SSP1)};
        pg8::gemm_phase<pg8::EpiOutSS, pg8::StaticOrder>(lds, g, S, E);
        if (bx >= 128) copy_tiles(p, lds, 1792, 3200, bx - 128, 128); }
    GRID_BAR();
    p7_x1(p);
    GRID_BAR();
    {   pg8::Gemm g{(const bf16_t*)(ws + WS_HN2), (const bf16_t*)(ws + WS_WFI), MT, 2 * DFF, 1024}; pg8::StaticOrder S; S.init(MT, 2 * DFF, G, bx);
        pg8::EpiFF E{(bf16_t*)(ws + WS_HID)};
        pg8::gemm_phase<pg8::EpiFF, pg8::StaticOrder>(lds, g, S, E); }
    GRID_BAR();
    {
        pg8::Gemm g{(const bf16_t*)(ws + WS_HID), (const bf16_t*)(ws + WS_WFO), MT, 1024, DFF}; pg8::StaticOrder S; S.init(128 * 256, 1024, G, bx);
        pg8::EpiPlain E{(bf16_t*)(ws + WS_FO)};
        pg8::gemm_phase<pg8::EpiPlain, pg8::StaticOrder>(lds, g, S, E);
        const int tile = bx >> 1, kh = bx & 1;
        pg8::Gemm gh{(const bf16_t*)(ws + WS_HID) + kh * (DFF / 2), (const bf16_t*)(ws + WS_WFO) + kh * (DFF / 2), MT, 1024, DFF / 2, DFF};
        pg8::OneUnit S1{128 + (tile >> 2), tile & 3};
        pg8::EpiPlain Eh{(bf16_t*)(ws + (kh ? WS_FOB : WS_FO))};
        pg8::gemm_phase<pg8::EpiPlain, pg8::OneUnit>(lds, gh, S1, Eh); }
    GRID_BAR();
    p10_out(p);
}

extern "C" void kernel_launch(void* const* d_in, const int* in_sizes, int n_in, void* d_out, int out_size, void* d_ws, size_t ws_size, hipStream_t stream) {
    static int grid = 0;
    if (grid == 0) {
        if (n_in != 38 || (size_t)out_size != OFF_IM + 32 * 2 * 32 * 64 || ws_size < WS_END) { fprintf(stderr, "kernel_launch: unexpected shapes (n_in %d out %d ws %zu)\n", n_in, out_size, ws_size); grid = -1; return; }
        int dev = 0, cus = 0, per_cu = 0;
        hipGetDevice(&dev); hipDeviceGetAttribute(&cus, hipDeviceAttributeMultiprocessorCount, dev);
        if (hipFuncSetAttribute((const void*)fwd_mega, hipFuncAttributeMaxDynamicSharedMemorySize, LDS_BYTES) != hipSuccess) { fprintf(stderr, "kernel_launch: hipFuncSetAttribute failed\n"); grid = -1; return; }
        if (hipOccupancyMaxActiveBlocksPerMultiprocessor(&per_cu, (const void*)fwd_mega, 512, LDS_BYTES) != hipSuccess || per_cu < 1) { fprintf(stderr, "kernel_launch: occupancy query says %d blocks/CU\n", per_cu); grid = -1; return; }
        if (cus < 256) { fprintf(stderr, "kernel_launch: needs 256 CUs, device has %d\n", cus); grid = -1; return; }
        grid = 256;
    }
    if (grid < 0) return;
    Params p{};
    for (int i = 0; i < 38; ++i) p.in[i] = (const float*)d_in[i];
    p.out = (float*)d_out; p.ws = (unsigned char*)d_ws;
    if (hipMemsetAsync((char*)d_ws + 768 * 1024, 0, XCD_BAR_WORDS * 4, stream) != hipSuccess) { fprintf(stderr, "kernel_launch: hipMemsetAsync of the barrier word failed\n"); return; }
    void* args[] = {&p};
    hipError_t e = hipLaunchCooperativeKernel((const void*)fwd_mega, dim3(grid), dim3(512), args, LDS_BYTES, stream);
    if (e != hipSuccess) fprintf(stderr, "cooperative launch failed: %s\n", hipGetErrorString(e));
}
```

```cpp
#include <hip/hip_runtime.h>
#include <hip/hip_cooperative_groups.h>
#include <cstdio>
#include <cstdint>
namespace cg = cooperative_groups;

#define LAS __attribute__((address_space(3)))
typedef unsigned short bf16_t;
typedef short bf16x8 __attribute__((ext_vector_type(8)));
typedef float f32x4 __attribute__((ext_vector_type(4)));
typedef float f32x16 __attribute__((ext_vector_type(16)));
typedef float f32x2 __attribute__((ext_vector_type(2)));
typedef unsigned u32x4 __attribute__((ext_vector_type(4)));
typedef unsigned u32x2 __attribute__((ext_vector_type(2)));

constexpr int DM = 1024, MC = 8192, MS = 32768, MT = MC + MS;
constexpr int NB_CTX = 32, T_CTX = 256, NB_S = 8, T_S = 4096;
constexpr int DFF = 2816, DS5 = 512;
constexpr float EPS = 1e-6f;
constexpr size_t OFF_LRU = (size_t)MT * DM, OFF_RE = OFF_LRU + 32 * 2 * 1024, OFF_IM = OFF_RE + 32 * 2 * 32 * 64;
constexpr size_t MiB = 1u << 20;
constexpr size_t WS_MOD = 512 * 1024;
constexpr size_t WS_W1T = 1 * MiB, WS_WPL = 10 * MiB, WS_WPS = 12 * MiB, WS_WOUT = 13 * MiB, WS_WFI = 15 * MiB, WS_WFO = 26 * MiB, WS_WGLU = 31 * MiB + 512 * 1024;
constexpr size_t WS_HN = 32 * MiB, WS_XA = 112 * MiB, WS_XS = 192 * MiB, WS_VS = 232 * MiB, WS_YA = 272 * MiB, WS_GA = 352 * MiB, WS_SSP1 = 432 * MiB, WS_SSP2 = 435 * MiB, WS_X1A = 252 * MiB  , WS_X1B = 438 * MiB  , WS_END = 498 * MiB;
constexpr size_t WS_TMP = WS_HN, WS_MPRE = WS_GA, WS_MO = WS_HN, WS_HN2 = WS_GA, WS_HID = WS_HN, WS_FO = WS_YA, WS_FOB = WS_GA, WS_YS = WS_XS;
constexpr int LDS_BYTES = 147456;

struct Params { const float* in[38]; float* out; unsigned char* ws; };
struct Ctx { const LAS unsigned long long* tbl; float* out; unsigned char* ws; };
__device__ __forceinline__ const float* inp_(const LAS unsigned long long* tbl, int i) { const unsigned long long v = tbl[i];
    const unsigned lo = __builtin_amdgcn_readfirstlane((unsigned)v), hi = __builtin_amdgcn_readfirstlane((unsigned)(v >> 32)); return (const float*)(const __attribute__((address_space(1))) float*)(((unsigned long long)hi << 32) | lo); }
#define PIN(i) inp_(p.tbl, (i))

__device__ __forceinline__ unsigned f2bf(float f) { unsigned u = __builtin_bit_cast(unsigned, f); return (u + 0x7fffu + ((u >> 16) & 1u)) >> 16; }
__device__ __forceinline__ unsigned pk2(float lo, float hi) { unsigned r; asm volatile("s_nop 1\n\tv_cvt_pk_bf16_f32 %0, %1, %2" : "=v"(r) : "v"(lo), "v"(hi)); return r; }
__device__ __forceinline__ bf16_t f2bf1(float x) { return (bf16_t)(pk2(x, 0.f) & 0xffffu); }
__device__ __forceinline__ float bf_lo(unsigned w) { return __builtin_bit_cast(float, w << 16); }
__device__ __forceinline__ float bf_hi(unsigned w) { return __builtin_bit_cast(float, w & 0xffff0000u); }
__device__ __forceinline__ float bf2f(bf16_t h) { return __builtin_bit_cast(float, ((unsigned)h) << 16); }
__device__ __forceinline__ float sigmoidf_(float x) { return __builtin_amdgcn_rcpf(1.0f + __builtin_amdgcn_exp2f(-1.44269504089f * x)); }
__device__ __forceinline__ float siluf_(float x) { return x * sigmoidf_(x); }
__device__ __forceinline__ float gelu_tanh(float x) { const float u = x + 0.044715f * x * x * x; return x * __builtin_amdgcn_rcpf(1.0f + __builtin_amdgcn_exp2f(-2.30220819f * u)); }
__device__ __forceinline__ const float* xrow(const Ctx p, int r) { return r < MC ? PIN(0) + (size_t)r * DM : PIN(1) + (size_t)(r - MC) * DM; }
__device__ __forceinline__ int mod_index(int r) { return r < MC ? 0 : 1 + ((r - MC) >> 12); }
namespace pg8 {
#define PG8_LAS __attribute__((address_space(3)))
constexpr int BM = 256, BK = 64, HALF = 128, HTB = HALF * BK * 2  , STAGE_BYTES = 8 * HTB, NXCD = 8, WGM = 8;
__host__ __device__ __forceinline__ int lds_byte(int r, int c) { const int st = (r >> 4) * 2 + (c >> 5), rr = r & 15, cc = c & 31, ob = rr * 64 + cc * 2; return st * 1024 + (ob ^ (((ob >> 9) & 1) << 5)); }
__host__ __device__ __forceinline__ void stage_rc(int b, int& R, int& C) { const int st = b / 1024, sb = b % 1024, swz = sb ^ (((sb >> 9) & 1) << 5); R = (st >> 1) * 16 + swz / 64; C = (st & 1) * 32 + (swz % 64) / 2; }
__host__ __device__ __forceinline__ int perm32(int rho) { const int n = rho >> 4, i = rho & 15; return 8 * (i >> 2) + 4 * n + (i & 3); }
struct Unit { int pm, pn; };
struct Gemm { const bf16_t* A; const bf16_t* Bt; int M, N, K; int ld = 0; };
struct StaticOrder {
    int nM, nN, nwg, G, c;
    __host__ __device__ void init(int M, int N, int G_, int c_) { nM = M / BM; nN = N / BM; nwg = nM * nN; G = G_; c = c_; }
    __host__ __device__ bool next(int i, Unit& u) const {
        const long L = (long)i * G + c; if (L >= nwg) return false;
        int wgid = (int)L; { const int q = nwg / NXCD, r = nwg % NXCD, xcd = wgid % NXCD, off = wgid / NXCD; wgid = (xcd < r ? xcd * (q + 1) : r * (q + 1) + (xcd - r) * q) + off; }
        const int nig = WGM * nN, gid = wgid / nig, fm = gid * WGM, gsz = (nM - fm) < WGM ? (nM - fm) : WGM;
        u.pm = fm + ((wgid % nig) % gsz); u.pn = (wgid % nig) / gsz; return true;
    }
    __device__ __forceinline__ void a_ready(const Unit&) const {}
    __device__ __forceinline__ void done(const Unit&) const {}
};
struct ListOrder : StaticOrder {
    int base, stride, count, extra;
    __host__ __device__ bool next(int i, Unit& u) const {
        if (i > count || (i == count && extra < 0)) return false;
        const long L = (i < count) ? (long)base + (long)i * stride : (long)extra; if (L >= nwg) return false;
        int wgid = (int)L; { const int q = nwg / NXCD, r = nwg % NXCD, xcd = wgid % NXCD, off = wgid / NXCD; wgid = (xcd < r ? xcd * (q + 1) : r * (q + 1) + (xcd - r) * q) + off; }
        const int nig = WGM * nN, gid = wgid / nig, fm = gid * WGM, gsz = (nM - fm) < WGM ? (nM - fm) : WGM;
        u.pm = fm + ((wgid % nig) % gsz); u.pn = (wgid % nig) / gsz; return true;
    }
};
__device__ __forceinline__ unsigned cvt_pk_bf16(float lo, float hi) { unsigned r; asm volatile("s_nop 1\n\tv_cvt_pk_bf16_f32 %0, %1, %2" : "=v"(r) : "v"(lo), "v"(hi)); return r; }
__device__ __forceinline__ u32x4 pack8(const f32x4 a, const f32x4 b) { u32x4 w; w.x = cvt_pk_bf16(a[0], a[1]); w.y = cvt_pk_bf16(a[2], a[3]); w.z = cvt_pk_bf16(b[0], b[1]); w.w = cvt_pk_bf16(b[2], b[3]); return w; }
__device__ __forceinline__ void unpack8(const u32x4 w, f32x4& a, f32x4& b) { a = (f32x4){bf_lo(w.x), bf_hi(w.x), bf_lo(w.y), bf_hi(w.y)}; b = (f32x4){bf_lo(w.z), bf_hi(w.z), bf_lo(w.w), bf_hi(w.w)}; }

#define EPI_LOOP_BEGIN \
    _Pragma("unroll") for (int ai = 0; ai < 2; ++ai) _Pragma("unroll") for (int m = 0; m < 4; ++m) { const int row = u.pm * BM + ai * HALF + wr * 64 + m * 16 + fr; \
    _Pragma("unroll") for (int bj = 0; bj < 2; ++bj) { const int ct = bj * HALF + wc * 32 + 8 * fq; f32x4 v0 = acc[ai][bj][m][0], v1 = acc[ai][bj][m][1];
#define EPI_LOOP_END } }

struct Epi1 {
    static constexpr bool PERM = true, AFTER_DRAIN = false;
    bf16_t* XA; bf16_t* GA; bf16_t* XS;
    __device__ __forceinline__ void operator()(const f32x4 (&acc)[2][2][4][2], const Unit& u, int wr, int wc, int fr, int fq) const {
        const int pn = u.pn;
        if (pn < 4) {
            EPI_LOOP_BEGIN *(u32x4*)(XA + (size_t)row * 1024 + pn * 256 + ct) = pack8(v0, v1); EPI_LOOP_END
        } else if (pn < 8) {
            EPI_LOOP_BEGIN
#pragma unroll
                for (int j = 0; j < 4; ++j) { v0[j] = gelu_tanh(v0[j]); v1[j] = gelu_tanh(v1[j]); }
                *(u32x4*)(GA + (size_t)row * 1024 + (pn - 4) * 256 + ct) = pack8(v0, v1); EPI_LOOP_END
        } else {
            EPI_LOOP_BEGIN *(u32x4*)(XS + (size_t)row * 512 + (pn - 8) * 256 + ct) = pack8(v0, v1); EPI_LOOP_END
        }
    }
};
struct EpiGate {
    static constexpr bool PERM = true, AFTER_DRAIN = false;
    bf16_t* GATE; const float* bgate;
    __device__ __forceinline__ void operator()(const f32x4 (&acc)[2][2][4][2], const Unit& u, int wr, int wc, int fr, int fq) const {
        const int cb = u.pn * 256;
#pragma unroll
        for (int bj = 0; bj < 2; ++bj) { const int ct = bj * HALF + wc * 32 + 8 * fq;
            const f32x4 b0 = *(const f32x4*)(bgate + cb + ct), b1 = *(const f32x4*)(bgate + cb + ct + 4);
#pragma unroll
            for (int ai = 0; ai < 2; ++ai)
#pragma unroll
                for (int m = 0; m < 4; ++m) { const int row = u.pm * BM + ai * HALF + wr * 64 + m * 16 + fr; f32x4 v0 = acc[ai][bj][m][0], v1 = acc[ai][bj][m][1];
#pragma unroll
                    for (int j = 0; j < 4; ++j) { v0[j] = 1.0f - sigmoidf_(-(v0[j] + b0[j])); v1[j] = 1.0f - sigmoidf_(-(v1[j] + b1[j])); }
                    *(u32x4*)(GATE + (size_t)row * 2048 + cb + ct) = pack8(v0, v1); } }
    }
};
struct EpiGlu {
    static constexpr bool PERM = true, AFTER_DRAIN = false;
    const bf16_t* VS; bf16_t* YS; const float* bglu;
    __device__ __forceinline__ void operator()(const f32x4 (&acc)[2][2][4][2], const Unit& u, int wr, int wc, int fr, int fq) const {
        const int cb = u.pn * 256;
        f32x4 bb[2][2];
#pragma unroll
        for (int bj = 0; bj < 2; ++bj) { const int ct = bj * HALF + wc * 32 + 8 * fq; bb[bj][0] = *(const f32x4*)(bglu + cb + ct); bb[bj][1] = *(const f32x4*)(bglu + cb + ct + 4); }
#pragma unroll
        for (int ai = 0; ai < 2; ++ai) { u32x4 sv[4][2];
#pragma unroll
            for (int m = 0; m < 4; ++m)
#pragma unroll
                for (int bj = 0; bj < 2; ++bj) sv[m][bj] = *(const u32x4*)(VS + (size_t)(u.pm * BM + ai * HALF + wr * 64 + m * 16 + fr) * 512 + cb + bj * HALF + wc * 32 + 8 * fq);
            asm volatile("s_waitcnt vmcnt(0)" ::: "memory");
#pragma unroll
            for (int m = 0; m < 4; ++m)
#pragma unroll
                for (int bj = 0; bj < 2; ++bj) { const int row = u.pm * BM + ai * HALF + wr * 64 + m * 16 + fr, ct = bj * HALF + wc * 32 + 8 * fq; f32x4 v0 = acc[ai][bj][m][0], v1 = acc[ai][bj][m][1], s0, s1; unpack8(sv[m][bj], s0, s1);
#pragma unroll
                    for (int j = 0; j < 4; ++j) { v0[j] = s0[j] * sigmoidf_(v0[j] + bb[bj][0][j]); v1[j] = s1[j] * sigmoidf_(v1[j] + bb[bj][1][j]); }
                    *(u32x4*)(YS + (size_t)row * 512 + cb + ct) = pack8(v0, v1); } }
    }
};
template <int STEP> struct EpiMerge {
    static constexpr bool PERM = true, AFTER_DRAIN = false;
    const bf16_t* GATE; bf16_t* TMP; bf16_t* MPRE;
    __device__ __forceinline__ void operator()(const f32x4 (&acc)[2][2][4][2], const Unit& u, int wr, int wc, int fr, int fq) const {
        const int cb = u.pn * 256;
#pragma unroll
        for (int ai = 0; ai < 2; ++ai) { u32x4 gv[4][2], tv[4][2];
#pragma unroll
            for (int m = 0; m < 4; ++m)
#pragma unroll
                for (int bj = 0; bj < 2; ++bj) { const size_t row = (size_t)(u.pm * BM + ai * HALF + wr * 64 + m * 16 + fr); const int ct = bj * HALF + wc * 32 + 8 * fq;
                    gv[m][bj] = *(const u32x4*)(GATE + row * 2048 + STEP * 1024 + cb + ct); if (STEP == 1) tv[m][bj] = *(const u32x4*)(TMP + row * 1024 + cb + ct); }
            asm volatile("s_waitcnt vmcnt(0)" ::: "memory");
#pragma unroll
            for (int m = 0; m < 4; ++m)
#pragma unroll
                for (int bj = 0; bj < 2; ++bj) { const size_t row = (size_t)(u.pm * BM + ai * HALF + wr * 64 + m * 16 + fr); const int ct = bj * HALF + wc * 32 + 8 * fq;
                    const f32x4 v0 = acc[ai][bj][m][0], v1 = acc[ai][bj][m][1]; f32x4 g0, g1; unpack8(gv[m][bj], g0, g1);
                    if (STEP == 0) { *(u32x4*)(TMP + row * 1024 + cb + ct) = pack8(g0 * v0, g1 * v1); }
                    else { f32x4 t0, t1; unpack8(tv[m][bj], t0, t1); *(u32x4*)(MPRE + row * 1024 + cb + ct) = pack8(t0 + g0 * v0, t1 + g1 * v1); } } }
    }
};
struct EpiOutSS {
    static constexpr bool PERM = true, AFTER_DRAIN = false;
    bf16_t* O; float* rowss;
    __device__ __forceinline__ void operator()(const f32x4 (&acc)[2][2][4][2], const Unit& u, int wr, int wc, int fr, int fq) const {
        const int cb = u.pn * 256;
#pragma unroll
        for (int ai = 0; ai < 2; ++ai)
#pragma unroll
            for (int m = 0; m < 4; ++m) { const int row = u.pm * BM + ai * HALF + wr * 64 + m * 16 + fr; float ss = 0.f;
#pragma unroll
                for (int bj = 0; bj < 2; ++bj) { const int ct = bj * HALF + wc * 32 + 8 * fq; const f32x4 v0 = acc[ai][bj][m][0], v1 = acc[ai][bj][m][1];
                    ss += (v0[0] * v0[0] + v0[1] * v0[1]) + (v0[2] * v0[2] + v0[3] * v0[3]) + (v1[0] * v1[0] + v1[1] * v1[1]) + (v1[2] * v1[2] + v1[3] * v1[3]);
                    *(u32x4*)(O + (size_t)row * 1024 + cb + ct) = pack8(v0, v1); }
                ss += __shfl_xor(ss, 16); ss += __shfl_xor(ss, 32);
                if (fq == 0) rowss[((size_t)u.pn * MT + row) * 4 + wc] = ss; }
    }
};
struct EpiPlain {
    static constexpr bool PERM = true, AFTER_DRAIN = false;
    bf16_t* O;
    __device__ __forceinline__ void operator()(const f32x4 (&acc)[2][2][4][2], const Unit& u, int wr, int wc, int fr, int fq) const {
        const int cb = u.pn * 256;
        EPI_LOOP_BEGIN *(u32x4*)(O + (size_t)row * 1024 + cb + ct) = pack8(v0, v1); EPI_LOOP_END
    }
};
struct OneUnit { int pm, pn;
    __device__ __forceinline__ bool next(int i, Unit& u) const { if (i) return false; u.pm = pm; u.pn = pn; return true; }
    __device__ __forceinline__ void a_ready(const Unit&) const {}
    __device__ __forceinline__ void done(const Unit&) const {} };
struct EpiFF {
    static constexpr bool PERM = true, AFTER_DRAIN = false;
    bf16_t* HID;
    __device__ __forceinline__ void operator()(const f32x4 (&acc)[2][2][4][2], const Unit& u, int wr, int wc, int fr, int fq) const {
#pragma unroll
        for (int ai = 0; ai < 2; ++ai)
#pragma unroll
            for (int m = 0; m < 4; ++m) { const int row = u.pm * BM + ai * HALF + wr * 64 + m * 16 + fr;
                f32x4 a0 = acc[ai][0][m][0], a1 = acc[ai][0][m][1]; const f32x4 g0 = acc[ai][1][m][0], g1 = acc[ai][1][m][1];
#pragma unroll
                for (int j = 0; j < 4; ++j) { a0[j] = siluf_(a0[j]) * g0[j]; a1[j] = siluf_(a1[j]) * g1[j]; }
                *(u32x4*)(HID + (size_t)row * DFF + u.pn * 128 + wc * 32 + 8 * fq) = pack8(a0, a1); }
    }
};
template <class Epi, class Sched>
__device__ __forceinline__ void gemm_phase(PG8_LAS unsigned char* lds, const Gemm g, const Sched& S, const Epi& E) {
    int tid_ = threadIdx.x; asm volatile("" : "+v"(tid_));
    const int tid = tid_, wid = __builtin_amdgcn_readfirstlane(tid >> 6), lane = tid & 63, wr = wid >> 2, wc = wid & 3, fr = lane & 15, fq = lane >> 4;
    const int K = g.K, nt = K / BK, LD = g.ld ? g.ld : g.K;
    unsigned voffA[2], voffB[2];
#pragma unroll
    for (int i = 0; i < 2; ++i) { int R, C; stage_rc(tid * 16 + i * 8192, R, C); const int Rb = Epi::PERM ? ((R & ~31) + perm32(R & 31)) : R;
        voffA[i] = (unsigned)(R * LD + C) * 2u; voffB[i] = (unsigned)(Rb * LD + C) * 2u; }
    const size_t kstep = (size_t)(BK * 2);
    const size_t hstep = (size_t)HALF * LD * 2;
    const size_t tstep = 2 * hstep;
    const unsigned ldsw = (unsigned)wid * 1024u;
    const int aoff = lds_byte(wr * 64 + fr, fq * 8), boff = lds_byte(wc * 32 + fr, fq * 8);
#define PG8_SA(b, h) (((b) * 2 + (h)) * HTB)
#define PG8_SB(b, h) ((4 + (b) * 2 + (h)) * HTB)
#define PG8_STAGE(bufoff, gbase, voff) do { _Pragma("unroll") for (int _i = 0; _i < 2; ++_i) \
        __builtin_amdgcn_global_load_lds((const unsigned*)((const char*)(gbase) + (voff)[_i]), (PG8_LAS unsigned*)(lds + (bufoff) + ldsw + _i * 8192), 16, 0, 0); } while (0)
#define PG8_LDA(dst, b, h) do { _Pragma("unroll") for (int m = 0; m < 4; ++m) _Pragma("unroll") for (int k = 0; k < 2; ++k) dst[m][k] = *(const PG8_LAS bf16x8*)(lds + PG8_SA(b, h) + aoff + m * 2048 + k * 1024); } while (0)
#define PG8_LDB(dst, b, h) do { _Pragma("unroll") for (int n = 0; n < 2; ++n) _Pragma("unroll") for (int k = 0; k < 2; ++k) dst[n][k] = *(const PG8_LAS bf16x8*)(lds + PG8_SB(b, h) + boff + n * 2048 + k * 1024); } while (0)
#define PG8_MMA(ai, bj, At, Bt) do { __builtin_amdgcn_s_setprio(1); _Pragma("unroll") for (int m = 0; m < 4; ++m) _Pragma("unroll") for (int n = 0; n < 2; ++n) _Pragma("unroll") for (int k = 0; k < 2; ++k) \
        acc[ai][bj][m][n] = __builtin_amdgcn_mfma_f32_16x16x32_bf16(Bt[n][k], At[m][k], acc[ai][bj][m][n], 0, 0, 0); __builtin_amdgcn_s_setprio(0); } while (0)
#define PG8_WAIT_V(n) asm volatile("s_waitcnt vmcnt(" #n ")" ::: "memory")
#define PG8_WAIT_L(n) asm volatile("s_waitcnt lgkmcnt(" #n ")" ::: "memory")
#define PG8_BAR __builtin_amdgcn_s_barrier()
#define PG8_SCHED __builtin_amdgcn_sched_barrier(0)
    Unit cur, nxt; int ui = 0;
    if (!S.next(0, cur)) return;
    f32x4 acc[2][2][4][2];
#pragma unroll
    for (int a = 0; a < 2; ++a)
#pragma unroll
        for (int b = 0; b < 2; ++b)
#pragma unroll
            for (int m = 0; m < 4; ++m)
#pragma unroll
                for (int n = 0; n < 2; ++n) acc[a][b][m][n] = (f32x4){0.f, 0.f, 0.f, 0.f};
    bf16x8 At[4][2], B0[2][2], B1[2][2];
    const char* cA = (const char*)g.A + (size_t)cur.pm * tstep; const char* cB = (const char*)g.Bt + (size_t)cur.pn * tstep;
    S.a_ready(cur);
    PG8_STAGE(PG8_SB(0, 0), cB, voffB); PG8_STAGE(PG8_SA(0, 0), cA, voffA); PG8_STAGE(PG8_SB(0, 1), cB + hstep, voffB); PG8_STAGE(PG8_SA(0, 1), cA + hstep, voffA);
    if (wr == 1) PG8_BAR;
    PG8_WAIT_V(4); PG8_BAR;
    PG8_STAGE(PG8_SB(1, 0), cB + kstep, voffB); PG8_STAGE(PG8_SA(1, 0), cA + kstep, voffA); PG8_STAGE(PG8_SB(1, 1), cB + hstep + kstep, voffB);
    PG8_WAIT_V(6); PG8_BAR;
    for (;;) {
        const bool has_next = S.next(ui + 1, nxt);
        const char* nA = has_next ? (const char*)g.A + (size_t)nxt.pm * tstep : cA; const char* nB = has_next ? (const char*)g.Bt + (size_t)nxt.pn * tstep : cB;
        for (int t = 0; t < nt; t += 2) {
            const bool last = (t == nt - 2);
            const char* a1 = cA + (size_t)(t + 1) * kstep;
            const char* a2 = last ? nA : cA + (size_t)(t + 2) * kstep; const char* b2 = last ? nB : cB + (size_t)(t + 2) * kstep;
            const char* a3 = a2 + kstep; const char* b3 = b2 + kstep;
            if (last && has_next) S.a_ready(nxt);
            PG8_LDB(B0, 0, 0); PG8_SCHED; PG8_LDA(At, 0, 0); PG8_STAGE(PG8_SA(1, 1), a1 + hstep, voffA);
            PG8_WAIT_L(8); PG8_BAR; PG8_WAIT_L(0); PG8_MMA(0, 0, At, B0); PG8_BAR; PG8_SCHED;
            PG8_LDB(B1, 0, 1); PG8_STAGE(PG8_SB(0, 0), b2, voffB);
            PG8_BAR; PG8_WAIT_L(0); PG8_MMA(0, 1, At, B1); PG8_BAR;
            PG8_LDA(At, 0, 1); PG8_STAGE(PG8_SA(0, 0), a2, voffA);
            PG8_BAR; PG8_WAIT_L(0); PG8_MMA(1, 0, At, B0); PG8_BAR; PG8_SCHED;
            PG8_STAGE(PG8_SB(0, 1), b2 + hstep, voffB);
            PG8_WAIT_V(6); PG8_BAR; PG8_MMA(1, 1, At, B1); PG8_BAR;
            PG8_LDB(B0, 1, 0); PG8_SCHED; PG8_LDA(At, 1, 0); PG8_STAGE(PG8_SA(0, 1), a2 + hstep, voffA);
            PG8_WAIT_L(8); PG8_BAR; PG8_WAIT_L(0); PG8_MMA(0, 0, At, B0); PG8_BAR; PG8_SCHED;
            PG8_LDB(B1, 1, 1); PG8_STAGE(PG8_SB(1, 0), b3, voffB);
            PG8_BAR; PG8_WAIT_L(0); PG8_MMA(0, 1, At, B1); PG8_BAR;
            PG8_LDA(At, 1, 1); PG8_STAGE(PG8_SA(1, 0), a3, voffA);
            PG8_BAR; PG8_WAIT_L(0); PG8_MMA(1, 0, At, B0); PG8_BAR; PG8_SCHED;
            PG8_STAGE(PG8_SB(1, 1), b3 + hstep, voffB);
            PG8_WAIT_V(6); PG8_BAR; PG8_MMA(1, 1, At, B1); PG8_BAR;
        }
        if constexpr (!Epi::AFTER_DRAIN) { E(acc, cur, wr, wc, fr, fq); S.done(cur); }
        if (!has_next) break;
#pragma unroll
        for (int a = 0; a < 2; ++a)
#pragma unroll
            for (int b = 0; b < 2; ++b)
#pragma unroll
                for (int m = 0; m < 4; ++m)
#pragma unroll
                    for (int n = 0; n < 2; ++n) acc[a][b][m][n] = (f32x4){0.f, 0.f, 0.f, 0.f};
        cur = nxt; cA = nA; cB = nB; ++ui;
    }
    PG8_WAIT_V(0);
    if (wr == 0) PG8_BAR;
    PG8_BAR;
    if constexpr (Epi::AFTER_DRAIN) { E.fused(acc, cur, wr, wc, fr, fq, lds, wid, lane); S.done(cur); }
#undef PG8_SA
#undef PG8_SB
#undef PG8_STAGE
#undef PG8_LDA
#undef PG8_LDB
#undef PG8_MMA
#undef PG8_WAIT_V
#undef PG8_WAIT_L
#undef PG8_BAR
#undef PG8_SCHED
}
}

__device__ __forceinline__ int ffin_row(int n) { const int half = n >= DFF, j = half ? n - DFF : n; return (j >> 7) * 256 + half * 128 + (j & 127); }
__device__ __forceinline__ void copy_tiles(const Ctx p, LAS unsigned char* lds, int tbeg, int tend, int first, int stride) {
    int tid_ = threadIdx.x; asm volatile("" : "+v"(tid_)); const int tid = tid_;
    unsigned char* ws = p.ws;
    LAS float* tile = (LAS float*)lds;
    const float* src; bf16_t* dst; int K, N, k0, n0; bool perm;
#define TILE_INFO(T) do { int t_ = (T), tk_; \
        if (t_ < 640) { src = PIN(13); K = 1024; N = 2560; dst = (bf16_t*)(ws + WS_W1T); perm = false; } \
        else if (t_ < 1152) { t_ -= 640; src = PIN(33); K = 1024; N = 2048; dst = (bf16_t*)(ws + WS_W1T) + (size_t)2560 * 1024; perm = false; } \
        else if (t_ < 1408) { t_ -= 1152; src = PIN(31); K = 1024; N = 1024; dst = (bf16_t*)(ws + WS_WPL); perm = false; } \
        else if (t_ < 1536) { t_ -= 1408; src = PIN(32); K = 512; N = 1024; dst = (bf16_t*)(ws + WS_WPS); perm = false; } \
        else if (t_ < 1792) { t_ -= 1536; src = PIN(35); K = 1024; N = 1024; dst = (bf16_t*)(ws + WS_WOUT); perm = false; } \
        else if (t_ < 3200) { t_ -= 1792; src = PIN(36); K = 1024; N = 2 * DFF; dst = (bf16_t*)(ws + WS_WFI); perm = true; } \
        else if (t_ < 3904) { t_ -= 3200; src = PIN(37); K = DFF; N = 1024; dst = (bf16_t*)(ws + WS_WFO); perm = false; } \
        else { t_ -= 3904; src = PIN(29); K = 512; N = 512; dst = (bf16_t*)(ws + WS_WGLU); perm = false; } \
        tk_ = K / 64; k0 = (t_ % tk_) * 64; n0 = (t_ / tk_) * 64; } while (0)
    {   const int r = tid >> 4, c4 = tid & 15, n = tid >> 3, kc = tid & 7;
        f32x4 v0, v1; int T = tbeg + first;
        if (T < tend) { TILE_INFO(T); v0 = __builtin_nontemporal_load((const f32x4*)(src + (size_t)(k0 + r) * N + n0 + 4 * c4)); v1 = __builtin_nontemporal_load((const f32x4*)(src + (size_t)(k0 + r + 32) * N + n0 + 4 * c4)); }
        for (; T < tend; T += stride) {
            TILE_INFO(T);
            bf16_t* const cdst = dst; const int cK = K, ck0 = k0, cdrow = perm ? ffin_row(n0 + n) : n0 + n;
            {   LAS float* t = tile + r * 65 + 4 * c4; t[0] = v0[0]; t[1] = v0[1]; t[2] = v0[2]; t[3] = v0[3]; t += 32 * 65; t[0] = v1[0]; t[1] = v1[1]; t[2] = v1[2]; t[3] = v1[3]; }
            __syncthreads();
            if (T + stride < tend) { TILE_INFO(T + stride); v0 = __builtin_nontemporal_load((const f32x4*)(src + (size_t)(k0 + r) * N + n0 + 4 * c4)); v1 = __builtin_nontemporal_load((const f32x4*)(src + (size_t)(k0 + r + 32) * N + n0 + 4 * c4)); }
            {   const LAS float* t = tile + (8 * kc) * 65 + n; u32x4 w;
                w.x = pk2(t[0], t[65]); w.y = pk2(t[130], t[195]); w.z = pk2(t[260], t[325]); w.w = pk2(t[390], t[455]);
                *(u32x4*)(cdst + (size_t)cdrow * cK + ck0 + 8 * kc) = w; }
            __syncthreads();
        }
    }
#undef TILE_INFO
}
__device__ __forceinline__ void p0_prologue(const Ctx p, LAS unsigned char* lds) {
    const int tid = threadIdx.x, G = gridDim.x, bx = blockIdx.x;
    unsigned char* ws = p.ws;
    if (bx >= G - 96) {
        const int item = bx - (G - 96), n0 = item * 64, w = tid >> 6, lane = tid & 63;
        LAS float* sc = (LAS float*)lds;
        LAS float* red = (LAS float*)(lds + 9 * 1024 * 4);
        for (int i = tid; i < 9 * 1024; i += 512) { const int j = i >> 10, k = i & 1023; const float v = j == 0 ? PIN(6)[k] : PIN(2)[(j - 1) * 1024 + k]; sc[i] = siluf_(v); }
        __syncthreads();
        float a[9];
#pragma unroll
        for (int j = 0; j < 9; ++j) a[j] = 0.f;
        const float* wm = PIN(7) + n0 + lane;
#pragma unroll 16
        for (int k = 128 * w; k < 128 * w + 128; ++k) { const float wv = __builtin_nontemporal_load(wm + (size_t)k * 6144);
#pragma unroll
            for (int j = 0; j < 9; ++j) a[j] += sc[j * 1024 + k] * wv; }
#pragma unroll
        for (int j = 0; j < 9; ++j) red[(w * 9 + j) * 64 + lane] = a[j];
        __syncthreads();
        for (int i = tid; i < 9 * 64; i += 512) { const int j = i >> 6, l = i & 63; float s = PIN(8)[n0 + l];
#pragma unroll
            for (int ww = 0; ww < 8; ++ww) s += red[(ww * 9 + j) * 64 + l];
            ((float*)(ws + WS_MOD))[j * 6144 + n0 + l] = s; }
        __syncthreads();
    }
    if (bx < G - 96) copy_tiles(p, lds, 0, 1568, bx, G - 96);
    else { copy_tiles(p, lds, 1568, 1792, bx - (G - 96), 96); copy_tiles(p, lds, 3904, 3968, bx - (G - 96), 96); }
}

#define ROW_SS(v) ((v[0][0] * v[0][0] + v[0][1] * v[0][1]) + (v[0][2] * v[0][2] + v[0][3] * v[0][3]) + (v[1][0] * v[1][0] + v[1][1] * v[1][1]) + (v[1][2] * v[1][2] + v[1][3] * v[1][3]) + \
                   (v[2][0] * v[2][0] + v[2][1] * v[2][1]) + (v[2][2] * v[2][2] + v[2][3] * v[2][3]) + (v[3][0] * v[3][0] + v[3][1] * v[3][1]) + (v[3][2] * v[3][2] + v[3][3] * v[3][3]))
__device__ __forceinline__ float wave_sum(float x) {
#pragma unroll
    for (int o = 1; o < 64; o <<= 1) x += __shfl_xor(x, o);
    return x; }
__device__ __forceinline__ f32x4 bf4(const u32x2 w) { return (f32x4){bf_lo(w.x), bf_hi(w.x), bf_lo(w.y), bf_hi(w.y)}; }
__device__ __forceinline__ bf16_t* x1_row(const Ctx p, int r) { return r < 10240 ? (bf16_t*)(p.ws + WS_X1A) + (size_t)r * 1024 : (bf16_t*)(p.ws + WS_X1B) + (size_t)(r - 10240) * 1024; }
__device__ __forceinline__ void p1_hn(const Ctx p) {
    int tid_ = threadIdx.x; asm volatile("" : "+v"(tid_)); const int tid = tid_, w = tid >> 6, lane = tid & 63, r0 = blockIdx.x * 160 + w * 20;
    bf16_t* HN = (bf16_t*)(p.ws + WS_HN);
    f32x4 gs[4], sh[4]; int cur = -1;
    for (int it = 0; it < 10; ++it) { const int r = r0 + 2 * it, mi = mod_index(r);
        if (mi != cur) { cur = mi; const float* mod = (const float*)(p.ws + WS_MOD) + mi * 6144;
#pragma unroll
            for (int j = 0; j < 4; ++j) { const int c = 4 * lane + 256 * j; gs[j] = *(const f32x4*)(PIN(9) + c) * (*(const f32x4*)(mod + 1024 + c) + 1.0f); sh[j] = *(const f32x4*)(mod + c); } }
        const float* xa = xrow(p, r); const float* xb = xrow(p, r + 1); f32x4 va[4], vb[4];
#pragma unroll
        for (int j = 0; j < 4; ++j) { va[j] = __builtin_nontemporal_load((const f32x4*)(xa + 4 * lane + 256 * j)); vb[j] = __builtin_nontemporal_load((const f32x4*)(xb + 4 * lane + 256 * j)); }
        const float ra = __builtin_amdgcn_rsqf(wave_sum(ROW_SS(va)) * (1.0f / 1024.0f) + EPS), rb = __builtin_amdgcn_rsqf(wave_sum(ROW_SS(vb)) * (1.0f / 1024.0f) + EPS);
#pragma unroll
        for (int j = 0; j < 4; ++j) { const f32x4 ya = va[j] * ra * gs[j] + sh[j], yb = vb[j] * rb * gs[j] + sh[j]; u32x2 oa, ob; oa.x = pk2(ya[0], ya[1]); oa.y = pk2(ya[2], ya[3]); ob.x = pk2(yb[0], yb[1]); ob.y = pk2(yb[2], yb[3]);
            *(u32x2*)(HN + (size_t)r * 1024 + 4 * lane + 256 * j) = oa; *(u32x2*)(HN + (size_t)(r + 1) * 1024 + 4 * lane + 256 * j) = ob; }
    }
}
__device__ __forceinline__ float row_rs(const float* ssp, int r, int lane) { float q = ssp[((size_t)((lane >> 2) & 3) * MT + r) * 4 + (lane & 3)]; q += __shfl_xor(q, 1); q += __shfl_xor(q, 2); q += __shfl_xor(q, 4); q += __shfl_xor(q, 8);
    return __builtin_amdgcn_rsqf(q * (1.0f / 1024.0f) + EPS); }
__device__ __forceinline__ void p7_x1(const Ctx p) {
    int tid_ = threadIdx.x; asm volatile("" : "+v"(tid_)); const int tid = tid_, w = tid >> 6, lane = tid & 63, r0 = blockIdx.x * 160 + w * 20;
    const bf16_t* MO = (const bf16_t*)(p.ws + WS_MO); bf16_t* HN2 = (bf16_t*)(p.ws + WS_HN2); const float* ss1 = (const float*)(p.ws + WS_SSP1);
    f32x4 gg[4], gs[4], sh[4]; int cur = -1;
    for (int it = 0; it < 10; ++it) { const int r = r0 + 2 * it, mi = mod_index(r);
        if (mi != cur) { cur = mi; const float* mod = (const float*)(p.ws + WS_MOD) + mi * 6144;
#pragma unroll
            for (int j = 0; j < 4; ++j) { const int c = 4 * lane + 256 * j; gg[j] = *(const f32x4*)(mod + 2048 + c) * *(const f32x4*)(PIN(10) + c);
                gs[j] = *(const f32x4*)(PIN(11) + c) * (*(const f32x4*)(mod + 4096 + c) + 1.0f); sh[j] = *(const f32x4*)(mod + 3072 + c); } }
        const float* xa = xrow(p, r); const float* xb = xrow(p, r + 1); f32x4 va[4], vb[4]; u32x2 ma[4], mb[4];
#pragma unroll
        for (int j = 0; j < 4; ++j) { const int c = 4 * lane + 256 * j; va[j] = __builtin_nontemporal_load((const f32x4*)(xa + c)); vb[j] = __builtin_nontemporal_load((const f32x4*)(xb + c)); ma[j] = *(const u32x2*)(MO + (size_t)r * 1024 + c); mb[j] = *(const u32x2*)(MO + (size_t)(r + 1) * 1024 + c); }
        const float sa = row_rs(ss1, r, lane), sb = row_rs(ss1, r + 1, lane);
#pragma unroll
        for (int j = 0; j < 4; ++j) { const int c = 4 * lane + 256 * j; va[j] = va[j] + gg[j] * bf4(ma[j]) * sa; vb[j] = vb[j] + gg[j] * bf4(mb[j]) * sb;
            { u32x2 oa, ob; oa.x = pk2(va[j][0], va[j][1]); oa.y = pk2(va[j][2], va[j][3]); ob.x = pk2(vb[j][0], vb[j][1]); ob.y = pk2(vb[j][2], vb[j][3]); __builtin_nontemporal_store(oa, (u32x2*)(x1_row(p, r) + c)); __builtin_nontemporal_store(ob, (u32x2*)(x1_row(p, r + 1) + c)); } }
        const float ra = __builtin_amdgcn_rsqf(wave_sum(ROW_SS(va)) * (1.0f / 1024.0f) + EPS), rb = __builtin_amdgcn_rsqf(wave_sum(ROW_SS(vb)) * (1.0f / 1024.0f) + EPS);
#pragma unroll
        for (int j = 0; j < 4; ++j) { const f32x4 ya = va[j] * ra * gs[j] + sh[j], yb = vb[j] * rb * gs[j] + sh[j]; u32x2 oa, ob; oa.x = pk2(ya[0], ya[1]); oa.y = pk2(ya[2], ya[3]); ob.x = pk2(yb[0], yb[1]); ob.y = pk2(yb[2], yb[3]);
            *(u32x2*)(HN2 + (size_t)r * 1024 + 4 * lane + 256 * j) = oa; *(u32x2*)(HN2 + (size_t)(r + 1) * 1024 + 4 * lane + 256 * j) = ob; }
    }
}
__device__ __forceinline__ void p10_out(const Ctx p) {
    int tid_ = threadIdx.x; asm volatile("" : "+v"(tid_)); const int tid = tid_, w = tid >> 6, lane = tid & 63, r0 = blockIdx.x * 160 + w * 20;
    const bf16_t* FO = (const bf16_t*)(p.ws + WS_FO); const bf16_t* FOB = (const bf16_t*)(p.ws + WS_FOB);
    f32x4 gg[4]; int cur = -1;
    for (int it = 0; it < 10; ++it) { const int r = r0 + 2 * it, mi = mod_index(r); const bool split = r >= 128 * 256;
        if (mi != cur) { cur = mi; const float* mod = (const float*)(p.ws + WS_MOD) + mi * 6144;
#pragma unroll
            for (int j = 0; j < 4; ++j) { const int c = 4 * lane + 256 * j; gg[j] = *(const f32x4*)(mod + 5120 + c) * *(const f32x4*)(PIN(12) + c); } }
        f32x4 va[4], vb[4], fa[4], fb[4];
#pragma unroll
        for (int j = 0; j < 4; ++j) { const int c = 4 * lane + 256 * j; va[j] = bf4(__builtin_nontemporal_load((const u32x2*)(x1_row(p, r) + c))); vb[j] = bf4(__builtin_nontemporal_load((const u32x2*)(x1_row(p, r + 1) + c)));
            fa[j] = bf4(*(const u32x2*)(FO + (size_t)r * 1024 + c)); fb[j] = bf4(*(const u32x2*)(FO + (size_t)(r + 1) * 1024 + c));
            if (split) { fa[j] = fa[j] + bf4(*(const u32x2*)(FOB + (size_t)r * 1024 + c)); fb[j] = fb[j] + bf4(*(const u32x2*)(FOB + (size_t)(r + 1) * 1024 + c)); } }
        const float sa = __builtin_amdgcn_rsqf(wave_sum(ROW_SS(fa)) * (1.0f / 1024.0f) + EPS), sb = __builtin_amdgcn_rsqf(wave_sum(ROW_SS(fb)) * (1.0f / 1024.0f) + EPS);
#pragma unroll
        for (int j = 0; j < 4; ++j) { const int c = 4 * lane + 256 * j; __builtin_nontemporal_store(va[j] + gg[j] * fa[j] * sa, (f32x4*)(p.out + (size_t)r * 1024 + c)); __builtin_nontemporal_store(vb[j] + gg[j] * fb[j] * sb, (f32x4*)(p.out + (size_t)(r + 1) * 1024 + c)); }
    }
}

constexpr int LRU_U16 = 0, LRU_UB = 9216, LRU_AA = LRU_UB + 17408, LRU_AGG = LRU_AA + 17408, LRU_CAR = LRU_AGG + 2048, LRU_HALF = 46592;
__device__ __forceinline__ void lru_unit(const Ctx p, LAS unsigned char* lds, int sample, int b, int hd) {
    int tid_ = threadIdx.x; asm volatile("" : "+v"(tid_)); const int tid = tid_, d = tid >> 8, ht = tid & 255, hw = ht >> 6, lane = tid & 63;
    const int T = sample ? T_S : T_CTX, row0 = sample ? MC + b * T_S : b * T_CTX, nch = T / 64;
    LAS unsigned char* L = lds + d * LRU_HALF;
    LAS bf16_t* U16 = (LAS bf16_t*)(L + LRU_U16); LAS float* UB = (LAS float*)(L + LRU_UB); LAS float* AA = (LAS float*)(L + LRU_AA);
    LAS f32x2* AGG = (LAS f32x2*)(L + LRU_AGG); LAS float* CAR = (LAS float*)(L + LRU_CAR);
    const bf16_t* XA = (const bf16_t*)(p.ws + WS_XA); const bf16_t* GA = (const bf16_t*)(p.ws + WS_GA); bf16_t* YA = (bf16_t*)(p.ws + WS_YA);
    const int fj = lane & 15, fq = lane >> 4, chg = hd * 64 + 16 * hw + fj;
    bf16x8 wrf[2], wif[2];
    {   const float* wr = PIN(16) + (size_t)(d * 16 + hd) * 4096 + 16 * hw + fj; const float* wi = PIN(18) + (size_t)(d * 16 + hd) * 4096 + 16 * hw + fj;
#pragma unroll
        for (int s = 0; s < 2; ++s)
#pragma unroll
            for (int e = 0; e < 8; ++e) { const int k = 32 * s + 8 * fq + e; wrf[s][e] = (short)f2bf(wr[k * 64]); wif[s][e] = (short)f2bf(wi[k * 64]); } }
    const float br = PIN(17)[d * 1024 + chg], bi = PIN(19)[d * 1024 + chg];
    const float sp8 = -8.0f * 1.44269504089f * log1pf(__expf(-PIN(20)[d * 1024 + chg]));
    const int cp = ht & 31, tg = ht >> 5, cc0 = hd * 64 + 2 * cp;
    float cw0[4], cw1[4];
#pragma unroll
    for (int j = 0; j < 4; ++j) { cw0[j] = PIN(14)[j * 1024 + cc0]; cw1[j] = PIN(14)[j * 1024 + cc0 + 1]; }
    const float cb0 = PIN(15)[cc0], cb1 = PIN(15)[cc0 + 1];
    const int chs = hd * 64 + lane;
    if (ht < 64) CAR[lane] = sample ? PIN(3)[(size_t)(b * 2 + d) * 1024 + chs] : 0.f;
    float hfin = 0.f;
    __syncthreads();
    unsigned xw[11];
#define LRU_LOADX(kk) do { const int c_ = d ? nch - 1 - (kk) : (kk); _Pragma("unroll") for (int i = 0; i < 11; ++i) { const int t = 64 * c_ + 8 * tg - 2 + i; unsigned w = 0u; if (t >= 0 && t < T) w = *(const unsigned*)(XA + (size_t)(row0 + t) * 1024 + cc0); xw[i] = w; } } while (0)
    LRU_LOADX(0);
    for (int k = 0; k < nch; ++k) {
        const int c = d ? nch - 1 - k : k, t0 = 64 * c; const bool second = (2 * k >= nch);
        {   float x0[11], x1[11];
#pragma unroll
            for (int i = 0; i < 11; ++i) { x0[i] = bf_lo(xw[i]); x1[i] = bf_hi(xw[i]); }
#pragma unroll
            for (int i = 0; i < 8; ++i) { const float u0 = cb0 + cw0[0] * x0[i] + cw0[1] * x0[i + 1] + cw0[2] * x0[i + 2] + cw0[3] * x0[i + 3];
                const float u1 = cb1 + cw1[0] * x1[i] + cw1[1] * x1[i + 1] + cw1[2] * x1[i + 2] + cw1[3] * x1[i + 3]; const int tl = 8 * tg + i;
                *(LAS unsigned*)(U16 + tl * 72 + 2 * cp) = pk2(u0, u1); *(LAS f32x2*)(UB + tl * 68 + 2 * cp) = (f32x2){u0, u1}; } }
        if (k + 1 < nch) LRU_LOADX(k + 1);
        unsigned short hf16[16], g16[16];
        if (second) {
#pragma unroll
            for (int i = 0; i < 16; ++i) { const int pi = 16 * hw + i, tl = d ? 63 - pi : pi; const size_t ix = (size_t)(row0 + t0 + tl) * 1024 + chs; hf16[i] = YA[ix]; g16[i] = GA[ix]; } }
        __syncthreads();
        {   f32x4 ar[4], ai[4];
#pragma unroll
            for (int m = 0; m < 4; ++m) { ar[m] = (f32x4){0.f, 0.f, 0.f, 0.f}; ai[m] = ar[m];
#pragma unroll
                for (int s = 0; s < 2; ++s) { const bf16x8 a = *(const LAS bf16x8*)(U16 + (16 * m + fj) * 72 + 32 * s + 8 * fq);
                    ar[m] = __builtin_amdgcn_mfma_f32_16x16x32_bf16(a, wrf[s], ar[m], 0, 0, 0); ai[m] = __builtin_amdgcn_mfma_f32_16x16x32_bf16(a, wif[s], ai[m], 0, 0, 0); } }
#pragma unroll
            for (int m = 0; m < 4; ++m)
#pragma unroll
                for (int r4 = 0; r4 < 4; ++r4) { const int tok = 16 * m + 4 * fq + r4, ix = tok * 68 + 16 * hw + fj;
                    const float rg = sigmoidf_(ar[m][r4] + br), a = __builtin_amdgcn_exp2f(sp8 * rg);
                    const float ei = 1.0f + __builtin_amdgcn_exp2f(-1.44269504089f * (ai[m][r4] + bi)), om = fmaxf(1.0f - a * a, 1e-30f);
                    const float bb = om * __builtin_amdgcn_rsqf(om * ei * ei) * UB[ix]; AA[ix] = a; UB[ix] = bb; } }
        __syncthreads();
        float av[16], bv[16]; float P = 1.f, h = 0.f;
#pragma unroll
        for (int i = 0; i < 16; ++i) { const int pi = 16 * hw + i, tl = d ? 63 - pi : pi; av[i] = AA[tl * 68 + lane]; bv[i] = UB[tl * 68 + lane]; h = av[i] * h + bv[i]; P *= av[i]; }
        AGG[hw * 64 + lane] = (f32x2){P, h};
        __syncthreads();
        h = CAR[(k & 1) * 64 + lane];
        for (int s2 = 0; s2 < hw; ++s2) { const f32x2 ag = AGG[s2 * 64 + lane]; h = ag.x * h + ag.y; }
#pragma unroll
        for (int i = 0; i < 16; ++i) { const int pi = 16 * hw + i, tl = d ? 63 - pi : pi; const size_t ix = (size_t)(row0 + t0 + tl) * 1024 + chs; h = av[i] * h + bv[i];
            YA[ix] = f2bf1(second ? bf2f(g16[i]) * (bf2f(hf16[i]) + h) : h); }
        if (hw == 3) { CAR[((k + 1) & 1) * 64 + lane] = h; hfin = h; }
        if (2 * k + 2 == nch) asm volatile("s_waitcnt vmcnt(0)" ::: "memory");
        __syncthreads();
    }
#undef LRU_LOADX
    if (!sample && hw == 3) p.out[OFF_LRU + (size_t)(b * 2 + d) * 1024 + chs] = hfin;
}

__device__ __forceinline__ void sincos_f(float x, float& s, float& c) {
    const float jf = rintf(x * 0.636619772f); const int j = (int)jf;
    float r = x - jf * 1.5703125f; r -= jf * 4.837512969970703125e-4f; r -= jf * 7.54978995489188216e-8f;
    const float z = r * r;
    const float sp = r + r * z * (-1.6666654611e-1f + z * (8.3321608736e-3f + z * (-1.9515295891e-4f)));
    const float cp = 1.0f - 0.5f * z + z * z * (4.166664568298827e-2f + z * (-1.388731625493765e-3f + z * 2.443315711809948e-5f));
    const int q = j & 3;
    s = (q == 0) ? sp : (q == 1) ? cp : (q == 2) ? -sp : -cp;
    c = (q == 0) ? cp : (q == 1) ? -sp : (q == 2) ? -cp : sp;
}
__device__ __forceinline__ void s5_disc(const Ctx p, int d, int g, int ps, float& abr, float& abi, float& fre, float& fim) {
    const float lr = PIN(21)[(d * 32 + g) * 64 + ps], li = PIN(22)[(d * 32 + g) * 64 + ps], dt = __expf(PIN(23)[d * 32 + g]);
    const float mag = __expf(lr * dt); float sn, cs; sincos_f(li * dt, sn, cs);
    abr = mag * cs; abi = mag * sn;
    const float den = lr * lr + li * li, nr = abr - 1.0f, ni = abi;
    fre = (nr * lr + ni * li) / den; fim = (ni * lr - nr * li) / den;
}
constexpr int S5_HS_STRIDE = 272, S5_HS_WAVE = 32 * S5_HS_STRIDE;
__device__ __forceinline__ void s5_item(const Ctx p, LAS unsigned char* lds, int sample, int b, int g0) {
    int tid_ = threadIdx.x; asm volatile("" : "+v"(tid_)); const int tid = tid_, w = tid >> 6, lane = tid & 63, d = w & 1, g = g0 + (w >> 1);
    const int T = sample ? T_S : T_CTX, row0 = sample ? MC + b * T_S : b * T_CTX, nch = T / 32;
    LAS unsigned char* Hs = lds + w * S5_HS_WAVE;
    const bf16_t* XS = (const bf16_t*)(p.ws + WS_XS); bf16_t* VS = (bf16_t*)(p.ws + WS_VS);
    const int j31 = lane & 31, hi = lane >> 5;
    float abr1, abi1, fr1, fi1, abr2, abi2, fr2, fi2;
    s5_disc(p, d, g, j31, abr1, abi1, fr1, fi1); s5_disc(p, d, g, 32 + j31, abr2, abi2, fr2, fi2);
    const float abr = hi ? abr2 : abr1, abi = hi ? abi2 : abi1;
    bf16x8 bfr[4];
#pragma unroll
    for (int st = 0; st < 2; ++st) { const int ps = 32 * st + j31; const float fr = st ? fr2 : fr1, fi = st ? fi2 : fi1;
        const float* bre = PIN(24) + ((size_t)(d * 32 + g) * 64 + ps) * 16 + 8 * hi; const float* bim = PIN(25) + ((size_t)(d * 32 + g) * 64 + ps) * 16 + 8 * hi;
#pragma unroll
        for (int e = 0; e < 8; ++e) { const float vr = bre[e], vi = bim[e]; bfr[2 * st][e] = (short)f2bf(fr * vr - fi * vi); bfr[2 * st + 1][e] = (short)f2bf(fr * vi + fi * vr); } }
    const int fh = lane & 15, kq = lane >> 4;
    bf16x8 cfr[4];
#pragma unroll
    for (int ks = 0; ks < 4; ++ks)
#pragma unroll
        for (int e = 0; e < 8; ++e) { const int pp = 16 * ks + 4 * kq + (e >> 1); const size_t ix = ((size_t)(d * 32 + g) * 16 + fh) * 64 + pp;
            cfr[ks][e] = (short)f2bf((e & 1) ? -PIN(27)[ix] : PIN(26)[ix]); }
    const float dsk = PIN(28)[g * 16 + fh];
    const float one = __builtin_fmaf(dsk, 0.f, 1.0f);
    float hr = 0.f, hi_ = 0.f;
    if (sample) { const size_t ix = ((size_t)(b * 2 + d) * 32 + g) * 64 + lane; hr = PIN(4)[ix]; hi_ = PIN(5)[ix]; }
    const int step = (d ? -1 : 1) * (sample ? 64 : 1);
    const int ua_off = step * 512 * j31 + g * 16 + 8 * hi;
    int eoff[8];
#pragma unroll
    for (int e = 0; e < 8; ++e) eoff[e] = step * 512 * (16 * (e >> 2) + 4 * kq + (e & 3)) + g * 16 + fh;
#define S5_CBASE(kk) ({ const int s0_ = d ? T - 1 - 32 * (kk) : 32 * (kk); const int t0_ = sample ? ((s0_ & 63) * 64 + (s0_ >> 6)) : s0_; (size_t)(row0 + t0_) * 512; })
    bf16x8 ua_next = *(const bf16x8*)(XS + S5_CBASE(0) + ua_off);
    for (int k = 0; k < nch; ++k) {
        const bool second = (2 * k >= nch);
        const size_t cbase = S5_CBASE(k);
        const bf16x8 ua = ua_next;
        if (k + 1 < nch) ua_next = *(const bf16x8*)(XS + S5_CBASE(k + 1) + ua_off);
        unsigned short vf16[8], xs16[8];
        if (second) {
#pragma unroll
            for (int mt = 0; mt < 2; ++mt)
#pragma unroll
                for (int r4 = 0; r4 < 4; ++r4) { const size_t ix = cbase + eoff[mt * 4 + r4]; vf16[mt * 4 + r4] = VS[ix]; xs16[mt * 4 + r4] = XS[ix]; } }
        f32x16 acc[4];
#pragma unroll
        for (int nt = 0; nt < 4; ++nt) { f32x16 z;
#pragma unroll
            for (int v = 0; v < 16; ++v) z[v] = 0.f;
            acc[nt] = __builtin_amdgcn_mfma_f32_32x32x16_bf16(ua, bfr[nt], z, 0, 0, 0); }
        float bur[32], bui[32];
#pragma unroll
        for (int v = 0; v < 16; ++v) {
            unsigned r0 = __builtin_bit_cast(unsigned, acc[0][v] * one), r1 = __builtin_bit_cast(unsigned, acc[2][v] * one);
            unsigned q0 = __builtin_bit_cast(unsigned, acc[1][v] * one), q1 = __builtin_bit_cast(unsigned, acc[3][v] * one);
            asm volatile("s_nop 1\n\tv_permlane32_swap_b32 %0, %1" : "+v"(r0), "+v"(r1));
            asm volatile("s_nop 1\n\tv_permlane32_swap_b32 %0, %1" : "+v"(q0), "+v"(q1));
            const int ta = 8 * (v >> 2) + (v & 3);
            bur[ta] = __builtin_bit_cast(float, r0); bur[ta + 4] = __builtin_bit_cast(float, r1);
            bui[ta] = __builtin_bit_cast(float, q0); bui[ta + 4] = __builtin_bit_cast(float, q1); }
#pragma unroll
        for (int tt = 0; tt < 32; ++tt) { const float nr = abr * hr - abi * hi_ + bur[tt], ni = abr * hi_ + abi * hr + bui[tt]; hr = nr; hi_ = ni;
            *(LAS unsigned*)(Hs + tt * S5_HS_STRIDE + 4 * lane) = pk2(hr, hi_); }
        f32x4 ya[2];
#pragma unroll
        for (int mt = 0; mt < 2; ++mt) { ya[mt] = (f32x4){0.f, 0.f, 0.f, 0.f};
#pragma unroll
            for (int ks = 0; ks < 4; ++ks) { const bf16x8 a = *(const LAS bf16x8*)(Hs + (16 * mt + fh) * S5_HS_STRIDE + (32 * ks + 8 * kq) * 2);
                ya[mt] = __builtin_amdgcn_mfma_f32_16x16x32_bf16(a, cfr[ks], ya[mt], 0, 0, 0); } }
#pragma unroll
        for (int mt = 0; mt < 2; ++mt)
#pragma unroll
            for (int r4 = 0; r4 < 4; ++r4) { const size_t ix = cbase + eoff[mt * 4 + r4]; float y = ya[mt][r4];
                if (second) { y = gelu_tanh(y + bf2f(vf16[mt * 4 + r4]) + dsk * bf2f(xs16[mt * 4 + r4])); }
                VS[ix] = f2bf1(y); }
        if (2 * k + 2 == nch) { asm volatile("s_waitcnt vmcnt(0)" ::: "memory"); __syncthreads(); }
    }
#undef S5_CBASE
    if (!sample) { const size_t ix = ((size_t)(b * 2 + d) * 32 + g) * 64 + lane; p.out[OFF_RE + ix] = hr; p.out[OFF_IM + ix] = hi_; }
}
__device__ __forceinline__ void p3_scans(const Ctx p, LAS unsigned char* lds) {
    const int bx = blockIdx.x;
    if (bx < 128) { lru_unit(p, lds, 1, bx >> 4, bx & 15); }
    else if (bx < 192) { const int i = bx - 128; s5_item(p, lds, 1, i >> 3, 4 * (i & 7)); }
    else { const int i = bx - 192;
        for (int e = 0; e < 8; ++e) { const int c = 8 * i + e; lru_unit(p, lds, 0, c >> 4, c & 15); __syncthreads(); }
        for (int e = 0; e < 4; ++e) { const int c = 4 * i + e; s5_item(p, lds, 0, c >> 3, 4 * (c & 7)); __syncthreads(); } }
}

#define XB_TMO      128
#define XB_XCNT(j)  (256  + 64 * (j))
#define XB_XSUB(j)  (1280 + 64 * (j))
#define XB_XGEN(j)  (2304 + 64 * (j))
#define XB_TOP      3328
#define XB_TOPGEN   3392
#define XCD_BAR_WORDS 3456
#define XB_SPIN_CAP (1u << 18)

__device__ __forceinline__ unsigned xb_ld(unsigned* p)              { return __hip_atomic_load(p, __ATOMIC_RELAXED, __HIP_MEMORY_SCOPE_AGENT); }
__device__ __forceinline__ unsigned xb_add(unsigned* p, unsigned v) { return __hip_atomic_fetch_add(p, v, __ATOMIC_RELAXED, __HIP_MEMORY_SCOPE_AGENT); }
__device__ __forceinline__ unsigned xb_xcc_id() { return (unsigned)__builtin_amdgcn_s_getreg((3 << 11) | 20) & 0xFu; }
#define XB_SPIN(cond, bar) do { unsigned _sp = 0; while (cond) { __builtin_amdgcn_s_sleep(1); \
    if ((++_sp & 255u) == 0u) { if (xb_ld(&(bar)[XB_TMO])) break; if (_sp > XB_SPIN_CAP) { atomicAdd(&(bar)[XB_TMO], 1u); break; } } } } while (0)

struct XcdBarrier {
    unsigned* bar; unsigned x;
    volatile LAS unsigned* st;
};

__device__ __forceinline__ XcdBarrier xcd_barrier_post(unsigned* bar, volatile LAS unsigned* st) {
    XcdBarrier b; b.bar = bar; b.x = xb_xcc_id(); b.st = st;
    if (threadIdx.x == 0) (void)xb_add(&bar[XB_XCNT(b.x)], 1u);
    return b;
}
__device__ __forceinline__ void xcd_barrier_complete(unsigned* bar, unsigned x, unsigned& nloc, unsigned& nx) {
    const unsigned G = gridDim.x * gridDim.y * gridDim.z;
    unsigned sum, cnt, mine, sp = 0u;
    for (;;) {
        sum = 0u; cnt = 0u; mine = 0u;
#pragma unroll
        for (unsigned j = 0; j < 16; ++j) { const unsigned c = xb_ld(&bar[XB_XCNT(j)]); sum += c; cnt += (c > 0u) ? 1u : 0u; mine = (j == x) ? c : mine; }
        if (sum == G) break;
        __builtin_amdgcn_s_sleep(1);
        if ((++sp & 255u) == 0u) { if (xb_ld(&bar[XB_TMO])) break; if (sp > XB_SPIN_CAP) { atomicAdd(&bar[XB_TMO], 1u); break; } }
    }
    nloc = mine > 0u ? mine : 1u; nx = cnt > 0u ? cnt : 1u;
}

__device__ __forceinline__ void xcd_barrier(const XcdBarrier& b) {
    asm volatile("s_waitcnt vmcnt(0)" ::: "memory");
    __syncthreads();
    if (threadIdx.x == 0) {
        unsigned* bar = b.bar;
        __builtin_amdgcn_s_waitcnt(0);
        unsigned nloc = b.st[0], nx = b.st[1];
        if (nloc == 0u) { xcd_barrier_complete(bar, b.x, nloc, nx); b.st[0] = nloc; b.st[1] = nx; }
        const unsigned old = xb_add(&bar[XB_XSUB(b.x)], 1u);
        const unsigned gen = old / nloc;
        if (old + 1u == (gen + 1u) * nloc) {
            __builtin_amdgcn_fence(__ATOMIC_RELEASE, "agent");
            asm volatile("s_waitcnt vmcnt(0)" ::: "memory");
            const unsigned og = xb_add(&bar[XB_TOP], 1u);
            const unsigned tg = og / nx;
            if (og + 1u == (tg + 1u) * nx) xb_add(&bar[XB_TOPGEN], 1u);
            else XB_SPIN(xb_ld(&bar[XB_TOPGEN]) == tg, bar);
            __builtin_amdgcn_fence(__ATOMIC_ACQUIRE, "agent");
            xb_add(&bar[XB_XGEN(b.x)], 1u);
            asm volatile("s_waitcnt vmcnt(0)" ::: "memory");
        } else {
            XB_SPIN(xb_ld(&bar[XB_XGEN(b.x)]) == gen, bar);
            __builtin_amdgcn_fence(__ATOMIC_ACQUIRE, "agent");
            asm volatile("s_waitcnt vmcnt(0)" ::: "memory");
        }
    }
    __syncthreads();
}

#define GRID_SYNC() do { asm volatile("s_waitcnt vmcnt(0)" ::: "memory"); grid.sync(); if (threadIdx.x < 64) { __builtin_amdgcn_fence(__ATOMIC_ACQUIRE, "agent"); asm volatile("s_waitcnt vmcnt(0)" ::: "memory"); } __syncthreads(); } while (0)
__global__ void __launch_bounds__(512, 2) fwd_mega(Params kp) {
    extern __shared__ __attribute__((aligned(16))) unsigned char lds_raw[];
    LAS unsigned char* lds = (LAS unsigned char*)lds_raw;
    {   LAS unsigned long long* t_ = (LAS unsigned long long*)(lds + LDS_BYTES - 512);
        if (threadIdx.x == 0) { t_[0] = (unsigned long long)kp.in[0]; t_[1] = (unsigned long long)kp.in[1]; t_[2] = (unsigned long long)kp.in[2]; t_[3] = (unsigned long long)kp.in[3]; t_[4] = (unsigned long long)kp.in[4]; t_[5] = (unsigned long long)kp.in[5]; t_[6] = (unsigned long long)kp.in[6]; t_[7] = (unsigned long long)kp.in[7]; t_[8] = (unsigned long long)kp.in[8]; t_[9] = (unsigned long long)kp.in[9]; t_[10] = (unsigned long long)kp.in[10]; t_[11] = (unsigned long long)kp.in[11]; t_[12] = (unsigned long long)kp.in[12]; t_[13] = (unsigned long long)kp.in[13]; t_[14] = (unsigned long long)kp.in[14]; t_[15] = (unsigned long long)kp.in[15]; t_[16] = (unsigned long long)kp.in[16]; t_[17] = (unsigned long long)kp.in[17]; t_[18] = (unsigned long long)kp.in[18]; t_[19] = (unsigned long long)kp.in[19]; t_[20] = (unsigned long long)kp.in[20]; t_[21] = (unsigned long long)kp.in[21]; t_[22] = (unsigned long long)kp.in[22]; t_[23] = (unsigned long long)kp.in[23]; t_[24] = (unsigned long long)kp.in[24]; t_[25] = (unsigned long long)kp.in[25]; t_[26] = (unsigned long long)kp.in[26]; t_[27] = (unsigned long long)kp.in[27]; t_[28] = (unsigned long long)kp.in[28]; t_[29] = (unsigned long long)kp.in[29]; t_[30] = (unsigned long long)kp.in[30]; t_[31] = (unsigned long long)kp.in[31]; t_[32] = (unsigned long long)kp.in[32]; t_[33] = (unsigned long long)kp.in[33]; t_[34] = (unsigned long long)kp.in[34]; t_[35] = (unsigned long long)kp.in[35]; t_[36] = (unsigned long long)kp.in[36]; t_[37] = (unsigned long long)kp.in[37]; }
        __syncthreads(); }
    Ctx p; p.tbl = (const LAS unsigned long long*)(lds + LDS_BYTES - 512); p.out = kp.out; p.ws = kp.ws;
    cg::grid_group grid = cg::this_grid();
    unsigned char* ws = p.ws; const int G = gridDim.x, bx = blockIdx.x;
    bf16_t* GATE = (bf16_t*)p.out;
    volatile LAS unsigned* xst = (volatile LAS unsigned*)(lds + LDS_BYTES - 512 - 16);
    if (threadIdx.x < 4) xst[threadIdx.x] = 0u;
    __syncthreads();
    const XcdBarrier xb = xcd_barrier_post((unsigned*)(ws + 768 * 1024), xst);
#define GRID_BAR() xcd_barrier(xb)
    p0_prologue(p, lds);
    if (G == 0x7fffffff) GRID_SYNC();
    GRID_BAR();
    p1_hn(p);
    GRID_BAR();
    {   pg8::Gemm g{(const bf16_t*)(ws + WS_HN), (const bf16_t*)(ws + WS_W1T), MT, 2560, 1024}; pg8::StaticOrder S; S.init(MT, 2560, G, bx);
        pg8::Epi1 E{(bf16_t*)(ws + WS_XA), (bf16_t*)(ws + WS_GA), (bf16_t*)(ws + WS_XS)};
        pg8::gemm_phase<pg8::Epi1, pg8::StaticOrder>(lds, g, S, E);
        pg8::Gemm g2{(const bf16_t*)(ws + WS_HN), (const bf16_t*)(ws + WS_W1T) + (size_t)2560 * 1024, MT, 2048, 1024}; pg8::ListOrder S2; S2.init(MT, 2048, G, bx); S2.base = bx; S2.stride = 256; S2.count = 3; S2.extra = bx >= 64 ? 768 + (bx - 64) : -1;
        pg8::EpiGate E2{GATE, PIN(34)};
        pg8::gemm_phase<pg8::EpiGate, pg8::ListOrder>(lds, g2, S2, E2); }
    GRID_BAR();
    p3_scans(p, lds);
    if (bx < 128 || bx >= 192) {
        __syncthreads();
        pg8::Gemm g2{(const bf16_t*)(ws + WS_HN), (const bf16_t*)(ws + WS_W1T) + (size_t)2560 * 1024, MT, 2048, 1024}; pg8::ListOrder S2; S2.init(MT, 2048, G, bx);
        S2.extra = -1; if (bx >= 192) { S2.base = 1088 + (bx - 192); S2.stride = 64; S2.count = 3; } else { S2.base = 960 + bx; S2.stride = 1; S2.count = 1; }
        pg8::EpiGate E2{GATE, PIN(34)};
        pg8::gemm_phase<pg8::EpiGate, pg8::ListOrder>(lds, g2, S2, E2);
    }
    GRID_BAR();
    {
        pg8::StaticOrder S; S.init(MT, 1024, G, bx);
        pg8::Gemm ga{(const bf16_t*)(ws + WS_YA), (const bf16_t*)(ws + WS_WPL), MT, 1024, 1024};
        pg8::EpiMerge<0> Ea{GATE, (bf16_t*)(ws + WS_TMP), (bf16_t*)(ws + WS_MPRE)};
        pg8::gemm_phase<pg8::EpiMerge<0>, pg8::StaticOrder>(lds, ga, S, Ea);
        pg8::Gemm g{(const bf16_t*)(ws + WS_VS), (const bf16_t*)(ws + WS_WGLU), MT, 512, 512}; pg8::StaticOrder S4; S4.init(MT, 512, G, (bx + 128) & 255);
        pg8::EpiGlu E{(const bf16_t*)(ws + WS_VS), (bf16_t*)(ws + WS_YS), PIN(30)};
        pg8::gemm_phase<pg8::EpiGlu, pg8::StaticOrder>(lds, g, S4, E); }
    GRID_BAR();
    {   pg8::StaticOrder S; S.init(MT, 1024, G, bx);
        pg8::Gemm gb{(const bf16_t*)(ws + WS_YS), (const bf16_t*)(ws + WS_WPS), MT, 1024, 512};
        pg8::EpiMerge<1> Eb{GATE, (bf16_t*)(ws + WS_TMP), (bf16_t*)(ws + WS_MPRE)};
        pg8::gemm_phase<pg8::EpiMerge<1>, pg8::StaticOrder>(lds, gb, S, Eb);
        if (bx >= 128) copy_tiles(p, lds, 3200, 3904, bx - 128, 128); }
    GRID_BAR();
    {   pg8::Gemm g{(const bf16_t*)(ws + WS_MPRE), (const bf16_t*)(ws + WS_WOUT), MT, 1024, 1024}; pg8::StaticOrder S; S.init(MT, 1024, G, bx);
        pg8::EpiOutSS E{(bf16_t*)(ws + WS_MO), (float*)(ws + WS_SSP1)};
        pg8::gemm_phase<pg8::EpiOutSS, pg8::StaticOrder>(lds, g, S, E);
        if (bx >= 128) copy_tiles(p, lds, 1792, 3200, bx - 128, 128); }
    GRID_BAR();
    p7_x1(p);
    GRID_BAR();
    {   pg8::Gemm g{(const bf16_t*)(ws + WS_HN2), (const bf16_t*)(ws + WS_WFI), MT, 2 * DFF, 1024}; pg8::StaticOrder S; S.init(MT, 2 * DFF, G, bx);
        pg8::EpiFF E{(bf16_t*)(ws + WS_HID)};
        pg8::gemm_phase<pg8::EpiFF, pg8::StaticOrder>(lds, g, S, E); }
    GRID_BAR();
    {
        pg8::Gemm g{(const bf16_t*)(ws + WS_HID), (const bf16_t*)(ws + WS_WFO), MT, 1024, DFF}; pg8::StaticOrder S; S.init(128 * 256, 1024, G, bx);
        pg8::EpiPlain E{(bf16_t*)(ws + WS_FO)};
        pg8::gemm_phase<pg8::EpiPlain, pg8::StaticOrder>(lds, g, S, E);
        const int tile = bx >> 1, kh = bx & 1;
        pg8::Gemm gh{(const bf16_t*)(ws + WS_HID) + kh * (DFF / 2), (const bf16_t*)(ws + WS_WFO) + kh * (DFF / 2), MT, 1024, DFF / 2, DFF};
        pg8::OneUnit S1{128 + (tile >> 2), tile & 3};
        pg8::EpiPlain Eh{(bf16_t*)(ws + (kh ? WS_FOB : WS_FO))};
        pg8::gemm_phase<pg8::EpiPlain, pg8::OneUnit>(lds, gh, S1, Eh); }
    GRID_BAR();
    p10_out(p);
}

extern "C" void kernel_launch(void* const* d_in, const int* in_sizes, int n_in, void* d_out, int out_size, void* d_ws, size_t ws_size, hipStream_t stream) {
    static int grid = 0;
    if (grid == 0) {
        if (n_in != 38 || (size_t)out_size != OFF_IM + 32 * 2 * 32 * 64 || ws_size < WS_END) { fprintf(stderr, "kernel_launch: unexpected shapes (n_in %d out %d ws %zu)\n", n_in, out_size, ws_size); grid = -1; return; }
        int dev = 0, cus = 0, per_cu = 0;
        hipGetDevice(&dev); hipDeviceGetAttribute(&cus, hipDeviceAttributeMultiprocessorCount, dev);
        if (hipFuncSetAttribute((const void*)fwd_mega, hipFuncAttributeMaxDynamicSharedMemorySize, LDS_BYTES) != hipSuccess) { fprintf(stderr, "kernel_launch: hipFuncSetAttribute failed\n"); grid = -1; return; }
        if (hipOccupancyMaxActiveBlocksPerMultiprocessor(&per_cu, (const void*)fwd_mega, 512, LDS_BYTES) != hipSuccess || per_cu < 1) { fprintf(stderr, "kernel_launch: occupancy query says %d blocks/CU\n", per_cu); grid = -1; return; }
        if (cus < 256) { fprintf(stderr, "kernel_launch: needs 256 CUs, device has %d\n", cus); grid = -1; return; }
        grid = 256;
    }
    if (grid < 0) return;
    Params p{};
    for (int i = 0; i < 38; ++i) p.in[i] = (const float*)d_in[i];
    p.out = (float*)d_out; p.ws = (unsigned char*)d_ws;
    if (hipMemsetAsync((char*)d_ws + 768 * 1024, 0, XCD_BAR_WORDS * 4, stream) != hipSuccess) { fprintf(stderr, "kernel_launch: hipMemsetAsync of the barrier word failed\n"); return; }
    void* args[] = {&p};
    hipError_t e = hipLaunchCooperativeKernel((const void*)fwd_mega, dim3(grid), dim3(512), args, LDS_BYTES, stream);
    if (e != hipSuccess) fprintf(stderr, "cooperative launch failed: %s\n", hipGetErrorString(e));
}
```
